# Optimizing an MI355X kernel written in HIP

```python
import jax, jax.numpy as jnp
from jax import lax
import numpy as np

D_MODEL = 1024
BATCH = 32
SEQ = 256
DEPTH = 4
DEC_BATCH = 8
DEC_SEQ = 4096
PAST_LEN = 512

GRID_W = 64
N_MIXERS = 3
N_HEADS = 16
N_KV_HEADS = 4
HEAD_DIM = D_MODEL // N_HEADS
Q_PER_KV = N_HEADS // N_KV_HEADS
QKV_DIM = (N_HEADS + 2 * N_KV_HEADS) * HEAD_DIM
WINDOW = 128
BLOCK = 128
ROPE_THETA = 10000.0
POOL_WINDOWS = (2, 4, 8, 16)
N_POOL_GROUPS = 4
POOL_GROUP_DIM = D_MODEL // N_POOL_GROUPS
N_FFT_GROUPS = 4
FFT_GROUP_DIM = D_MODEL // N_FFT_GROUPS
D_FF = ((8 * D_MODEL // 3 + 127) // 128) * 128
CONV_W = 3
EPS = 1e-6
NEG_INF = -1e30
N_ATTN_LAYERS = (DEPTH + 2) // 3
N_POOL_LAYERS = (DEPTH + 1) // 3
N_FFT_LAYERS = DEPTH // 3

kernel_name = 'hybrid_diffusion_prefix_trunk_step'


def rmsnorm(x, g):
    xf = x.astype(jnp.float32)
    y = xf * lax.rsqrt(jnp.mean(xf * xf, axis=-1, keepdims=True) + EPS)
    return (y * g.astype(jnp.float32)).astype(x.dtype)


def ada_mods(cond, w, b):
    cond = cond.reshape(-1, D_MODEL)
    mod = (jax.nn.silu(cond) @ w + b)[:, None, :]
    return jnp.split(mod, 6, axis=-1)


def modulate(h, shift, scale):
    return h * (1 + scale) + shift


def axial_rope(x):
    L = x.shape[1]
    rows_n = L // GRID_W
    rows = jnp.repeat(jnp.arange(rows_n), GRID_W)
    cols = jnp.tile(jnp.arange(GRID_W), rows_n)
    half = HEAD_DIM // 2
    inv_freq = 1.0 / (ROPE_THETA ** (jnp.arange(0, half, 2, dtype=jnp.float32) / half))

    def rot(xp, pos):
        ang = pos.astype(jnp.float32)[:, None] * inv_freq
        cos = jnp.cos(ang)[None, :, None, :]
        sin = jnp.sin(ang)[None, :, None, :]
        x1, x2 = jnp.split(xp.astype(jnp.float32), 2, axis=-1)
        return jnp.concatenate([x1 * cos - x2 * sin, x1 * sin + x2 * cos], axis=-1)

    return jnp.concatenate([rot(x[..., :half], rows), rot(x[..., half:], cols)], axis=-1).astype(x.dtype)


def qkv_proj(h, w_qkv, q_norm, k_norm):
    B, L, _ = h.shape
    q, k, v = jnp.split(h @ w_qkv, [N_HEADS * HEAD_DIM, (N_HEADS + N_KV_HEADS) * HEAD_DIM], axis=-1)
    q = rmsnorm(q.reshape(B, L, N_HEADS, HEAD_DIM), q_norm)
    k = rmsnorm(k.reshape(B, L, N_KV_HEADS, HEAD_DIM), k_norm)
    v = v.reshape(B, L, N_KV_HEADS, HEAD_DIM)
    return q, k, v


def attend_block(qb, keys, values, masks, sink):
    scale = HEAD_DIM ** -0.5
    scores = []
    for kp, mk in zip(keys, masks):
        s = jnp.einsum('bqkgd,bskd->bkgqs', qb, kp).astype(jnp.float32) * scale
        if mk is not None:
            s = jnp.where(mk, s, NEG_INF)
        scores.append(s)
    sink_f = sink.astype(jnp.float32).reshape(1, N_KV_HEADS, Q_PER_KV, 1)
    m = sink_f
    for s in scores:
        m = jnp.maximum(m, jnp.max(s, axis=-1))
    denom = jnp.exp(sink_f - m)
    out = jnp.zeros(qb.shape, jnp.float32)
    for s, vp in zip(scores, values):
        p = jnp.exp(s - m[..., None])
        denom = denom + jnp.sum(p, axis=-1)
        out = out + jnp.einsum('bkgqs,bskd->bqkgd', p.astype(vp.dtype), vp).astype(jnp.float32)
    out = out / jnp.moveaxis(denom, -1, 1)[..., None]
    return out.astype(qb.dtype)


def context_attention(q, k, v, sink):
    B, S = q.shape[:2]
    nqb = S // BLOCK
    qg = jnp.moveaxis(q.reshape(B, nqb, BLOCK, N_KV_HEADS, Q_PER_KV, HEAD_DIM), 1, 0)
    out = lax.map(lambda qb: attend_block(qb, [k], [v], [None], sink), qg)
    return jnp.moveaxis(out, 0, 1).reshape(B, S, N_HEADS * HEAD_DIM)


def latent_attention(q, k, v, ctx_k, ctx_v, sink):
    B, L = q.shape[:2]
    nqb = L // BLOCK
    qg = jnp.moveaxis(q.reshape(B, nqb, BLOCK, N_KV_HEADS, Q_PER_KV, HEAD_DIM), 1, 0)
    pad = ((0, 0), (BLOCK, BLOCK), (0, 0), (0, 0))
    k_pad = jnp.pad(k, pad)
    v_pad = jnp.pad(v, pad)
    qi = jnp.arange(BLOCK)
    sj = jnp.arange(3 * BLOCK)
    band = jnp.abs((sj[None, :] - BLOCK) - qi[:, None]) <= WINDOW

    def one_block(args):
        n, qb = args
        kw = lax.dynamic_slice_in_dim(k_pad, n * BLOCK, 3 * BLOCK, axis=1)
        vw = lax.dynamic_slice_in_dim(v_pad, n * BLOCK, 3 * BLOCK, axis=1)
        kpos = n * BLOCK - BLOCK + sj
        mask = band & ((kpos >= 0) & (kpos < L))[None, :]
        return attend_block(qb, [kw, ctx_k], [vw, ctx_v], [mask, None], sink)

    out = lax.map(one_block, (jnp.arange(nqb), qg))
    return jnp.moveaxis(out, 0, 1).reshape(B, L, N_HEADS * HEAD_DIM)


def pool_mix(h, w, scale):
    B, L, D = h.shape
    hf = h.astype(jnp.float32)
    cs = jnp.concatenate([jnp.zeros((B, 1, D), jnp.float32), jnp.cumsum(hf, axis=1)], axis=1)
    t = jnp.arange(L)
    outs = []
    for g, win in enumerate(POOL_WINDOWS):
        lo = win // 2
        hi = win - lo - 1
        start = jnp.clip(t - lo, 0, L)
        end = jnp.clip(t + hi + 1, 0, L)
        csg = cs[..., g * POOL_GROUP_DIM:(g + 1) * POOL_GROUP_DIM]
        mean = (csg[:, end] - csg[:, start]) / (end - start).astype(jnp.float32)[None, :, None]
        outs.append(mean - hf[..., g * POOL_GROUP_DIM:(g + 1) * POOL_GROUP_DIM])
    pooled = jnp.stack(outs, axis=2).astype(h.dtype)
    mixed = jnp.einsum('blgc,gcd->blgd', pooled, w).reshape(B, L, D)
    return mixed * scale


def fourier_mix(h, w):
    B, L, D = h.shape
    hg = h.astype(jnp.float32).reshape(B, L, N_FFT_GROUPS, FFT_GROUP_DIM)
    f = jnp.fft.fft2(hg, axes=(1, 3), norm='ortho').real
    return f.reshape(B, L, D).astype(h.dtype) @ w


def conv_ffn(h, w_in, conv_w, conv_b, w_out):
    u = h @ w_in
    up = jnp.pad(u, ((0, 0), (1, 1), (0, 0)))
    u = up[:, :-2] * conv_w[0] + up[:, 1:-1] * conv_w[1] + up[:, 2:] * conv_w[2] + conv_b
    gate, val = jnp.split(u, 2, axis=-1)
    return (jax.nn.silu(gate) * val) @ w_out


def trunk(x, cond, ctx_k_cache, ctx_v_cache, weights):
    (norm_mix, norm_ffn, ada_w, ada_b, attn_w_qkv, attn_q_norm, attn_k_norm, attn_sink, attn_w_o,
     pool_w, pool_scale, fnet_w, ffn_w_in, ffn_conv_w, ffn_conv_b, ffn_w_out) = weights
    is_latent = ctx_k_cache is not None
    ks, vs = [], []
    for i in range(DEPTH):
        kind, j = i % N_MIXERS, i // N_MIXERS
        sh1, sc1, g1, sh2, sc2, g2 = ada_mods(cond, ada_w[i], ada_b[i])
        h = modulate(rmsnorm(x, norm_mix[i]), sh1, sc1)
        if kind == 0:
            q, k, v = qkv_proj(h, attn_w_qkv[j], attn_q_norm[j], attn_k_norm[j])
            if is_latent:
                o = latent_attention(axial_rope(q), axial_rope(k), v,
                                     ctx_k_cache[:, j], ctx_v_cache[:, j], attn_sink[j])
            else:
                o = context_attention(q, k, v, attn_sink[j])
                ks.append(k)
                vs.append(v)
            mix = o @ attn_w_o[j]
        elif kind == 1:
            mix = pool_mix(h, pool_w[j], pool_scale[j])
        else:
            mix = fourier_mix(h, fnet_w[j])
        x = x + g1 * mix
        h = modulate(rmsnorm(x, norm_ffn[i]), sh2, sc2)
        x = x + g2 * conv_ffn(h, ffn_w_in[i], ffn_conv_w[i], ffn_conv_b[i], ffn_w_out[i])
    return x, ks, vs


def setup_inputs(seed: int = 0) -> dict:
    key = jax.random.key(seed)
    ks = jax.random.split(key, 24)

    def nrm(k, shape, scale=1.0):
        return jax.random.normal(k, shape, jnp.float32) * scale

    cache_shape = (DEC_BATCH, N_ATTN_LAYERS, PAST_LEN, N_KV_HEADS, HEAD_DIM)
    return {
        'x_prompt': nrm(ks[0], (BATCH, SEQ, D_MODEL)),
        'x_sample': nrm(ks[1], (DEC_BATCH, DEC_SEQ, D_MODEL)),
        'cache_k': nrm(ks[2], cache_shape),
        'cache_v': nrm(ks[3], cache_shape),
        'c': nrm(ks[4], (DEC_BATCH, D_MODEL)),
        'c_ctx': nrm(ks[5], (D_MODEL,)),
        'norm_mix': 1.0 + nrm(ks[6], (DEPTH, D_MODEL), 0.1),
        'norm_ffn': 1.0 + nrm(ks[7], (DEPTH, D_MODEL), 0.1),
        'ada_w': nrm(ks[8], (DEPTH, D_MODEL, 6 * D_MODEL), 0.5 * D_MODEL ** -0.5),
        'ada_b': nrm(ks[9], (DEPTH, 6 * D_MODEL), 0.02),
        'attn_w_qkv': nrm(ks[10], (N_ATTN_LAYERS, D_MODEL, QKV_DIM), D_MODEL ** -0.5),
        'attn_q_norm': 1.0 + nrm(ks[11], (N_ATTN_LAYERS, HEAD_DIM), 0.1),
        'attn_k_norm': 1.0 + nrm(ks[12], (N_ATTN_LAYERS, HEAD_DIM), 0.1),
        'attn_sink': nrm(ks[13], (N_ATTN_LAYERS, N_HEADS)),
        'attn_w_o': nrm(ks[14], (N_ATTN_LAYERS, N_HEADS * HEAD_DIM, D_MODEL), (N_HEADS * HEAD_DIM) ** -0.5),
        'pool_w': nrm(ks[15], (N_POOL_LAYERS, N_POOL_GROUPS, POOL_GROUP_DIM, POOL_GROUP_DIM), POOL_GROUP_DIM ** -0.5),
        'pool_scale': 1.0 + nrm(ks[16], (N_POOL_LAYERS, D_MODEL), 0.1),
        'fnet_w': nrm(ks[17], (N_FFT_LAYERS, D_MODEL, D_MODEL), D_MODEL ** -0.5),
        'ffn_w_in': nrm(ks[18], (DEPTH, D_MODEL, 2 * D_FF), D_MODEL ** -0.5),
        'ffn_conv_w': nrm(ks[19], (DEPTH, CONV_W, 2 * D_FF), CONV_W ** -0.5),
        'ffn_conv_b': nrm(ks[20], (DEPTH, 2 * D_FF), 0.02),
        'ffn_w_out': nrm(ks[21], (DEPTH, D_FF, D_MODEL), D_FF ** -0.5),
    }


def reference(x_prompt, x_sample, cache_k, cache_v, c, c_ctx, norm_mix, norm_ffn, ada_w, ada_b,
              attn_w_qkv, attn_q_norm, attn_k_norm, attn_sink, attn_w_o, pool_w, pool_scale, fnet_w,
              ffn_w_in, ffn_conv_w, ffn_conv_b, ffn_w_out):
    weights = (norm_mix, norm_ffn, ada_w, ada_b, attn_w_qkv, attn_q_norm, attn_k_norm, attn_sink,
               attn_w_o, pool_w, pool_scale, fnet_w, ffn_w_in, ffn_conv_w, ffn_conv_b, ffn_w_out)
    y_prompt, ctx_ks, ctx_vs = trunk(x_prompt, c_ctx, None, None, weights)
    new_cache_k = jnp.stack(ctx_ks, axis=1)
    new_cache_v = jnp.stack(ctx_vs, axis=1)
    y_sample, _, _ = trunk(x_sample, c, cache_k, cache_v, weights)
    return (y_prompt, y_sample, new_cache_k, new_cache_v)
```

```cpp
#include <hip/hip_runtime.h>
#include <hip/hip_cooperative_groups.h>
#include <cstdio>
#include <cstdint>
namespace cg = cooperative_groups;

#ifndef MK_MULTI
#define MK_MULTI 0
#endif

#define LAS __attribute__((address_space(3)))
typedef unsigned short bf16_t;
typedef short bf16x8 __attribute__((ext_vector_type(8)));
typedef float f32x2 __attribute__((ext_vector_type(2)));
typedef float f32x4 __attribute__((ext_vector_type(4)));
typedef float f32x16 __attribute__((ext_vector_type(16)));
typedef unsigned u32x2 __attribute__((ext_vector_type(2)));
typedef unsigned u32x4 __attribute__((ext_vector_type(4)));
typedef __bf16 bf16x2_t __attribute__((ext_vector_type(2)));

constexpr int DM = 1024, NCTX = 8192, NTOK = 40960, DFF = 2816, DFF2 = 5632, NQKV = 1536, NMOD = 6144;
constexpr float LOG2E = 1.4426950408889634f;
constexpr float QSCALE = 0.125f * LOG2E;

constexpr size_t MiB = 1u << 20;
constexpr size_t WS_MODS = 0;
constexpr size_t WS_ROPE = 1 * MiB;
constexpr size_t WS_DFT256 = 1 * MiB + 64 * 1024;
constexpr size_t WS_WQKV = 2 * MiB;
constexpr size_t WS_WO = 8 * MiB;
constexpr size_t WS_WPOOL = 12 * MiB;
constexpr size_t WS_WCS = 13 * MiB;
constexpr size_t WS_WIN = 17 * MiB;
constexpr size_t WS_WOUT = 61 * MiB;
constexpr size_t WS_CK = 83 * MiB;
constexpr size_t WS_CVT = 470 * MiB;
constexpr int K_LD = 272;
constexpr int VT_LDC = 288, VT_LDL = 4160, CVT_LD = 544;
constexpr size_t VT_CTX_SEQ = (size_t)256 * VT_LDC, VT_LAT_BASE = 32 * VT_CTX_SEQ, VT_LAT_SEQ = (size_t)256 * VT_LDL;
constexpr size_t WS_HAL = 91 * MiB;
constexpr size_t WS_A1 = 105 * MiB;
constexpr size_t WS_A2 = 109 * MiB;
constexpr size_t WS_YT = 112 * MiB;
constexpr size_t WS_H = 169 * MiB;
constexpr size_t WS_BIG = 249 * MiB;
constexpr size_t WS_PTC = WS_BIG, WS_PTL = WS_BIG + 32 * MiB;
constexpr size_t WS_Q = WS_BIG, WS_K = WS_BIG + 80 * MiB, WS_VT = WS_BIG + 104 * MiB;
constexpr size_t WS_CTL = 469 * MiB;
constexpr size_t CTL_BYTES = 64 * 1024;
constexpr size_t WS_END = 476 * MiB;

constexpr size_t OUT_CK = (size_t)NTOK * DM;
constexpr size_t OUT_CV = OUT_CK + (size_t)32 * 2 * 256 * 256;

constexpr int LDS_RING = 131072, LDS_X = 131072, LDS_MISC = 131072 + 8192, LDS_BYTES = 147456;

__device__ __forceinline__ unsigned cvtpk(float lo, float hi) { f32x2 v = {lo, hi}; bf16x2_t b = __builtin_convertvector(v, bf16x2_t); return __builtin_bit_cast(unsigned, b); }
__device__ __forceinline__ bf16_t f2bf(float f) { return (bf16_t)(cvtpk(f, 0.f) & 0xffffu); }
__device__ __forceinline__ float bf2f(unsigned v) { return __uint_as_float(v << 16); }
__device__ __forceinline__ float dpp_prev(float v) { return __int_as_float(__builtin_amdgcn_update_dpp(0, __float_as_int(v), 0x121, 0xf, 0xf, false)); }
__device__ __forceinline__ float dpp_next(float v) { return __int_as_float(__builtin_amdgcn_update_dpp(0, __float_as_int(v), 0x12F, 0xf, 0xf, false)); }
__device__ __forceinline__ f32x4 dpp_prev4(f32x4 v) { return (f32x4){dpp_prev(v[0]), dpp_prev(v[1]), dpp_prev(v[2]), dpp_prev(v[3])}; }
__device__ __forceinline__ f32x4 dpp_next4(f32x4 v) { return (f32x4){dpp_next(v[0]), dpp_next(v[1]), dpp_next(v[2]), dpp_next(v[3])}; }
#define FMAC_DPP4(ROR) "s_nop 1\n\tv_fmac_f32_dpp %0, %4, %8 row_ror:" #ROR " row_mask:0xf bank_mask:0xf\n\tv_fmac_f32_dpp %1, %5, %9 row_ror:" #ROR " row_mask:0xf bank_mask:0xf\n\t" \
                       "v_fmac_f32_dpp %2, %6, %10 row_ror:" #ROR " row_mask:0xf bank_mask:0xf\n\tv_fmac_f32_dpp %3, %7, %11 row_ror:" #ROR " row_mask:0xf bank_mask:0xf"
__device__ __forceinline__ void fmac_prev4(f32x4& c, const f32x4 s, const f32x4 w) { float c0 = c[0], c1 = c[1], c2 = c[2], c3 = c[3];
    asm volatile(FMAC_DPP4(1) : "+v"(c0), "+v"(c1), "+v"(c2), "+v"(c3) : "v"(s[0]), "v"(s[1]), "v"(s[2]), "v"(s[3]), "v"(w[0]), "v"(w[1]), "v"(w[2]), "v"(w[3])); c = (f32x4){c0, c1, c2, c3}; }
__device__ __forceinline__ void fmac_next4(f32x4& c, const f32x4 s, const f32x4 w) { float c0 = c[0], c1 = c[1], c2 = c[2], c3 = c[3];
    asm volatile(FMAC_DPP4(15) : "+v"(c0), "+v"(c1), "+v"(c2), "+v"(c3) : "v"(s[0]), "v"(s[1]), "v"(s[2]), "v"(s[3]), "v"(w[0]), "v"(w[1]), "v"(w[2]), "v"(w[3])); c = (f32x4){c0, c1, c2, c3}; }
__device__ __forceinline__ float silu_mul(float g, float v) { const float e = __builtin_amdgcn_exp2f(-g * LOG2E); return g * __builtin_amdgcn_rcpf(1.0f + e) * v; }
__device__ __forceinline__ int cond_of_row(int row) { return row < NCTX ? 0 : 1 + ((row - NCTX) >> 12); }

namespace pg8 {
constexpr int BM = 256, BK = 64, HALF = 128, HTB = HALF * BK * 2, NXCD = 8, WGM = 8;
__device__ __forceinline__ int lds_byte(int r, int c) { const int st = (r >> 4) * 2 + (c >> 5), rr = r & 15, cc = c & 31, ob = rr * 64 + cc * 2; return st * 1024 + (ob ^ (((ob >> 9) & 1) << 5)); }
__device__ __forceinline__ void stage_rc(int b, int& R, int& C) { const int st = b / 1024, sb = b % 1024, swz = sb ^ (((sb >> 9) & 1) << 5); R = (st >> 1) * 16 + swz / 64; C = (st & 1) * 32 + (swz % 64) / 2; }
__device__ __forceinline__ int perm32(int rho) { const int n = rho >> 4, i = rho & 15; return 8 * (i >> 2) + 4 * n + (i & 3); }

struct Unit { int pm, pn, half; };
struct Gemm { const char* A; const char* Bt; int lda, ldb, K, nM, nN, amod, akoff; size_t bstride; int bmod = 1 << 30; size_t bstride2 = 0; int bperm = 0; int bkc = 16; };
__device__ __forceinline__ const char* aptr(const Gemm& g, const Unit& u) { return g.A + (size_t)(u.pm % g.amod) * (size_t)512 * g.lda + (size_t)u.pn * g.akoff; }
__device__ __forceinline__ const char* bptr(const Gemm& g, const Unit& u) {
    if (g.bperm) return g.Bt + (size_t)((u.pn >> 4) * 4096 + 4 * (u.pn & 15)) * (size_t)2 * g.ldb;
    return g.Bt + (size_t)(u.pm / g.bmod) * g.bstride + (size_t)(u.pm % g.bmod) * g.bstride2 + (size_t)u.pn * (size_t)512 * g.ldb; }

struct Order {
    int nM, nN, nwg, G, c, lo, hi;
    __device__ __forceinline__ void init(int nM_, int nN_, int G_, int c_) { nM = nM_; nN = nN_; nwg = nM * nN; G = G_; c = c_; lo = 0; hi = nwg; }
    __device__ __forceinline__ bool next(int i, Unit& u) const {
        const long L = (long)lo + (long)i * G + c; if (L >= hi) return false;
        int wgid = (int)L; u.half = 0; { const int q = nwg / NXCD, r = nwg % NXCD, xcd = wgid % NXCD, off = wgid / NXCD; wgid = (xcd < r ? xcd * (q + 1) : r * (q + 1) + (xcd - r) * q) + off; }
        const int nig = WGM * nN, gid = wgid / nig, fm = gid * WGM, gsz = (nM - fm) < WGM ? (nM - fm) : WGM;
        u.pm = fm + ((wgid % nig) % gsz); u.pn = (wgid % nig) / gsz; return true;
    }
};


struct EpiRes {
    static constexpr bool PERM = false;
    const float* src0; const float* src1; float* dst; const float* gate; const float* pscale; int pm0; int rowmap;
    __device__ __forceinline__ void operator()(f32x4 (&acc)[2][2][4][2], const Unit& u, int wr, int wc, int fr, int fq, LAS unsigned char*) const {
        asm volatile("" : "+v"(fr), "+v"(fq), "+s"(wr), "+s"(wc));

        const int rowt = rowmap ? NCTX + (u.pm >> 4) * 4096 + 4 * (u.pm & 15) : (pm0 + u.pm) * BM; const float* g = gate + (size_t)cond_of_row(rowt) * NMOD;
        const int col0 = u.pn * BM + wc * 32 + 4 * fq;
        f32x4 gv[2][2];
#pragma unroll
        for (int bj = 0; bj < 2; ++bj)
#pragma unroll
            for (int n = 0; n < 2; ++n) { gv[bj][n] = *(const f32x4*)(g + col0 + bj * HALF + n * 16); if (pscale) gv[bj][n] = gv[bj][n] * *(const f32x4*)(pscale + col0 + bj * HALF + n * 16); }
#pragma unroll
        for (int ai = 0; ai < 2; ++ai) { if (u.half == 2 - ai) continue;
#pragma unroll
            for (int m = 0; m < 4; ++m) {
                const int row = rowmap ? rowt + 2 * ai + wr + 64 * (16 * m + fr) : rowt + ai * HALF + wr * 64 + m * 16 + fr;
                const float* s = (row < NCTX ? src0 + (size_t)row * DM : src1 + (size_t)(row - NCTX) * DM) + col0; float* d = dst + (size_t)row * DM + col0;
#pragma unroll
                for (int bj = 0; bj < 2; ++bj)
#pragma unroll
                    for (int n = 0; n < 2; ++n) { const f32x4 xv = *(const f32x4*)(s + bj * HALF + n * 16); *(f32x4*)(d + bj * HALF + n * 16) = xv + gv[bj][n] * acc[ai][bj][m][n]; }
            } }
    }
};

struct EpiQKV {
    static constexpr bool PERM = false;
    bf16_t* Q; bf16_t* Kb; bf16_t* VT; float* ock; float* ocv; const float* qn; const float* kn; const float* ropec; const float* ropes;
    __device__ __forceinline__ void operator()(f32x4 (&acc)[2][2][4][2], const Unit& u, int wr, int wc, int fr, int fq, LAS unsigned char*) const {
        asm volatile("" : "+v"(fr), "+v"(fq), "+s"(wr), "+s"(wc));

        const int rowt = u.pm * BM; const bool lat = rowt >= NCTX; const int dl = 4 * fq;
        if (u.pn < 5) {
            const bool isq = u.pn < 4; const float* nw = isq ? qn : kn;
            f32x4 nwv[2][2];
#pragma unroll
            for (int bj = 0; bj < 2; ++bj)
#pragma unroll
                for (int n = 0; n < 2; ++n) nwv[bj][n] = *(const f32x4*)(nw + 32 * bj + 16 * n + dl);
#pragma unroll
            for (int ai = 0; ai < 2; ++ai)
#pragma unroll
                for (int m = 0; m < 4; ++m) {
                    const int row = rowt + ai * HALF + wr * 64 + m * 16 + fr;
                    float ss = 0.f;
#pragma unroll
                    for (int bj = 0; bj < 2; ++bj)
#pragma unroll
                        for (int n = 0; n < 2; ++n) { const f32x4 v = acc[ai][bj][m][n]; ss += (v[0] * v[0] + v[1] * v[1]) + (v[2] * v[2] + v[3] * v[3]); }
                    ss += __shfl_xor(ss, 16); ss += __shfl_xor(ss, 32);
                    const float rstd = 1.0f / sqrtf(ss * (1.0f / 64.0f) + 1e-6f);
                    f32x4 y[2][2];
#pragma unroll
                    for (int bj = 0; bj < 2; ++bj)
#pragma unroll
                        for (int n = 0; n < 2; ++n) y[bj][n] = acc[ai][bj][m][n] * rstd * nwv[bj][n];
                    if (!isq && !lat) {
                        float* p = ock + (size_t)(row >> 8) * 131072 + (size_t)(row & 255) * 256 + wc * 64 + dl;
#pragma unroll
                        for (int bj = 0; bj < 2; ++bj)
#pragma unroll
                            for (int n = 0; n < 2; ++n) *(f32x4*)(p + 32 * bj + 16 * n) = y[bj][n];
                    }
                    if (lat) {
                        const int lr = row - NCTX, pr = (lr & 4095) >> 6, pc = lr & 63;
#pragma unroll
                        for (int bj = 0; bj < 2; ++bj) {
                            const int pos = bj ? pc : pr;
                            const f32x4 c4 = *(const f32x4*)(ropec + pos * 16 + dl), s4 = *(const f32x4*)(ropes + pos * 16 + dl);
                            const f32x4 x1 = y[bj][0], x2 = y[bj][1];
                            y[bj][0] = x1 * c4 - x2 * s4; y[bj][1] = x1 * s4 + x2 * c4;
                        }
                    }
                    bf16_t* dstp;
                    if (isq) { dstp = Q + (size_t)row * DM + (4 * u.pn + wc) * 64 + dl;
#pragma unroll
                        for (int bj = 0; bj < 2; ++bj)
#pragma unroll
                            for (int n = 0; n < 2; ++n) y[bj][n] = y[bj][n] * QSCALE;
                    } else dstp = Kb + (size_t)row * K_LD + wc * 64 + dl;
#pragma unroll
                    for (int bj = 0; bj < 2; ++bj)
#pragma unroll
                        for (int n = 0; n < 2; ++n) { u32x2 w; w.x = cvtpk(y[bj][n][0], y[bj][n][1]); w.y = cvtpk(y[bj][n][2], y[bj][n][3]); *(u32x2*)(dstp + 32 * bj + 16 * n) = w; }
                }
        } else {
#pragma unroll
            for (int ai = 0; ai < 2; ++ai)
#pragma unroll
                for (int m = 0; m < 4; ++m) {
                    const int row = rowt + ai * HALF + wr * 64 + m * 16 + fr;
                    if (!lat) {
                        float* p = ocv + (size_t)(row >> 8) * 131072 + (size_t)(row & 255) * 256 + wc * 64 + dl;
#pragma unroll
                        for (int bj = 0; bj < 2; ++bj)
#pragma unroll
                            for (int n = 0; n < 2; ++n) *(f32x4*)(p + 32 * bj + 16 * n) = acc[ai][bj][m][n];
                    }
                    size_t sb; int pos, L;
                    if (lat) { const int lr = row - NCTX; sb = VT_LAT_BASE + (size_t)(lr >> 12) * VT_LAT_SEQ; pos = lr & 4095; L = VT_LDL; } else { sb = (size_t)(row >> 8) * VT_CTX_SEQ; pos = row & 255; L = VT_LDC; }
                    const int k16 = pos & 15, pp = (pos & ~15) + 8 * ((k16 >> 2) & 1) + (k16 & 3) + 4 * (k16 >> 3);
                    bf16_t* base = VT + sb + (size_t)(wc * 64 + dl) * L + pp;
#pragma unroll
                    for (int bj = 0; bj < 2; ++bj)
#pragma unroll
                        for (int n = 0; n < 2; ++n)
#pragma unroll
                            for (int e = 0; e < 4; ++e) base[(size_t)(32 * bj + 16 * n + e) * L] = f2bf(acc[ai][bj][m][n][e]);
                }
        }
    }
};

struct EpiChan {
    static constexpr bool PERM = true;
    bf16_t* PT; int lat;
    __device__ __forceinline__ void operator()(f32x4 (&acc)[2][2][4][2], const Unit& u, int wr, int wc, int fr, int fq, LAS unsigned char*) const {
        asm volatile("" : "+v"(fr), "+v"(fq), "+s"(wr), "+s"(wc));
#pragma unroll
        for (int ai = 0; ai < 2; ++ai)
#pragma unroll
            for (int m = 0; m < 4; ++m) {
                const int row = u.pm * BM + ai * HALF + wr * 64 + m * 16 + fr, part = row >> 10, n_ = row & 1023;
#pragma unroll
                for (int bj = 0; bj < 2; ++bj) {
                    bf16_t* d;
                    if (lat) d = PT + (size_t)(u.pn >> 4) * (1024 * 8192) + (size_t)n_ * 8192 + (4 * (u.pn & 15) + 2 * bj + (wc >> 1)) * 128 + part * 64 + (wc & 1) * 32 + 8 * fq;
                    else d = PT + (size_t)u.pn * (256 * 2048) + (size_t)n_ * 512 + part * 256 + bj * HALF + wc * 32 + 8 * fq;
                    const f32x4 v0 = acc[ai][bj][m][0], v1 = acc[ai][bj][m][1]; u32x4 w; w.x = cvtpk(v0[0], v0[1]); w.y = cvtpk(v0[2], v0[3]); w.z = cvtpk(v1[0], v1[1]); w.w = cvtpk(v1[2], v1[3]); *(u32x4*)d = w; }
            }
    }
};

struct EpiY1 {
    static constexpr bool PERM = true;
    bf16_t* YT;
    __device__ __forceinline__ void operator()(f32x4 (&acc)[2][2][4][2], const Unit& u, int wr, int wc, int fr, int fq, LAS unsigned char*) const {
        asm volatile("" : "+v"(fr), "+v"(fq), "+s"(wr), "+s"(wc));
#pragma unroll
        for (int ai = 0; ai < 2; ++ai)
#pragma unroll
            for (int m = 0; m < 4; ++m) {
                bf16_t* d = YT + (size_t)(u.pm * BM + ai * HALF + wr * 64 + m * 16 + fr) * 8192 + u.pn * BM + wc * 32 + 8 * fq;
#pragma unroll
                for (int bj = 0; bj < 2; ++bj) { const f32x4 v0 = acc[ai][bj][m][0], v1 = acc[ai][bj][m][1]; u32x4 w; w.x = cvtpk(v0[0], v0[1]); w.y = cvtpk(v0[2], v0[3]); w.z = cvtpk(v1[0], v1[1]); w.w = cvtpk(v1[2], v1[3]); *(u32x4*)(d + bj * HALF) = w; }
            }
    }
};

struct EpiFfn1 {
    static constexpr bool PERM = true;
    bf16_t* Aout; float* hal; const float* cw; const float* cb;
    __device__ __forceinline__ void operator()(f32x4 (&acc)[2][2][4][2], const Unit& u, int wr, int wc, int fr, int fq, LAS unsigned char* xl) const {
        asm volatile("" : "+v"(fr), "+v"(fq), "+s"(wr), "+s"(wc));

        LAS float* X = (LAS float*)xl;
        const int chl = wc * 32 + 8 * fq;
        LAS float* WL = (LAS float*)(xl + 9216);
        { const int t2 = (wr * 4 + wc) * 64 + fq * 16 + fr;
#pragma unroll
            for (int q = 0; q < 2; ++q) { const int idx = t2 + 512 * q, k = idx >> 8, c = idx & 255, col = (c >> 7) * DFF + u.pn * 128 + (c & 127); WL[idx] = (k < 3) ? cw[(size_t)k * DFF2 + col] : cb[col]; } }
#pragma unroll
        for (int ai = 0; ai < 2; ++ai) { const int blk = 2 * ai + wr;
            if (fr == 0) {
#pragma unroll
                for (int bj = 0; bj < 2; ++bj)
#pragma unroll
                    for (int n = 0; n < 2; ++n) *(LAS f32x4*)(X + ((blk * 2 + 0) * 2 + bj) * 128 + chl + 4 * n) = acc[ai][bj][0][n]; }
            if (fr == 15) {
#pragma unroll
                for (int bj = 0; bj < 2; ++bj)
#pragma unroll
                    for (int n = 0; n < 2; ++n) *(LAS f32x4*)(X + ((blk * 2 + 1) * 2 + bj) * 128 + chl + 4 * n) = acc[ai][bj][3][n]; }
        }
        { float* hp = hal + (size_t)u.pm * 4 * DFF2 + u.pn * 128 + chl;
            if (wr == 0 && fr < 2) {
#pragma unroll
                for (int bj = 0; bj < 2; ++bj)
#pragma unroll
                    for (int n = 0; n < 2; ++n) *(f32x4*)(hp + (size_t)fr * DFF2 + bj * DFF + 4 * n) = acc[0][bj][0][n]; }
            if (wr == 1 && fr >= 14) {
#pragma unroll
                for (int bj = 0; bj < 2; ++bj)
#pragma unroll
                    for (int n = 0; n < 2; ++n) *(f32x4*)(hp + (size_t)(fr - 12) * DFF2 + bj * DFF + 4 * n) = acc[1][bj][3][n]; }
        }
        asm volatile("s_waitcnt lgkmcnt(0)" ::: "memory"); __builtin_amdgcn_s_barrier(); asm volatile("" ::: "memory");
        const f32x4 z4 = {0.f, 0.f, 0.f, 0.f};
        const float f0 = fr == 0 ? 1.f : 0.f, f15 = fr == 15 ? 1.f : 0.f, n0 = 1.f - f0, n15 = 1.f - f15;
#pragma unroll
        for (int n = 0; n < 2; ++n) {
            const LAS float* wl = WL + chl + 4 * n;
#define CW_(k, bj) (*(const LAS f32x4*)(wl + (k) * 256 + (bj) * 128))
            f32x4 w0n[2], w0f[2], w2n[2], w2f[2];
#pragma unroll
            for (int bj = 0; bj < 2; ++bj) { const f32x4 a0 = CW_(0, bj), a2 = CW_(2, bj); w0n[bj] = a0 * n0; w0f[bj] = a0 * f0; w2n[bj] = a2 * n15; w2f[bj] = a2 * f15; }
#pragma unroll
            for (int ai = 0; ai < 2; ++ai) { const int blk = 2 * ai + wr;
#pragma unroll
                for (int m = 0; m < 4; ++m) {
                    f32x4 cv[2];
#pragma unroll
                    for (int bj = 0; bj < 2; ++bj) {
                        const f32x4 cur = acc[ai][bj][m][n];
                        f32x4 c = CW_(1, bj) * cur + CW_(3, bj);
                        fmac_prev4(c, cur, w0n[bj]);
                        fmac_next4(c, cur, w2n[bj]);
                        if (m > 0) fmac_prev4(c, acc[ai][bj][m > 0 ? m - 1 : 0][n], w0f[bj]);
                        else c = (blk > 0 ? *(LAS f32x4*)(X + (((blk - 1) * 2 + 1) * 2 + bj) * 128 + chl + 4 * n) : z4) * w0f[bj] + c;
                        if (m < 3) fmac_next4(c, acc[ai][bj][m < 3 ? m + 1 : 3][n], w2f[bj]);
                        else c = (blk < 3 ? *(LAS f32x4*)(X + (((blk + 1) * 2 + 0) * 2 + bj) * 128 + chl + 4 * n) : z4) * w2f[bj] + c;
                        cv[bj] = c;
                    }
                    u32x2 w; w.x = cvtpk(silu_mul(cv[0][0], cv[1][0]), silu_mul(cv[0][1], cv[1][1])); w.y = cvtpk(silu_mul(cv[0][2], cv[1][2]), silu_mul(cv[0][3], cv[1][3]));
                    *(u32x2*)(Aout + (size_t)(u.pm * BM + ai * HALF + wr * 64 + m * 16 + fr) * DFF + u.pn * 128 + chl + 4 * n) = w;
                }
            }
#undef CW_
        }
    }
};

template <class Epi, int HM = 0>
__device__ __forceinline__ void gemm_phase(LAS unsigned char* lds, LAS unsigned char* xl, const Gemm g, const Order& S, const Epi& E, const int tid) {
    const int wid = __builtin_amdgcn_readfirstlane(tid >> 6), lane = tid & 63, wr = wid >> 2, wc = wid & 3, fr = lane & 15, fq = lane >> 4;
    const int nt = g.K / BK;
    unsigned voffA[2], voffB[2];
#pragma unroll
    for (int i = 0; i < 2; ++i) { int R, C; stage_rc(tid * 16 + i * 8192, R, C); const int Rb = Epi::PERM ? ((R & ~31) + perm32(R & 31)) : R;
        const int Rt = g.bperm ? 64 * (Rb & 63) + (Rb >> 6) : Rb;
        voffA[i] = (unsigned)(R * g.lda + C) * 2u; voffB[i] = (unsigned)(Rt * g.ldb) * 2u + (unsigned)((C >> 3) * g.bkc); }
    const size_t kstep = (size_t)(BK * 2), kstepB = (size_t)(8 * g.bkc);
    const size_t hA = (size_t)HALF * g.lda * 2, hB = g.bperm ? (size_t)4 * g.ldb : (size_t)HALF * g.ldb * 2;
    const unsigned ldsw = (unsigned)wid * 1024u;
    const int aoff = lds_byte(wr * 64 + fr, fq * 8), boff = lds_byte(wc * 32 + fr, fq * 8);
#define PG8_SA(b, h) (((b) * 2 + (h)) * HTB)
#define PG8_SB(b, h) ((4 + (b) * 2 + (h)) * HTB)
#define PG8_STAGE(bufoff, gbase, voff) do { _Pragma("unroll") for (int _i = 0; _i < 2; ++_i) \
        __builtin_amdgcn_global_load_lds((const unsigned*)((const char*)(gbase) + (voff)[_i]), (LAS unsigned*)(lds + (bufoff) + ldsw + _i * 8192), 16, 0, 0); } while (0)
#define PG8_LDA(dst, b, h) do { _Pragma("unroll") for (int m = 0; m < 4; ++m) _Pragma("unroll") for (int k = 0; k < 2; ++k) dst[m][k] = *(const LAS bf16x8*)(lds + PG8_SA(b, h) + aoff + m * 2048 + k * 1024); } while (0)
#define PG8_LDB(dst, b, h) do { _Pragma("unroll") for (int n = 0; n < 2; ++n) _Pragma("unroll") for (int k = 0; k < 2; ++k) dst[n][k] = *(const LAS bf16x8*)(lds + PG8_SB(b, h) + boff + n * 2048 + k * 1024); } while (0)
#define PG8_MMA(ai, bj, At, Bt) do { __builtin_amdgcn_s_setprio(1); _Pragma("unroll") for (int m = 0; m < 4; ++m) _Pragma("unroll") for (int n = 0; n < 2; ++n) _Pragma("unroll") for (int k = 0; k < 2; ++k) \
        acc[ai][bj][m][n] = __builtin_amdgcn_mfma_f32_16x16x32_bf16(Bt[n][k], At[m][k], acc[ai][bj][m][n], 0, 0, 0); __builtin_amdgcn_s_setprio(0); } while (0)
#define PG8_WAIT_V(n) asm volatile("s_waitcnt vmcnt(" #n ")" ::: "memory")
#define PG8_WAIT_L(n) asm volatile("s_waitcnt lgkmcnt(" #n ")" ::: "memory")
#define PG8_BAR __builtin_amdgcn_s_barrier()
#define PG8_SCHED __builtin_amdgcn_sched_barrier(0)
    Unit cur, nxt; int ui = 0;
    if (!S.next(0, cur)) return;
    f32x4 acc[2][2][4][2];
#pragma unroll
    for (int a = 0; a < 2; ++a)
#pragma unroll
        for (int b = 0; b < 2; ++b)
#pragma unroll
            for (int m = 0; m < 4; ++m)
#pragma unroll
                for (int n = 0; n < 2; ++n) acc[a][b][m][n] = (f32x4){0.f, 0.f, 0.f, 0.f};
    bf16x8 At[4][2], B0[2][2], B1[2][2];
    const char* cA = aptr(g, cur); const char* cB = bptr(g, cur);
    PG8_STAGE(PG8_SB(0, 0), cB, voffB); PG8_STAGE(PG8_SB(0, 1), cB + hB, voffB); PG8_STAGE(PG8_SA(0, 0), cA, voffA); PG8_STAGE(PG8_SA(0, 1), cA + hA, voffA);
    if (wr == 1) PG8_BAR;
    PG8_WAIT_V(2); PG8_BAR;
    PG8_STAGE(PG8_SB(1, 0), cB + kstepB, voffB); PG8_STAGE(PG8_SA(1, 0), cA + kstep, voffA); PG8_STAGE(PG8_SB(1, 1), cB + hB + kstepB, voffB);
    PG8_WAIT_V(6); PG8_BAR;
    for (;;) {
        const bool has_next = S.next(ui + 1, nxt);
        const char* nA = has_next ? aptr(g, nxt) : cA; const char* nB = has_next ? bptr(g, nxt) : cB;
        for (int t = 0; t < nt; t += 2) {
            const bool last = (t == nt - 2);
            const char* a1 = cA + (size_t)(t + 1) * kstep;
            const char* a2 = last ? nA : cA + (size_t)(t + 2) * kstep; const char* b2 = last ? nB : cB + (size_t)(t + 2) * kstepB;
            const char* a3 = a2 + kstep; const char* b3 = b2 + kstepB;
            PG8_LDB(B0, 0, 0); PG8_LDB(B1, 0, 1); PG8_SCHED; PG8_LDA(At, 0, 0); PG8_STAGE(PG8_SA(1, 1), a1 + hA, voffA);
            PG8_WAIT_V(8); PG8_WAIT_L(0); PG8_BAR; if constexpr (HM != 2) { PG8_MMA(0, 0, At, B0); PG8_MMA(0, 1, At, B1); } PG8_BAR; PG8_SCHED;
            PG8_LDA(At, 0, 1); PG8_STAGE(PG8_SB(0, 0), b2, voffB); PG8_STAGE(PG8_SB(0, 1), b2 + hB, voffB); PG8_STAGE(PG8_SA(0, 0), a2, voffA);
            PG8_WAIT_V(8); PG8_WAIT_L(0); PG8_BAR; if constexpr (HM != 1) { PG8_MMA(1, 0, At, B0); PG8_MMA(1, 1, At, B1); } PG8_BAR; PG8_SCHED;
            PG8_LDB(B0, 1, 0); PG8_LDB(B1, 1, 1); PG8_SCHED; PG8_LDA(At, 1, 0); PG8_STAGE(PG8_SA(0, 1), a2 + hA, voffA);
            PG8_WAIT_V(8); PG8_WAIT_L(0); PG8_BAR; if constexpr (HM != 2) { PG8_MMA(0, 0, At, B0); PG8_MMA(0, 1, At, B1); } PG8_BAR; PG8_SCHED;
            PG8_LDA(At, 1, 1); PG8_STAGE(PG8_SB(1, 0), b3, voffB); PG8_STAGE(PG8_SB(1, 1), b3 + hB, voffB); PG8_STAGE(PG8_SA(1, 0), a3, voffA);
            PG8_WAIT_V(8); PG8_WAIT_L(0); PG8_BAR; if constexpr (HM != 1) { PG8_MMA(1, 0, At, B0); PG8_MMA(1, 1, At, B1); } PG8_BAR; PG8_SCHED;
        }
        if (wr == 0) PG8_BAR;
        cur.half = HM; E(acc, cur, wr, wc, fr, fq, xl);
        if (!has_next) break;
#pragma unroll
        for (int a = 0; a < 2; ++a)
#pragma unroll
            for (int b = 0; b < 2; ++b)
#pragma unroll
                for (int m = 0; m < 4; ++m)
#pragma unroll
                    for (int n = 0; n < 2; ++n) acc[a][b][m][n] = (f32x4){0.f, 0.f, 0.f, 0.f};
        cur = nxt; cA = nA; cB = nB; ++ui;
        if (wr == 1) PG8_BAR;
    }
    PG8_WAIT_V(0);
    PG8_BAR;
#undef PG8_SA
#undef PG8_SB
#undef PG8_STAGE
#undef PG8_LDA
#undef PG8_LDB
#undef PG8_MMA
#undef PG8_WAIT_V
#undef PG8_WAIT_L
#undef PG8_BAR
#undef PG8_SCHED
}
}


#define XB_TMO      128
#define XB_XCNT(j)  (256  + 64 * (j))
#define XB_XSUB(j)  (1280 + 64 * (j))
#define XB_XGEN(j)  (2304 + 64 * (j))
#define XB_TOP      3328
#define XB_TOPGEN   3392
#define XCD_BAR_WORDS 3456
#define XB_SPIN_CAP (1u << 18)
__device__ __forceinline__ unsigned xb_ld(unsigned* p)              { return __hip_atomic_load(p, __ATOMIC_RELAXED, __HIP_MEMORY_SCOPE_AGENT); }
__device__ __forceinline__ unsigned xb_add(unsigned* p, unsigned v) { return __hip_atomic_fetch_add(p, v, __ATOMIC_RELAXED, __HIP_MEMORY_SCOPE_AGENT); }
__device__ __forceinline__ unsigned xb_xcc_id() { return (unsigned)__builtin_amdgcn_s_getreg((3 << 11) | 20) & 0xFu; }
#define XB_SPIN(cond, bar) do { unsigned _sp = 0; while (cond) { __builtin_amdgcn_s_sleep(1); \
    if ((++_sp & 255u) == 0u) { if (xb_ld(&(bar)[XB_TMO])) break; if (_sp > XB_SPIN_CAP) { atomicAdd(&(bar)[XB_TMO], 1u); break; } } } } while (0)
__device__ __forceinline__ void xcd_barrier_complete(unsigned* bar, unsigned x, unsigned& nloc, unsigned& nx) {
    const unsigned G = gridDim.x * gridDim.y * gridDim.z;
    unsigned sum, cnt, mine, sp = 0u;
    for (;;) {
        sum = 0u; cnt = 0u; mine = 0u;
#pragma unroll
        for (unsigned j = 0; j < 16; ++j) { const unsigned c = xb_ld(&bar[XB_XCNT(j)]); sum += c; cnt += (c > 0u) ? 1u : 0u; mine = (j == x) ? c : mine; }
        if (sum == G) break;
        __builtin_amdgcn_s_sleep(1);
        if ((++sp & 255u) == 0u) { if (xb_ld(&bar[XB_TMO])) break; if (sp > XB_SPIN_CAP) { atomicAdd(&bar[XB_TMO], 1u); break; } }
    }
    nloc = mine > 0u ? mine : 1u; nx = cnt > 0u ? cnt : 1u;
}
__device__ __forceinline__ void xcd_barrier(unsigned* bar, unsigned x, volatile LAS unsigned* st) {
    asm volatile("s_waitcnt vmcnt(0)" ::: "memory");
    __syncthreads();
    if (threadIdx.x == 0) {
        __builtin_amdgcn_s_waitcnt(0);
        unsigned nloc = st[0], nx = st[1];
        if (nloc == 0u) { xcd_barrier_complete(bar, x, nloc, nx); st[0] = nloc; st[1] = nx; }
        const unsigned old = xb_add(&bar[XB_XSUB(x)], 1u);
        const unsigned gen = old / nloc;
        if (old + 1u == (gen + 1u) * nloc) {
            __builtin_amdgcn_fence(__ATOMIC_RELEASE, "agent");
            asm volatile("s_waitcnt vmcnt(0)" ::: "memory");
            const unsigned og = xb_add(&bar[XB_TOP], 1u);
            const unsigned tg = og / nx;
            if (og + 1u == (tg + 1u) * nx) xb_add(&bar[XB_TOPGEN], 1u);
            else XB_SPIN(xb_ld(&bar[XB_TOPGEN]) == tg, bar);
            __builtin_amdgcn_fence(__ATOMIC_ACQUIRE, "agent");
            xb_add(&bar[XB_XGEN(x)], 1u);
            asm volatile("s_waitcnt vmcnt(0)" ::: "memory");
        } else {
            XB_SPIN(xb_ld(&bar[XB_XGEN(x)]) == gen, bar);
            __builtin_amdgcn_fence(__ATOMIC_ACQUIRE, "agent");
            asm volatile("s_waitcnt vmcnt(0)" ::: "memory");
        }
    }
    __syncthreads();
}

#define MFMA32(a, b, c) __builtin_amdgcn_mfma_f32_32x32x16_bf16((a), (b), (c), 0, 0, 0)
__device__ __forceinline__ int crow(int r, int hi) { return (r & 3) + 8 * (r >> 2) + 4 * hi; }

__device__ __forceinline__ void attn_phase(bf16_t* Q, const bf16_t* Kb, const bf16_t* VT, const bf16_t* CK, const bf16_t* CVT, const float* sink, int j, int vcu, int G, int wave, int lane) {
    const int r = lane & 31, h = lane >> 5;
    for (int u = vcu; u < 1280; u += G) {
        const bool lat = u < 1024;
        int b, kvh, qb, L, seqrow;
        if (lat) { b = u >> 7; kvh = (u >> 5) & 3; qb = u & 31; L = 4096; seqrow = NCTX + b * 4096; }
        else { const int v = u - 1024; b = v >> 3; kvh = (v >> 1) & 3; qb = v & 1; L = 256; seqrow = b * 256; }
        const int hq = kvh * 4 + (wave & 3), t0 = qb * 128 + (wave >> 2) * 64;
        bf16_t* Qp = Q + (size_t)(seqrow + t0) * DM + hq * 64;
        bf16x8 qf[2][4];
#pragma unroll
        for (int qi = 0; qi < 2; ++qi)
#pragma unroll
            for (int ks = 0; ks < 4; ++ks) qf[qi][ks] = *(const bf16x8*)(Qp + (size_t)(qi * 32 + r) * DM + ks * 16 + h * 8);
        const float m0 = sink[hq] * LOG2E;
        float mrow[2] = {m0, m0}, lrow[2] = {h == 0 ? 1.f : 0.f, h == 0 ? 1.f : 0.f};
        f32x16 O[2][2];
#pragma unroll
        for (int qi = 0; qi < 2; ++qi)
#pragma unroll
            for (int db = 0; db < 2; ++db)
#pragma unroll
                for (int i = 0; i < 16; ++i) O[qi][db][i] = 0.f;
        const int nseg = lat ? 2 : 1;
        for (int seg = 0; seg < nseg; ++seg) {
            const bf16_t* kb; const bf16_t* vb; int ldv, klo, khi; bool mask;
            if (seg == 0) { kb = Kb + (size_t)seqrow * K_LD + kvh * 64; ldv = lat ? VT_LDL : VT_LDC; vb = VT + (lat ? VT_LAT_BASE + (size_t)b * VT_LAT_SEQ : (size_t)b * VT_CTX_SEQ) + (size_t)kvh * 64 * ldv;
                if (lat) { klo = t0 - 128 < 0 ? 0 : t0 - 128; khi = t0 + 192 > L ? L : t0 + 192; mask = true; } else { klo = 0; khi = 256; mask = false; } }
            else { kb = CK + (size_t)(b * 2 + j) * 512 * K_LD + kvh * 64; vb = CVT + (size_t)((b * 2 + j) * 4 + kvh) * 64 * CVT_LD; ldv = CVT_LD; klo = 0; khi = 512; mask = false; }
            bf16x8 kf[4];
#pragma unroll
            for (int ks = 0; ks < 4; ++ks) kf[ks] = *(const bf16x8*)(kb + (size_t)(klo + r) * K_LD + ks * 16 + h * 8);
            bf16x8 vf[2][2];
#pragma unroll
            for (int db = 0; db < 2; ++db)
#pragma unroll
                for (int s = 0; s < 2; ++s) vf[db][s] = *(const bf16x8*)(vb + (size_t)(db * 32 + r) * ldv + klo + s * 16 + h * 8);
            for (int key = klo; key < khi; key += 32) {
                bf16x8 kn[4], vn[2][2];
                const int keyn = (key + 32 < khi) ? key + 32 : key;
#pragma unroll
                for (int db = 0; db < 2; ++db)
#pragma unroll
                    for (int s = 0; s < 2; ++s) vn[db][s] = *(const bf16x8*)(vb + (size_t)(db * 32 + r) * ldv + keyn + s * 16 + h * 8);
#pragma unroll
                for (int ks = 0; ks < 4; ++ks) kn[ks] = *(const bf16x8*)(kb + (size_t)(keyn + r) * K_LD + ks * 16 + h * 8);
                f32x16 S[2];
#pragma unroll
                for (int qi = 0; qi < 2; ++qi) {
#pragma unroll
                    for (int i = 0; i < 16; ++i) S[qi][i] = 0.f;
#pragma unroll
                    for (int ks = 0; ks < 4; ++ks) S[qi] = MFMA32(kf[ks], qf[qi][ks], S[qi]);
                }
                if (mask) {
#pragma unroll
                    for (int qi = 0; qi < 2; ++qi) { const int t = t0 + qi * 32 + r;
#pragma unroll
                        for (int i = 0; i < 16; ++i) { const int d = t - (key + crow(i, h)); if (d > 128 || d < -128) S[qi][i] = -1e30f; } }
                }
#pragma unroll
                for (int qi = 0; qi < 2; ++qi) {
                    float tm = S[qi][0];
#pragma unroll
                    for (int i = 1; i < 16; ++i) tm = fmaxf(tm, S[qi][i]);
                    tm = fmaxf(tm, __shfl_xor(tm, 32));
                    const float mn = fmaxf(mrow[qi], tm), alpha = __builtin_amdgcn_exp2f(mrow[qi] - mn);
                    mrow[qi] = mn;
                    float ps = 0.f;
#pragma unroll
                    for (int i = 0; i < 16; ++i) { S[qi][i] = __builtin_amdgcn_exp2f(S[qi][i] - mn); ps += S[qi][i]; }
                    lrow[qi] = lrow[qi] * alpha + ps;
#pragma unroll
                    for (int db = 0; db < 2; ++db)
#pragma unroll
                        for (int i = 0; i < 16; ++i) O[qi][db][i] *= alpha;
                    bf16x8 pk[2];
#pragma unroll
                    for (int s = 0; s < 2; ++s) { u32x4 w; w.x = cvtpk(S[qi][8 * s], S[qi][8 * s + 1]); w.y = cvtpk(S[qi][8 * s + 2], S[qi][8 * s + 3]); w.z = cvtpk(S[qi][8 * s + 4], S[qi][8 * s + 5]); w.w = cvtpk(S[qi][8 * s + 6], S[qi][8 * s + 7]); pk[s] = __builtin_bit_cast(bf16x8, w); }
#pragma unroll
                    for (int db = 0; db < 2; ++db)
#pragma unroll
                        for (int s = 0; s < 2; ++s) O[qi][db] = MFMA32(vf[db][s], pk[s], O[qi][db]);
                }
#pragma unroll
                for (int ks = 0; ks < 4; ++ks) kf[ks] = kn[ks];
#pragma unroll
                for (int db = 0; db < 2; ++db)
#pragma unroll
                    for (int s = 0; s < 2; ++s) vf[db][s] = vn[db][s];
            }
        }
#pragma unroll
        for (int qi = 0; qi < 2; ++qi) {
            const float lt = lrow[qi] + __shfl_xor(lrow[qi], 32), inv = 1.0f / lt;
#pragma unroll
            for (int db = 0; db < 2; ++db)
#pragma unroll
                for (int g4 = 0; g4 < 4; ++g4) { u32x2 w; w.x = cvtpk(O[qi][db][4 * g4] * inv, O[qi][db][4 * g4 + 1] * inv); w.y = cvtpk(O[qi][db][4 * g4 + 2] * inv, O[qi][db][4 * g4 + 3] * inv);
                    *(u32x2*)(Qp + (size_t)(qi * 32 + r) * DM + db * 32 + 8 * g4 + 4 * h) = w; }
        }
    }
}

__device__ __forceinline__ float wave_sum(float v) {
#pragma unroll
    for (int o = 1; o < 64; o <<= 1) v += __shfl_xor(v, o);
    return v;
}
__device__ __forceinline__ void prep_phase(const float* src0, const float* src1, bf16_t* H, const float* nw, const float* mods, int shoff, int scoff, int gw, int NGW, int lane) {
    for (int row = gw; row < NTOK; row += NGW) {
        const float* s = row < NCTX ? src0 + (size_t)row * DM : src1 + (size_t)(row - NCTX) * DM;
        const float* md = mods + (size_t)cond_of_row(row) * NMOD;
        f32x4 v[4]; float ss = 0.f;
#pragma unroll
        for (int q = 0; q < 4; ++q) { v[q] = *(const f32x4*)(s + 4 * (lane + 64 * q)); ss += (v[q][0] * v[q][0] + v[q][1] * v[q][1]) + (v[q][2] * v[q][2] + v[q][3] * v[q][3]); }
        const float rstd = 1.0f / sqrtf(wave_sum(ss) * (1.0f / DM) + 1e-6f);
#pragma unroll
        for (int q = 0; q < 4; ++q) { const int c = 4 * (lane + 64 * q);
            const f32x4 g4 = *(const f32x4*)(nw + c), sc = *(const f32x4*)(md + scoff + c), sh = *(const f32x4*)(md + shoff + c);
            const f32x4 o = v[q] * rstd * g4 * (sc + 1.0f) + sh;
            u32x2 w; w.x = cvtpk(o[0], o[1]); w.y = cvtpk(o[2], o[3]); *(u32x2*)(H + (size_t)row * DM + c) = w; }
    }
}
__device__ __forceinline__ void pool_phase(const bf16_t* H, bf16_t* P, int gw, int NGW, int lane) {
    for (int row = gw; row < NTOK; row += NGW) {
        int sb, t, L;
        if (row < NCTX) { sb = row & ~255; t = row & 255; L = 256; } else { const int lr = row - NCTX; sb = NCTX + (lr & ~4095); t = lr & 4095; L = 4096; }
#pragma unroll
        for (int q = 0; q < 2; ++q) { const int c8 = lane + 64 * q, grp = c8 >> 5, hw = 1 << grp;
            int st = t - hw; if (st < 0) st = 0; int en = t + hw; if (en > L) en = L;
            float a[8];
#pragma unroll
            for (int e = 0; e < 8; ++e) a[e] = 0.f;
            for (int jr = st; jr < en; ++jr) { const u32x4 w = *(const u32x4*)(H + (size_t)(sb + jr) * DM + c8 * 8);
#pragma unroll
                for (int e = 0; e < 4; ++e) { a[2 * e] += bf2f(w[e] & 0xffffu); a[2 * e + 1] += bf2f(w[e] >> 16); } }
            const float inv = 1.0f / (float)(en - st);
            const u32x4 w = *(const u32x4*)(H + (size_t)row * DM + c8 * 8); u32x4 o;
#pragma unroll
            for (int e = 0; e < 4; ++e) o[e] = cvtpk(a[2 * e] * inv - bf2f(w[e] & 0xffffu), a[2 * e + 1] * inv - bf2f(w[e] >> 16));
            *(u32x4*)(P + (size_t)row * DM + c8 * 8) = o; }
    }
}
__device__ __forceinline__ void fix_phase(const float* hal, bf16_t* A, const float* cw, const float* cb, int gt, int GT) {
    for (int it = gt; it < 120 * 704; it += GT) {
        const int bi = it / 704, c = (it % 704) * 4, b = bi / 15, i = bi % 15 + 1, pmh = 32 + b * 16 + i;
        const float* hl = hal + (size_t)(pmh - 1) * 4 * DFF2; const float* hh = hal + (size_t)pmh * 4 * DFF2;
        f32x4 cv1[2], cv2[2];
#pragma unroll
        for (int bj = 0; bj < 2; ++bj) { const int col = bj * DFF + c;
            const f32x4 uA = *(const f32x4*)(hl + 2 * DFF2 + col), uB = *(const f32x4*)(hl + 3 * DFF2 + col), uC = *(const f32x4*)(hh + col), uD = *(const f32x4*)(hh + DFF2 + col);
            const f32x4 w0 = *(const f32x4*)(cw + col), w1 = *(const f32x4*)(cw + DFF2 + col), w2 = *(const f32x4*)(cw + 2 * DFF2 + col), bb = *(const f32x4*)(cb + col);
            cv1[bj] = w0 * uA + w1 * uB + w2 * uC + bb; cv2[bj] = w0 * uB + w1 * uC + w2 * uD + bb; }
        const size_t R = (size_t)pmh * 256;
        u32x2 w; w.x = cvtpk(silu_mul(cv1[0][0], cv1[1][0]), silu_mul(cv1[0][1], cv1[1][1])); w.y = cvtpk(silu_mul(cv1[0][2], cv1[1][2]), silu_mul(cv1[0][3], cv1[1][3]));
        *(u32x2*)(A + (R - 1) * DFF + c) = w;
        w.x = cvtpk(silu_mul(cv2[0][0], cv2[1][0]), silu_mul(cv2[0][1], cv2[1][1])); w.y = cvtpk(silu_mul(cv2[0][2], cv2[1][2]), silu_mul(cv2[0][3], cv2[1][3]));
        *(u32x2*)(A + R * DFF + c) = w;
    }
}

__device__ __forceinline__ void transpose_item(const float* W, int K, int N, bf16_t* WT, int mapkind, LAS float* scr, int item, int lane) {
    const int nblk = N / 32, kb = item / nblk, nb = item % nblk, k0 = 64 * kb, n0 = 32 * nb;
    int d0 = n0;
    if (mapkind == 1) { const int head = n0 >> 6, bj = (n0 >> 5) & 1; d0 = 256 * (head >> 2) + 128 * bj + 32 * (head & 3); }
    else if (mapkind == 2) { const int bj = n0 >= DFF ? 1 : 0, cc = n0 - bj * DFF; d0 = 256 * (cc >> 7) + 128 * bj + (cc & 127); }
#pragma unroll 32
    for (int i = 0; i < 32; ++i) { const int kk = 2 * i + (lane >> 5); scr[kk * 33 + (lane & 31)] = W[(size_t)(k0 + kk) * N + n0 + (lane & 31)]; }
    asm volatile("s_waitcnt lgkmcnt(0)" ::: "memory");
    const int c = lane & 7;
#pragma unroll
    for (int jj = 0; jj < 4; ++jj) { const int n = (lane >> 3) + 8 * jj; const LAS float* s = scr + (8 * c) * 33 + n;
        u32x4 o; o.x = cvtpk(s[0 * 33], s[1 * 33]); o.y = cvtpk(s[2 * 33], s[3 * 33]); o.z = cvtpk(s[4 * 33], s[5 * 33]); o.w = cvtpk(s[6 * 33], s[7 * 33]);
        *(u32x4*)(WT + (size_t)(d0 + n) * K + k0 + 8 * c) = o; }
    asm volatile("s_waitcnt lgkmcnt(0)" ::: "memory");
}

enum { K_PRO = 0, K_PREP1, K_PREP2, K_QKV, K_ATTN, K_WO, K_POOLP, K_POOLG, K_CHAN, K_SEQC, K_SEQL, K_FFN1, K_FIX, K_FFN2, K_ST1, K_ST2, K_FFN2X };
#ifndef PROBE_DUP
#define PROBE_DUP(X, k)
#endif
#define PROG_LIST(X) X(K_PRO,0) \
    X(K_PREP1,0) X(K_QKV,0) X(K_ATTN,0) X(K_WO,0) X(K_PREP2,0) PROBE_DUP(X, 0) X(K_FFN1,0) X(K_FIX,0) X(K_FFN2,0) \
    X(K_PREP1,1) X(K_POOLP,1) X(K_POOLG,1) X(K_PREP2,1) PROBE_DUP(X, 1) X(K_FFN1,1) X(K_FIX,1) X(K_FFN2,1) \
    X(K_PREP1,2) X(K_CHAN,2) X(K_SEQC,2) X(K_ST1,2) X(K_ST2,2) X(K_PREP2,2) PROBE_DUP(X, 2) X(K_FFN1,2) X(K_FIX,2) X(K_FFN2,2) \
    X(K_PREP1,3) X(K_QKV,3) X(K_ATTN,3) X(K_WO,3) X(K_PREP2,3) PROBE_DUP(X, 3) X(K_FFN1,3) X(K_FIX,3) X(K_FFN2,3)
#define PROG_K(k, l) k,
#define PROG_L(k, l) l,
__constant__ unsigned char PROG_KIND[] = { PROG_LIST(PROG_K) };
__constant__ unsigned char PROG_LAYER[] = { PROG_LIST(PROG_L) };
static const unsigned char H_PROG_KIND[] = { PROG_LIST(PROG_K) };
constexpr int NSTEP = (int)sizeof(H_PROG_KIND);

struct Args { const float* in[22]; float* out; unsigned char* ws; int s_lo, s_hi; };

__global__ void __launch_bounds__(512, 2) mega_fwd(Args a) {
    extern __shared__ __attribute__((aligned(16))) unsigned char lds_raw[];
    LAS unsigned char* lds = (LAS unsigned char*)lds_raw;
    LAS unsigned char* xl = lds + LDS_X;
    cg::grid_group grid = cg::this_grid();
    volatile LAS unsigned* bst = (volatile LAS unsigned*)(lds + LDS_MISC);
    unsigned* bar = (unsigned*)(a.ws + WS_CTL);
    if (threadIdx.x < 4) bst[threadIdx.x] = 0u;
    __syncthreads();
    const unsigned xcc = xb_xcc_id();
    if (threadIdx.x == 0) (void)xb_add(&bar[XB_XCNT(xcc)], 1u);
    const int G = gridDim.x, NGW = G * 8, GT = G * 512;
    unsigned char* ws = a.ws; float* out = a.out;
    float* mods = (float*)(ws + WS_MODS);
    float* ropec = (float*)(ws + WS_ROPE); float* ropes = ropec + 1024;
    bf16_t* Hb = (bf16_t*)(ws + WS_H);
    bf16_t* BIG = (bf16_t*)(ws + WS_BIG);
    bf16_t* Qb = (bf16_t*)(ws + WS_Q); bf16_t* Kbuf = (bf16_t*)(ws + WS_K); bf16_t* VTb = (bf16_t*)(ws + WS_VT);
    float* hal = (float*)(ws + WS_HAL);

    for (int s = a.s_lo; s < a.s_hi; ++s) {
        int tid = threadIdx.x, bx = blockIdx.x;
        asm volatile("" : "+v"(tid), "+s"(bx));
        const int lane = tid & 63, wave = __builtin_amdgcn_readfirstlane(tid >> 6);
        const int vcu = (G % 8 == 0) ? (bx % 8) * (G / 8) + bx / 8 : bx;
        const int gw = vcu * 8 + wave, gt = bx * 512 + tid;
        const int kind = PROG_KIND[s], layer = PROG_LAYER[s], jl = layer / 3;
        const float* xs0 = (s <= 4) ? a.in[0] : out; const float* xs1 = (s <= 4) ? a.in[1] : out + (size_t)NCTX * DM;
        const float* lmods = mods + (size_t)layer * 9 * NMOD;
        switch (kind) {
#ifndef NO_PRO
        case K_PRO: {
            LAS float* scond = (LAS float*)lds; LAS float* part = (LAS float*)(lds + 40960);
            for (int i = tid; i < 9 * 1024; i += 512) { const int cnd = i >> 10, k = i & 1023; const float v = cnd == 0 ? a.in[5][k] : a.in[4][(cnd - 1) * 1024 + k]; scond[i] = v / (1.0f + __expf(-v)); }
            __syncthreads();
            for (int item = bx; item < 384; item += G) {
                const int ly = item / 96, cb = item % 96;
                const float* w = a.in[8] + (size_t)ly * 1024 * NMOD + cb * 64 + lane;
                float ac[9];
#pragma unroll
                for (int c = 0; c < 9; ++c) ac[c] = 0.f;
                const int k0 = wave * 128;
#pragma unroll 32
                for (int kk = 0; kk < 128; ++kk) { const float wv = w[(size_t)(k0 + kk) * NMOD];
#pragma unroll
                    for (int c = 0; c < 9; ++c) ac[c] += wv * scond[c * 1024 + k0 + kk]; }
#pragma unroll
                for (int c = 0; c < 9; ++c) part[(wave * 9 + c) * 64 + lane] = ac[c];
                __syncthreads();
                for (int i = tid; i < 576; i += 512) { const int c = i >> 6, l = i & 63; float sm = a.in[9][ly * NMOD + cb * 64 + l];
#pragma unroll
                    for (int w8 = 0; w8 < 8; ++w8) sm += part[(w8 * 9 + c) * 64 + l];
                    mods[((size_t)ly * 9 + c) * NMOD + cb * 64 + l] = sm; }
                __syncthreads();
            }
            {
                LAS float* scr = (LAS float*)(lds + wave * 16384);
                constexpr int I_QKV = 16 * 48, I_WO = 16 * 32, I_POOL = 4 * 8, I_IN = 16 * 176, I_OUT = 44 * 32;
                constexpr int NIT = 2 * I_QKV + 2 * I_WO + 4 * I_POOL + 4 * I_IN + 4 * I_OUT;
                for (int it = gw; it < NIT; it += NGW) {
                    int r_ = it;
                    if (r_ < 4 * I_IN) { const int ly = r_ / I_IN; transpose_item(a.in[18] + (size_t)ly * DM * DFF2, DM, DFF2, (bf16_t*)(ws + WS_WIN) + (size_t)ly * DFF2 * DM, 2, scr, r_ % I_IN, lane); continue; } r_ -= 4 * I_IN;
                    if (r_ < 4 * I_OUT) { const int ly = r_ / I_OUT; transpose_item(a.in[21] + (size_t)ly * DFF * DM, DFF, DM, (bf16_t*)(ws + WS_WOUT) + (size_t)ly * DM * DFF, 0, scr, r_ % I_OUT, lane); continue; } r_ -= 4 * I_OUT;
                    if (r_ < 2 * I_QKV) { const int ly = r_ / I_QKV; transpose_item(a.in[10] + (size_t)ly * DM * NQKV, DM, NQKV, (bf16_t*)(ws + WS_WQKV) + (size_t)ly * NQKV * DM, 1, scr, r_ % I_QKV, lane); continue; } r_ -= 2 * I_QKV;
                    if (r_ < 2 * I_WO) { const int ly = r_ / I_WO; transpose_item(a.in[14] + (size_t)ly * DM * DM, DM, DM, (bf16_t*)(ws + WS_WO) + (size_t)ly * DM * DM, 0, scr, r_ % I_WO, lane); continue; } r_ -= 2 * I_WO;
                    { const int gp = r_ / I_POOL; transpose_item(a.in[15] + (size_t)gp * 65536, 256, 256, (bf16_t*)(ws + WS_WPOOL) + (size_t)gp * 65536, 0, scr, r_ % I_POOL, lane); }
                }
            }
            __syncthreads();
            LAS f32x2* TAB = (LAS f32x2*)lds;
            for (int k = tid; k < 4096; k += 512) { float sv, cv; sincospif((float)k * (1.0f / 2048.0f), &sv, &cv); TAB[k] = (f32x2){cv, sv}; }
            __syncthreads();
            { bf16_t* A1 = (bf16_t*)(ws + WS_A1);
                for (int it = gt; it < 32 * 256 * 32; it += GT) { const int p = it >> 13, j = (it >> 5) & 255, k0 = (it & 31) * 8, t1 = (j >> 1) & 63, bbl = j >> 7, ri = j & 1, part_ = (k0 >> 6) & 1, a0 = k0 & 63; float v[8];
#pragma unroll
                    for (int e = 0; e < 8; ++e) { const f32x2 cs = TAB[(t1 * (64 * (a0 + e) + 2 * p + bbl)) & 4095]; const float x = ri == 0 ? (part_ == 0 ? cs.x : -cs.y) : (part_ == 0 ? -cs.y : -cs.x); v[e] = ((k0 >> 7) == bbl) ? x * (1.0f / 64.0f) : 0.f; }
                    u32x4 o; o.x = cvtpk(v[0], v[1]); o.y = cvtpk(v[2], v[3]); o.z = cvtpk(v[4], v[5]); o.w = cvtpk(v[6], v[7]); *(u32x4*)(A1 + (size_t)it * 8) = o; }
                bf16_t* A2 = (bf16_t*)(ws + WS_A2);
                for (int it = gt; it < 256 * 64; it += GT) { const int r_ = it >> 6, k0 = (it & 63) * 8, t1l = r_ >> 6, t2 = r_ & 63; float v[8];
#pragma unroll
                    for (int e = 0; e < 8; ++e) { const int k = k0 + e, bb = k >> 3; const f32x2 cs = TAB[((t2 * bb) & 63) * 64]; v[e] = (((k >> 1) & 3) == t1l) ? ((k & 1) ? cs.y : cs.x) : 0.f; }
                    u32x4 o; o.x = cvtpk(v[0], v[1]); o.y = cvtpk(v[2], v[3]); o.z = cvtpk(v[4], v[5]); o.w = cvtpk(v[6], v[7]); *(u32x4*)(A2 + (size_t)it * 8) = o; }
                bf16_t* D2 = (bf16_t*)(ws + WS_DFT256);
                for (int it = gt; it < 256 * 64; it += GT) { const int t = it >> 6, j0 = (it & 63) * 8, part_ = j0 >= 256, jj = j0 & 255; float v[8];
#pragma unroll
                    for (int e = 0; e < 8; ++e) { const f32x2 cs = TAB[((t * (jj + e)) & 255) * 16]; v[e] = (part_ ? -cs.y : cs.x) * (1.0f / 16.0f); }
                    u32x4 o; o.x = cvtpk(v[0], v[1]); o.y = cvtpk(v[2], v[3]); o.z = cvtpk(v[4], v[5]); o.w = cvtpk(v[6], v[7]); *(u32x4*)(D2 + (size_t)t * 512 + j0) = o; }
            }
            { LAS float* wt = (LAS float*)(lds + 32768); bf16_t* WCS = (bf16_t*)(ws + WS_WCS);
                for (int item = bx; item < 256; item += G) {
                    const int gp = item >> 6, n0 = (item & 63) * 16;
                    for (int i = tid; i < 4096; i += 512) wt[i] = a.in[17][(size_t)(gp * 256 + (i >> 4)) * DM + n0 + (i & 15)];
                    __syncthreads();
                    const int nn = tid & 15, cg_ = tid >> 4;
                    float ac[8], as[8];
#pragma unroll
                    for (int e = 0; e < 8; ++e) { ac[e] = 0.f; as[e] = 0.f; }
                    for (int cp = 0; cp < 256; ++cp) { const float wv = wt[cp * 16 + nn];
#pragma unroll
                        for (int e = 0; e < 8; ++e) { const f32x2 cs = TAB[(((cg_ * 8 + e) * cp) & 255) * 16]; ac[e] += wv * cs.x; as[e] += wv * cs.y; } }
                    u32x4 o; o.x = cvtpk(ac[0] * 0.0625f, ac[1] * 0.0625f); o.y = cvtpk(ac[2] * 0.0625f, ac[3] * 0.0625f); o.z = cvtpk(ac[4] * 0.0625f, ac[5] * 0.0625f); o.w = cvtpk(ac[6] * 0.0625f, ac[7] * 0.0625f);
                    *(u32x4*)(WCS + (size_t)(n0 + nn) * DM + gp * 256 + cg_ * 8) = o;
                    o.x = cvtpk(as[0] * 0.0625f, as[1] * 0.0625f); o.y = cvtpk(as[2] * 0.0625f, as[3] * 0.0625f); o.z = cvtpk(as[4] * 0.0625f, as[5] * 0.0625f); o.w = cvtpk(as[6] * 0.0625f, as[7] * 0.0625f);
                    *(u32x4*)(WCS + (size_t)(1024 + n0 + nn) * DM + gp * 256 + cg_ * 8) = o;
                    __syncthreads();
                }
            }
            for (int i = gt; i < 1024; i += GT) { const int pos = i >> 4, f = i & 15; const float invf = 1.0f / powf(10000.0f, (float)f * (1.0f / 16.0f)); float sv, cv; sincosf((float)pos * invf, &sv, &cv); ropec[i] = cv; ropes[i] = sv; }
            { bf16_t* CKb = (bf16_t*)(ws + WS_CK); bf16_t* CVTb = (bf16_t*)(ws + WS_CVT);
                for (int it = gt; it < 262144; it += GT) { const f32x4 v0 = *(const f32x4*)(a.in[2] + (size_t)it * 8), v1 = *(const f32x4*)(a.in[2] + (size_t)it * 8 + 4);
                    u32x4 o; o.x = cvtpk(v0[0], v0[1]); o.y = cvtpk(v0[2], v0[3]); o.z = cvtpk(v1[0], v1[1]); o.w = cvtpk(v1[2], v1[3]); *(u32x4*)(CKb + (size_t)(it >> 5) * K_LD + (it & 31) * 8) = o; }
                for (int it = gt; it < 262144; it += GT) { const int d = it & 63, chunk = (it >> 6) & 63, kvh = (it >> 12) & 3, bj2 = it >> 14, g16 = chunk >> 1, hh = chunk & 1; float v[8];
#pragma unroll
                    for (int e = 0; e < 8; ++e) { const int pos = 16 * g16 + 4 * hh + (e & 3) + 8 * (e >> 2); v[e] = a.in[3][((size_t)(bj2 * 512 + pos) * 4 + kvh) * 64 + d]; }
                    u32x4 o; o.x = cvtpk(v[0], v[1]); o.y = cvtpk(v[2], v[3]); o.z = cvtpk(v[4], v[5]); o.w = cvtpk(v[6], v[7]); *(u32x4*)(CVTb + ((size_t)(bj2 * 4 + kvh) * 64 + d) * CVT_LD + chunk * 8) = o; }
            }
        } break;
#endif
        case K_PREP1: prep_phase(xs0, xs1, Hb, a.in[6] + layer * DM, lmods, 0, 1024, gw, NGW, lane); break;
        case K_PREP2: prep_phase(xs0, xs1, Hb, a.in[7] + layer * DM, lmods, 3072, 4096, gw, NGW, lane); break;
        case K_POOLP: pool_phase(Hb, BIG, gw, NGW, lane); break;
        case K_FIX: fix_phase(hal, BIG, a.in[19] + (size_t)layer * 3 * DFF2, a.in[20] + (size_t)layer * DFF2, gt, GT); break;
#ifndef NO_ATTN
        case K_ATTN: attn_phase(Qb, Kbuf, VTb, (const bf16_t*)(ws + WS_CK), (const bf16_t*)(ws + WS_CVT), a.in[13] + jl * 16, jl, vcu, G, wave, lane); break;
#endif
#ifndef NO_QKV
        case K_QKV: {
            pg8::Gemm g{(const char*)Hb, (const char*)(ws + WS_WQKV) + (size_t)jl * NQKV * DM * 2, DM, DM, DM, 160, 6, 160, 0, 0};
            pg8::Order S; S.init(160, 6, G, bx);
            pg8::EpiQKV E{Qb, Kbuf, VTb, out + OUT_CK + (size_t)jl * 65536, out + OUT_CV + (size_t)jl * 65536, a.in[11] + jl * 64, a.in[12] + jl * 64, ropec, ropes};
            pg8::gemm_phase<pg8::EpiQKV>(lds, xl, g, S, E, tid);
        } break;
#endif
#ifndef NO_CHAN
        case K_CHAN: {
            for (int v = 0; v < 2; ++v) {
                pg8::Gemm g{(const char*)(ws + WS_WCS), (const char*)(Hb + (size_t)(v ? NCTX : 0) * DM), DM, DM, DM, 8, v ? 128 : 32, 8, 0, 0};
                g.bperm = v;
                pg8::Order S; S.init(8, v ? 128 : 32, G, bx);
                pg8::EpiChan E{(bf16_t*)(ws + (v ? WS_PTL : WS_PTC)), v};
                pg8::gemm_phase<pg8::EpiChan>(lds, xl, g, S, E, tid);
            }
        } break;
#endif
        case K_ST1: {
            pg8::Gemm g{(const char*)(ws + WS_PTL), (const char*)(ws + WS_A1), 8192, 256, 256, 32, 32, 32, 512, 0};
            pg8::Order S; S.init(32, 32, G, bx);
            pg8::EpiY1 E{(bf16_t*)(ws + WS_YT)};
            pg8::gemm_phase<pg8::EpiY1>(lds, xl, g, S, E, tid);
        } break;
#ifndef NO_FFN1
        case K_FFN1: {
            pg8::Gemm g{(const char*)Hb, (const char*)(ws + WS_WIN) + (size_t)layer * DFF2 * DM * 2, DM, DM, DM, 160, 22, 160, 0, 0};
            pg8::Order S; S.init(160, 22, G, bx);
            pg8::EpiFfn1 E{BIG, hal, a.in[19] + (size_t)layer * 3 * DFF2, a.in[20] + (size_t)layer * DFF2};
            pg8::gemm_phase<pg8::EpiFfn1>(lds, xl, g, S, E, tid);
        } break;
#endif
#ifndef NO_RES
        default: {
            pg8::Gemm g; pg8::EpiRes E; E.src0 = xs0; E.src1 = xs1; E.dst = out; E.pscale = nullptr; E.pm0 = 0; E.rowmap = 0; E.gate = lmods + 2048;
            g.akoff = 0; g.bstride = 0;
            if (kind == K_WO) { g.A = (const char*)Qb; g.Bt = (const char*)(ws + WS_WO) + (size_t)jl * DM * DM * 2; g.lda = DM; g.ldb = DM; g.K = DM; g.nM = 160; g.nN = 4; g.amod = 160; }
            else if (kind == K_POOLG) { g.A = (const char*)BIG; g.Bt = (const char*)(ws + WS_WPOOL); g.lda = DM; g.ldb = 256; g.K = 256; g.nM = 160; g.nN = 4; g.amod = 160; g.akoff = 512; E.pscale = a.in[16]; }
            else if (kind == K_SEQC) { g.A = (const char*)(ws + WS_DFT256); g.Bt = (const char*)(ws + WS_PTC); g.lda = 512; g.ldb = 512; g.K = 512; g.nM = 32; g.nN = 4; g.amod = 1; g.bmod = 1; g.bstride = (size_t)256 * 2048 * 2; }
            else if (kind == K_ST2) { g.A = (const char*)(ws + WS_A2); g.Bt = (const char*)(ws + WS_YT); g.lda = 512; g.ldb = 8192; g.K = 512; g.nM = 128; g.nN = 4; g.amod = 1; g.bmod = 16; g.bstride = (size_t)1024 * 8192 * 2; g.bstride2 = 16; g.bkc = 256; E.rowmap = 1; }
            else { g.A = (const char*)BIG; g.Bt = (const char*)(ws + WS_WOUT) + (size_t)layer * DM * DFF * 2; g.lda = DFF; g.ldb = DFF; g.K = DFF; g.nM = 160; g.nN = 4; g.amod = 160; E.gate = lmods + 5120; }
            if (kind == K_FFN2X) E.dst = (float*)BIG;
            pg8::Order S; S.init(g.nM, g.nN, G, bx);
            const int nfull = (S.nwg / G) * G, rem = S.nwg - nfull;
            if (rem > 0 && 2 * rem <= G && (G & 1) == 0) {
                S.hi = nfull; if (nfull > 0) pg8::gemm_phase<pg8::EpiRes>(lds, xl, g, S, E, tid);
                S.lo = nfull; S.hi = S.nwg; S.G = G >> 1; S.c = bx >> 1;
                if (bx & 1) pg8::gemm_phase<pg8::EpiRes, 2>(lds, xl, g, S, E, tid); else pg8::gemm_phase<pg8::EpiRes, 1>(lds, xl, g, S, E, tid);
            } else pg8::gemm_phase<pg8::EpiRes>(lds, xl, g, S, E, tid);
        } break;
#endif
        }
        if (s + 1 < a.s_hi && kind != K_SEQC) { if (s == a.s_lo) grid.sync(); else xcd_barrier(bar, xcc, bst); }
    }
}

extern "C" void kernel_launch(void* const* d_in, const int* in_sizes, int n_in, void* d_out, int out_size, void* d_ws, size_t ws_size, hipStream_t stream) {
    static int grid = 0;
    if (grid == 0) {
        if (n_in != 22 || ws_size < WS_END) { fprintf(stderr, "kernel_launch: unexpected n_in %d or ws_size %zu (< %zu)\n", n_in, ws_size, (size_t)WS_END); grid = -1; return; }
        int dev = 0, cus = 0, per_cu = 0;
        hipGetDevice(&dev); hipDeviceGetAttribute(&cus, hipDeviceAttributeMultiprocessorCount, dev);
        if (hipFuncSetAttribute((const void*)mega_fwd, hipFuncAttributeMaxDynamicSharedMemorySize, LDS_BYTES) != hipSuccess) { fprintf(stderr, "kernel_launch: hipFuncSetAttribute failed\n"); grid = -1; return; }
        if (hipOccupancyMaxActiveBlocksPerMultiprocessor(&per_cu, (const void*)mega_fwd, 512, LDS_BYTES) != hipSuccess || per_cu < 1) { fprintf(stderr, "kernel_launch: occupancy query says %d\n", per_cu); per_cu = 1; }
        (void)hipGetLastError();
        grid = cus * 1;
    }
    if (grid < 0) return;
    if (hipMemsetAsync((char*)d_ws + WS_CTL, 0, CTL_BYTES, stream) != hipSuccess) { fprintf(stderr, "kernel_launch: memset failed\n"); return; }
    Args a{};
    for (int i = 0; i < 22; ++i) a.in[i] = (const float*)d_in[i];
    a.out = (float*)d_out; a.ws = (unsigned char*)d_ws;
#if MK_MULTI
    for (int s = 0; s < NSTEP;) {
        int e = s + 1; if (H_PROG_KIND[s] == K_SEQC) e = s + 2;
        a.s_lo = s; a.s_hi = e; void* args[] = {&a};
        hipError_t err = hipLaunchCooperativeKernel((const void*)mega_fwd, dim3(grid), dim3(512), args, LDS_BYTES, stream);
        if (err != hipSuccess) { fprintf(stderr, "kernel_launch: cooperative launch failed: %s\n", hipGetErrorString(err)); break; }
        s = e;
    }
#else
    a.s_lo = 0; a.s_hi = NSTEP; void* args[] = {&a};
    hipError_t err = hipLaunchCooperativeKernel((const void*)mega_fwd, dim3(grid), dim3(512), args, LDS_BYTES, stream);
    if (err != hipSuccess) fprintf(stderr, "kernel_launch: cooperative launch failed: %s (grid %d)\n", hipGetErrorString(err), grid);
#endif
}
```

```cpp
#include <hip/hip_runtime.h>
#include <hip/hip_cooperative_groups.h>
#include <cstdio>
#include <cstdint>
namespace cg = cooperative_groups;

#ifndef MK_MULTI
#define MK_MULTI 0
#endif

#define LAS __attribute__((address_space(3)))
typedef unsigned short bf16_t;
typedef short bf16x8 __attribute__((ext_vector_type(8)));
typedef float f32x2 __attribute__((ext_vector_type(2)));
typedef float f32x4 __attribute__((ext_vector_type(4)));
typedef float f32x16 __attribute__((ext_vector_type(16)));
typedef unsigned u32x2 __attribute__((ext_vector_type(2)));
typedef unsigned u32x4 __attribute__((ext_vector_type(4)));
typedef __bf16 bf16x2_t __attribute__((ext_vector_type(2)));

constexpr int DM = 1024, NCTX = 8192, NTOK = 40960, DFF = 2816, DFF2 = 5632, NQKV = 1536, NMOD = 6144;
constexpr float LOG2E = 1.4426950408889634f;
constexpr float QSCALE = 0.125f * LOG2E;

constexpr size_t MiB = 1u << 20;
constexpr size_t WS_MODS = 0;
constexpr size_t WS_ROPE = 1 * MiB;
constexpr size_t WS_DFT256 = 1 * MiB + 64 * 1024;
constexpr size_t WS_WQKV = 2 * MiB;
constexpr size_t WS_WO = 8 * MiB;
constexpr size_t WS_WPOOL = 12 * MiB;
constexpr size_t WS_WCS = 13 * MiB;
constexpr size_t WS_WIN = 17 * MiB;
constexpr size_t WS_WOUT = 61 * MiB;
constexpr size_t WS_CK = 83 * MiB;
constexpr size_t WS_CVT = 488 * MiB;
constexpr int K_LD = 272;
constexpr int VT_LDC = 288, VT_LDL = 4160, CVT_LD = 544;
constexpr size_t VT_CTX_SEQ = (size_t)256 * VT_LDC, VT_LAT_BASE = 32 * VT_CTX_SEQ, VT_LAT_SEQ = (size_t)256 * VT_LDL;
constexpr size_t WS_HAL = 88 * MiB;
constexpr size_t WS_A1 = 102 * MiB;
constexpr size_t WS_A2 = 106 * MiB;
constexpr size_t WS_XB = 107 * MiB;
constexpr size_t WS_YT = 187 * MiB;
constexpr size_t WS_H = 187 * MiB;
constexpr size_t WS_BIG = 267 * MiB;
constexpr size_t WS_PTC = WS_BIG + 60 * MiB, WS_PTL = WS_BIG + 92 * MiB;
constexpr size_t WS_Q = WS_BIG, WS_K = WS_BIG + 80 * MiB, WS_VT = WS_BIG + 104 * MiB;
constexpr size_t WS_CTL = 487 * MiB;
constexpr size_t CTL_BYTES = 64 * 1024;
constexpr size_t WS_END = 494 * MiB;

constexpr size_t OUT_CK = (size_t)NTOK * DM;
constexpr size_t OUT_CV = OUT_CK + (size_t)32 * 2 * 256 * 256;

constexpr int LDS_RING = 131072, LDS_X = 131072, LDS_MISC = 131072 + 8192, LDS_BYTES = 147456;

__device__ __forceinline__ unsigned cvtpk(float lo, float hi) { f32x2 v = {lo, hi}; bf16x2_t b = __builtin_convertvector(v, bf16x2_t); return __builtin_bit_cast(unsigned, b); }
__device__ __forceinline__ bf16_t f2bf(float f) { return (bf16_t)(cvtpk(f, 0.f) & 0xffffu); }
__device__ __forceinline__ float bf2f(unsigned v) { return __uint_as_float(v << 16); }
__device__ __forceinline__ float dpp_prev(float v) { return __int_as_float(__builtin_amdgcn_update_dpp(0, __float_as_int(v), 0x121, 0xf, 0xf, false)); }
__device__ __forceinline__ float dpp_next(float v) { return __int_as_float(__builtin_amdgcn_update_dpp(0, __float_as_int(v), 0x12F, 0xf, 0xf, false)); }
__device__ __forceinline__ f32x4 dpp_prev4(f32x4 v) { return (f32x4){dpp_prev(v[0]), dpp_prev(v[1]), dpp_prev(v[2]), dpp_prev(v[3])}; }
__device__ __forceinline__ f32x4 dpp_next4(f32x4 v) { return (f32x4){dpp_next(v[0]), dpp_next(v[1]), dpp_next(v[2]), dpp_next(v[3])}; }
__device__ __forceinline__ float silu_mul(float g, float v) { const float e = __builtin_amdgcn_exp2f(-g * LOG2E); return g * __builtin_amdgcn_rcpf(1.0f + e) * v; }
__device__ __forceinline__ int cond_of_row(int row) { return row < NCTX ? 0 : 1 + ((row - NCTX) >> 12); }

namespace pg8 {
constexpr int BM = 256, BK = 64, HALF = 128, HTB = HALF * BK * 2, NXCD = 8, WGM = 8;
__device__ __forceinline__ int lds_byte(int r, int c) { const int st = (r >> 4) * 2 + (c >> 5), rr = r & 15, cc = c & 31, ob = rr * 64 + cc * 2; return st * 1024 + (ob ^ (((ob >> 9) & 1) << 5)); }
__device__ __forceinline__ void stage_rc(int b, int& R, int& C) { const int st = b / 1024, sb = b % 1024, swz = sb ^ (((sb >> 9) & 1) << 5); R = (st >> 1) * 16 + swz / 64; C = (st & 1) * 32 + (swz % 64) / 2; }
__device__ __forceinline__ int perm32(int rho) { const int n = rho >> 4, i = rho & 15; return 8 * (i >> 2) + 4 * n + (i & 3); }

struct Unit { int pm, pn, half; };
struct Gemm { const char* A; const char* Bt; int lda, ldb, K, nM, nN, amod, akoff; size_t bstride; int bmod = 1 << 30; size_t bstride2 = 0; int bperm = 0; int bkc = 16; };
__device__ __forceinline__ const char* aptr(const Gemm& g, const Unit& u) { return g.A + (size_t)(u.pm % g.amod) * (size_t)512 * g.lda + (size_t)u.pn * g.akoff; }
__device__ __forceinline__ const char* bptr(const Gemm& g, const Unit& u) {
    if (g.bperm) return g.Bt + (size_t)((u.pn >> 4) * 4096 + 4 * (u.pn & 15)) * (size_t)2 * g.ldb;
    return g.Bt + (size_t)(u.pm / g.bmod) * g.bstride + (size_t)(u.pm % g.bmod) * g.bstride2 + (size_t)u.pn * (size_t)512 * g.ldb; }

struct Order {
    int nM, nN, nwg, G, c, lo, hi;
    __device__ __forceinline__ void init(int nM_, int nN_, int G_, int c_) { nM = nM_; nN = nN_; nwg = nM * nN; G = G_; c = c_; lo = 0; hi = nwg; }
    __device__ __forceinline__ bool next(int i, Unit& u) const {
        const long L = (long)lo + (long)i * G + c; if (L >= hi) return false;
        int wgid = (int)L; u.half = 0; { const int q = nwg / NXCD, r = nwg % NXCD, xcd = wgid % NXCD, off = wgid / NXCD; wgid = (xcd < r ? xcd * (q + 1) : r * (q + 1) + (xcd - r) * q) + off; }
        const int nig = WGM * nN, gid = wgid / nig, fm = gid * WGM, gsz = (nM - fm) < WGM ? (nM - fm) : WGM;
        u.pm = fm + ((wgid % nig) % gsz); u.pn = (wgid % nig) / gsz; return true;
    }
};


struct EpiRes {
    static constexpr bool PERM = true;
    const float* src0; const float* src1;
    const bf16_t* xin; bf16_t* xout;
    float* dst;
    const float* gate; const float* pscale; int pm0; int rowmap;
    __device__ __forceinline__ void operator()(f32x4 (&acc)[2][2][4][2], const Unit& u, int wr, int wc, int fr, int fq, LAS unsigned char*) const {
        asm volatile("" : "+v"(fr), "+v"(fq), "+s"(wr), "+s"(wc));
        const int rowt = rowmap ? NCTX + (u.pm >> 4) * 4096 + 4 * (u.pm & 15) : (pm0 + u.pm) * BM; const float* g = gate + (size_t)cond_of_row(rowt) * NMOD;
        const int col0 = u.pn * BM + wc * 32 + 8 * fq;
        f32x4 gv[2][2];
#pragma unroll
        for (int bj = 0; bj < 2; ++bj)
#pragma unroll
            for (int n = 0; n < 2; ++n) { gv[bj][n] = *(const f32x4*)(g + col0 + bj * HALF + n * 4); if (pscale) gv[bj][n] = gv[bj][n] * *(const f32x4*)(pscale + col0 + bj * HALF + n * 4); }
#pragma unroll
        for (int ai = 0; ai < 2; ++ai) { if (u.half == 2 - ai) continue;
#pragma unroll
            for (int m = 0; m < 4; ++m) {
                const int row = rowmap ? rowt + 2 * ai + wr + 64 * (16 * m + fr) : rowt + ai * HALF + wr * 64 + m * 16 + fr;
#pragma unroll
                for (int bj = 0; bj < 2; ++bj) {
                    f32x4 x0, x1;
                    if (xin) { const u32x4 w = *(const u32x4*)(xin + (size_t)row * DM + col0 + bj * HALF);
                        x0 = (f32x4){bf2f(w.x & 0xffffu), bf2f(w.x >> 16), bf2f(w.y & 0xffffu), bf2f(w.y >> 16)}; x1 = (f32x4){bf2f(w.z & 0xffffu), bf2f(w.z >> 16), bf2f(w.w & 0xffffu), bf2f(w.w >> 16)}; }
                    else { const float* s = (row < NCTX ? src0 + (size_t)row * DM : src1 + (size_t)(row - NCTX) * DM) + col0 + bj * HALF; x0 = *(const f32x4*)s; x1 = *(const f32x4*)(s + 4); }
                    x0 = x0 + gv[bj][0] * acc[ai][bj][m][0]; x1 = x1 + gv[bj][1] * acc[ai][bj][m][1];
                    if (xout) { u32x4 w; w.x = cvtpk(x0[0], x0[1]); w.y = cvtpk(x0[2], x0[3]); w.z = cvtpk(x1[0], x1[1]); w.w = cvtpk(x1[2], x1[3]); *(u32x4*)(xout + (size_t)row * DM + col0 + bj * HALF) = w; }
                    if (dst) { float* d = dst + (size_t)row * DM + col0 + bj * HALF; *(f32x4*)d = x0; *(f32x4*)(d + 4) = x1; }
                }
            } }
    }
};

struct EpiQKV {
    static constexpr bool PERM = false;
    bf16_t* Q; bf16_t* Kb; bf16_t* VT; float* ock; float* ocv; const float* qn; const float* kn; const float* ropec; const float* ropes;
    __device__ __forceinline__ void operator()(f32x4 (&acc)[2][2][4][2], const Unit& u, int wr, int wc, int fr, int fq, LAS unsigned char*) const {
        asm volatile("" : "+v"(fr), "+v"(fq), "+s"(wr), "+s"(wc));

        const int rowt = u.pm * BM; const bool lat = rowt >= NCTX; const int dl = 4 * fq;
        if (u.pn < 5) {
            const bool isq = u.pn < 4; const float* nw = isq ? qn : kn;
            f32x4 nwv[2][2];
#pragma unroll
            for (int bj = 0; bj < 2; ++bj)
#pragma unroll
                for (int n = 0; n < 2; ++n) nwv[bj][n] = *(const f32x4*)(nw + 32 * bj + 16 * n + dl);
#pragma unroll
            for (int ai = 0; ai < 2; ++ai)
#pragma unroll
                for (int m = 0; m < 4; ++m) {
                    const int row = rowt + ai * HALF + wr * 64 + m * 16 + fr;
                    float ss = 0.f;
#pragma unroll
                    for (int bj = 0; bj < 2; ++bj)
#pragma unroll
                        for (int n = 0; n < 2; ++n) { const f32x4 v = acc[ai][bj][m][n]; ss += (v[0] * v[0] + v[1] * v[1]) + (v[2] * v[2] + v[3] * v[3]); }
                    ss += __shfl_xor(ss, 16); ss += __shfl_xor(ss, 32);
                    const float rstd = 1.0f / sqrtf(ss * (1.0f / 64.0f) + 1e-6f);
                    f32x4 y[2][2];
#pragma unroll
                    for (int bj = 0; bj < 2; ++bj)
#pragma unroll
                        for (int n = 0; n < 2; ++n) y[bj][n] = acc[ai][bj][m][n] * rstd * nwv[bj][n];
                    if (!isq && !lat) {
                        float* p = ock + (size_t)(row >> 8) * 131072 + (size_t)(row & 255) * 256 + wc * 64 + dl;
#pragma unroll
                        for (int bj = 0; bj < 2; ++bj)
#pragma unroll
                            for (int n = 0; n < 2; ++n) *(f32x4*)(p + 32 * bj + 16 * n) = y[bj][n];
                    }
                    if (lat) {
                        const int lr = row - NCTX, pr = (lr & 4095) >> 6, pc = lr & 63;
#pragma unroll
                        for (int bj = 0; bj < 2; ++bj) {
                            const int pos = bj ? pc : pr;
                            const f32x4 c4 = *(const f32x4*)(ropec + pos * 16 + dl), s4 = *(const f32x4*)(ropes + pos * 16 + dl);
                            const f32x4 x1 = y[bj][0], x2 = y[bj][1];
                            y[bj][0] = x1 * c4 - x2 * s4; y[bj][1] = x1 * s4 + x2 * c4;
                        }
                    }
                    bf16_t* dstp;
                    if (isq) { dstp = Q + (size_t)row * DM + (4 * u.pn + wc) * 64 + dl;
#pragma unroll
                        for (int bj = 0; bj < 2; ++bj)
#pragma unroll
                            for (int n = 0; n < 2; ++n) y[bj][n] = y[bj][n] * QSCALE;
                    } else dstp = Kb + (size_t)row * K_LD + wc * 64 + dl;
#pragma unroll
                    for (int bj = 0; bj < 2; ++bj)
#pragma unroll
                        for (int n = 0; n < 2; ++n) { u32x2 w; w.x = cvtpk(y[bj][n][0], y[bj][n][1]); w.y = cvtpk(y[bj][n][2], y[bj][n][3]); *(u32x2*)(dstp + 32 * bj + 16 * n) = w; }
                }
        } else {
#pragma unroll
            for (int ai = 0; ai < 2; ++ai)
#pragma unroll
                for (int m = 0; m < 4; ++m) {
                    const int row = rowt + ai * HALF + wr * 64 + m * 16 + fr;
                    if (!lat) {
                        float* p = ocv + (size_t)(row >> 8) * 131072 + (size_t)(row & 255) * 256 + wc * 64 + dl;
#pragma unroll
                        for (int bj = 0; bj < 2; ++bj)
#pragma unroll
                            for (int n = 0; n < 2; ++n) *(f32x4*)(p + 32 * bj + 16 * n) = acc[ai][bj][m][n];
                    }
                    size_t sb; int pos, L;
                    if (lat) { const int lr = row - NCTX; sb = VT_LAT_BASE + (size_t)(lr >> 12) * VT_LAT_SEQ; pos = lr & 4095; L = VT_LDL; } else { sb = (size_t)(row >> 8) * VT_CTX_SEQ; pos = row & 255; L = VT_LDC; }
                    const int k16 = pos & 15, pp = (pos & ~15) + 8 * ((k16 >> 2) & 1) + (k16 & 3) + 4 * (k16 >> 3);
                    bf16_t* base = VT + sb + (size_t)(wc * 64 + dl) * L + pp;
#pragma unroll
                    for (int bj = 0; bj < 2; ++bj)
#pragma unroll
                        for (int n = 0; n < 2; ++n)
#pragma unroll
                            for (int e = 0; e < 4; ++e) base[(size_t)(32 * bj + 16 * n + e) * L] = f2bf(acc[ai][bj][m][n][e]);
                }
        }
    }
};

struct EpiChan {
    static constexpr bool PERM = true;
    bf16_t* PT; int lat;
    __device__ __forceinline__ void operator()(f32x4 (&acc)[2][2][4][2], const Unit& u, int wr, int wc, int fr, int fq, LAS unsigned char*) const {
        asm volatile("" : "+v"(fr), "+v"(fq), "+s"(wr), "+s"(wc));
#pragma unroll
        for (int ai = 0; ai < 2; ++ai)
#pragma unroll
            for (int m = 0; m < 4; ++m) {
                const int row = u.pm * BM + ai * HALF + wr * 64 + m * 16 + fr, part = row >> 10, n_ = row & 1023;
#pragma unroll
                for (int bj = 0; bj < 2; ++bj) {
                    bf16_t* d;
                    if (lat) d = PT + (size_t)(u.pn >> 4) * (1024 * 8192) + (size_t)n_ * 8192 + (4 * (u.pn & 15) + 2 * bj + (wc >> 1)) * 128 + part * 64 + (wc & 1) * 32 + 8 * fq;
                    else d = PT + (size_t)u.pn * (256 * 2048) + (size_t)n_ * 512 + part * 256 + bj * HALF + wc * 32 + 8 * fq;
                    const f32x4 v0 = acc[ai][bj][m][0], v1 = acc[ai][bj][m][1]; u32x4 w; w.x = cvtpk(v0[0], v0[1]); w.y = cvtpk(v0[2], v0[3]); w.z = cvtpk(v1[0], v1[1]); w.w = cvtpk(v1[2], v1[3]); *(u32x4*)d = w; }
            }
    }
};

struct EpiY1 {
    static constexpr bool PERM = true;
    bf16_t* YT;
    __device__ __forceinline__ void operator()(f32x4 (&acc)[2][2][4][2], const Unit& u, int wr, int wc, int fr, int fq, LAS unsigned char*) const {
        asm volatile("" : "+v"(fr), "+v"(fq), "+s"(wr), "+s"(wc));
#pragma unroll
        for (int ai = 0; ai < 2; ++ai)
#pragma unroll
            for (int m = 0; m < 4; ++m) {
                bf16_t* d = YT + (size_t)(u.pm * BM + ai * HALF + wr * 64 + m * 16 + fr) * 8192 + u.pn * BM + wc * 32 + 8 * fq;
#pragma unroll
                for (int bj = 0; bj < 2; ++bj) { const f32x4 v0 = acc[ai][bj][m][0], v1 = acc[ai][bj][m][1]; u32x4 w; w.x = cvtpk(v0[0], v0[1]); w.y = cvtpk(v0[2], v0[3]); w.z = cvtpk(v1[0], v1[1]); w.w = cvtpk(v1[2], v1[3]); *(u32x4*)(d + bj * HALF) = w; }
            }
    }
};

struct EpiFfn1 {
    static constexpr bool PERM = true;
    bf16_t* Aout; float* hal; const float* cw; const float* cb;
    __device__ __forceinline__ void operator()(f32x4 (&acc)[2][2][4][2], const Unit& u, int wr, int wc, int fr, int fq, LAS unsigned char* xl) const {
        asm volatile("" : "+v"(fr), "+v"(fq), "+s"(wr), "+s"(wc));

        LAS float* X = (LAS float*)xl;
        const int chl = wc * 32 + 8 * fq;
        LAS float* WL = (LAS float*)(xl + 9216);
        { const int t2 = (wr * 4 + wc) * 64 + fq * 16 + fr;
#pragma unroll
            for (int q = 0; q < 2; ++q) { const int idx = t2 + 512 * q, k = idx >> 8, c = idx & 255, col = (c >> 7) * DFF + u.pn * 128 + (c & 127); WL[idx] = (k < 3) ? cw[(size_t)k * DFF2 + col] : cb[col]; } }
#pragma unroll
        for (int ai = 0; ai < 2; ++ai) { const int blk = 2 * ai + wr;
            if (fr == 0) {
#pragma unroll
                for (int bj = 0; bj < 2; ++bj)
#pragma unroll
                    for (int n = 0; n < 2; ++n) *(LAS f32x4*)(X + ((blk * 2 + 0) * 2 + bj) * 128 + chl + 4 * n) = acc[ai][bj][0][n]; }
            if (fr == 15) {
#pragma unroll
                for (int bj = 0; bj < 2; ++bj)
#pragma unroll
                    for (int n = 0; n < 2; ++n) *(LAS f32x4*)(X + ((blk * 2 + 1) * 2 + bj) * 128 + chl + 4 * n) = acc[ai][bj][3][n]; }
        }
        { float* hp = hal + (size_t)u.pm * 4 * DFF2 + u.pn * 128 + chl;
            if (wr == 0 && fr < 2) {
#pragma unroll
                for (int bj = 0; bj < 2; ++bj)
#pragma unroll
                    for (int n = 0; n < 2; ++n) *(f32x4*)(hp + (size_t)fr * DFF2 + bj * DFF + 4 * n) = acc[0][bj][0][n]; }
            if (wr == 1 && fr >= 14) {
#pragma unroll
                for (int bj = 0; bj < 2; ++bj)
#pragma unroll
                    for (int n = 0; n < 2; ++n) *(f32x4*)(hp + (size_t)(fr - 12) * DFF2 + bj * DFF + 4 * n) = acc[1][bj][3][n]; }
        }
        asm volatile("s_waitcnt lgkmcnt(0)" ::: "memory"); __builtin_amdgcn_s_barrier(); asm volatile("" ::: "memory");
        const f32x4 z4 = {0.f, 0.f, 0.f, 0.f};
#pragma unroll
        for (int n = 0; n < 2; ++n) {
            const LAS float* wl = WL + chl + 4 * n;
#define CW_(k, bj) (*(const LAS f32x4*)(wl + (k) * 256 + (bj) * 128))
#pragma unroll
            for (int ai = 0; ai < 2; ++ai) { const int blk = 2 * ai + wr;
                f32x4 top[2], bot[2];
#pragma unroll
                for (int bj = 0; bj < 2; ++bj) {
                    top[bj] = blk > 0 ? *(LAS f32x4*)(X + (((blk - 1) * 2 + 1) * 2 + bj) * 128 + chl + 4 * n) : z4;
                    bot[bj] = blk < 3 ? *(LAS f32x4*)(X + (((blk + 1) * 2 + 0) * 2 + bj) * 128 + chl + 4 * n) : z4; }
#pragma unroll
                for (int m = 0; m < 4; ++m) {
                    f32x4 cv[2];
#pragma unroll
                    for (int bj = 0; bj < 2; ++bj) {
                        const f32x4 cur = acc[ai][bj][m][n];
                        f32x4 pr = dpp_prev4(cur), nx = dpp_next4(cur);
                        const f32x4 pe = (m > 0) ? dpp_prev4(acc[ai][bj][m > 0 ? m - 1 : 0][n]) : top[bj];
                        const f32x4 ne = (m < 3) ? dpp_next4(acc[ai][bj][m < 3 ? m + 1 : 3][n]) : bot[bj];
                        if (fr == 0) pr = pe;
                        if (fr == 15) nx = ne;
                        cv[bj] = CW_(0, bj) * pr + CW_(1, bj) * cur + CW_(2, bj) * nx + CW_(3, bj);
                    }
                    u32x2 w; w.x = cvtpk(silu_mul(cv[0][0], cv[1][0]), silu_mul(cv[0][1], cv[1][1])); w.y = cvtpk(silu_mul(cv[0][2], cv[1][2]), silu_mul(cv[0][3], cv[1][3]));
                    *(u32x2*)(Aout + (size_t)(u.pm * BM + ai * HALF + wr * 64 + m * 16 + fr) * DFF + u.pn * 128 + chl + 4 * n) = w;
                }
            }
        }
    }
};

template <class Epi, int HM = 0>
__device__ __forceinline__ void gemm_phase(LAS unsigned char* lds, LAS unsigned char* xl, const Gemm g, const Order& S, const Epi& E, const int tid) {
    const int wid = __builtin_amdgcn_readfirstlane(tid >> 6), lane = tid & 63, wr = wid >> 2, wc = wid & 3, fr = lane & 15, fq = lane >> 4;
    const int nt = g.K / BK;
    unsigned voffA[2], voffB[2];
#pragma unroll
    for (int i = 0; i < 2; ++i) { int R, C; stage_rc(tid * 16 + i * 8192, R, C); const int Rb = Epi::PERM ? ((R & ~31) + perm32(R & 31)) : R;
        const int Rt = g.bperm ? 64 * (Rb & 63) + (Rb >> 6) : Rb;
        voffA[i] = (unsigned)(R * g.lda + C) * 2u; voffB[i] = (unsigned)(Rt * g.ldb) * 2u + (unsigned)((C >> 3) * g.bkc); }
    const size_t kstep = (size_t)(BK * 2), kstepB = (size_t)(8 * g.bkc);
    const size_t hA = (size_t)HALF * g.lda * 2, hB = g.bperm ? (size_t)4 * g.ldb : (size_t)HALF * g.ldb * 2;
    const unsigned ldsw = (unsigned)wid * 1024u;
    const int aoff = lds_byte(wr * 64 + fr, fq * 8), boff = lds_byte(wc * 32 + fr, fq * 8);
#define PG8_SA(b, h) (((b) * 2 + (h)) * HTB)
#define PG8_SB(b, h) ((4 + (b) * 2 + (h)) * HTB)
#define PG8_STAGE(bufoff, gbase, voff) do { _Pragma("unroll") for (int _i = 0; _i < 2; ++_i) \
        __builtin_amdgcn_global_load_lds((const unsigned*)((const char*)(gbase) + (voff)[_i]), (LAS unsigned*)(lds + (bufoff) + ldsw + _i * 8192), 16, 0, 0); } while (0)
#define PG8_LDA(dst, b, h) do { _Pragma("unroll") for (int m = 0; m < 4; ++m) _Pragma("unroll") for (int k = 0; k < 2; ++k) dst[m][k] = *(const LAS bf16x8*)(lds + PG8_SA(b, h) + aoff + m * 2048 + k * 1024); } while (0)
#define PG8_LDB(dst, b, h) do { _Pragma("unroll") for (int n = 0; n < 2; ++n) _Pragma("unroll") for (int k = 0; k < 2; ++k) dst[n][k] = *(const LAS bf16x8*)(lds + PG8_SB(b, h) + boff + n * 2048 + k * 1024); } while (0)
#define PG8_MMA(ai, bj, At, Bt) do { __builtin_amdgcn_s_setprio(1); _Pragma("unroll") for (int m = 0; m < 4; ++m) _Pragma("unroll") for (int n = 0; n < 2; ++n) _Pragma("unroll") for (int k = 0; k < 2; ++k) \
        acc[ai][bj][m][n] = __builtin_amdgcn_mfma_f32_16x16x32_bf16(Bt[n][k], At[m][k], acc[ai][bj][m][n], 0, 0, 0); __builtin_amdgcn_s_setprio(0); } while (0)
#define PG8_WAIT_V(n) asm volatile("s_waitcnt vmcnt(" #n ")" ::: "memory")
#define PG8_WAIT_L(n) asm volatile("s_waitcnt lgkmcnt(" #n ")" ::: "memory")
#define PG8_BAR __builtin_amdgcn_s_barrier()
#define PG8_SCHED __builtin_amdgcn_sched_barrier(0)
    Unit cur, nxt; int ui = 0;
    if (!S.next(0, cur)) return;
    f32x4 acc[2][2][4][2];
#pragma unroll
    for (int a = 0; a < 2; ++a)
#pragma unroll
        for (int b = 0; b < 2; ++b)
#pragma unroll
            for (int m = 0; m < 4; ++m)
#pragma unroll
                for (int n = 0; n < 2; ++n) acc[a][b][m][n] = (f32x4){0.f, 0.f, 0.f, 0.f};
    bf16x8 At[4][2], B0[2][2], B1[2][2];
    const char* cA = aptr(g, cur); const char* cB = bptr(g, cur);
    PG8_STAGE(PG8_SB(0, 0), cB, voffB); PG8_STAGE(PG8_SB(0, 1), cB + hB, voffB); PG8_STAGE(PG8_SA(0, 0), cA, voffA); PG8_STAGE(PG8_SA(0, 1), cA + hA, voffA);
    if (wr == 1) PG8_BAR;
    PG8_WAIT_V(2); PG8_BAR;
    PG8_STAGE(PG8_SB(1, 0), cB + kstepB, voffB); PG8_STAGE(PG8_SA(1, 0), cA + kstep, voffA); PG8_STAGE(PG8_SB(1, 1), cB + hB + kstepB, voffB);
    PG8_WAIT_V(6); PG8_BAR;
    for (;;) {
        const bool has_next = S.next(ui + 1, nxt);
        const char* nA = has_next ? aptr(g, nxt) : cA; const char* nB = has_next ? bptr(g, nxt) : cB;
        for (int t = 0; t < nt; t += 2) {
            const bool last = (t == nt - 2);
            const char* a1 = cA + (size_t)(t + 1) * kstep;
            const char* a2 = last ? nA : cA + (size_t)(t + 2) * kstep; const char* b2 = last ? nB : cB + (size_t)(t + 2) * kstepB;
            const char* a3 = a2 + kstep; const char* b3 = b2 + kstepB;
            PG8_LDB(B0, 0, 0); PG8_LDB(B1, 0, 1); PG8_SCHED; PG8_LDA(At, 0, 0); PG8_STAGE(PG8_SA(1, 1), a1 + hA, voffA);
            PG8_WAIT_V(8); PG8_WAIT_L(0); PG8_BAR; if constexpr (HM != 2) { PG8_MMA(0, 0, At, B0); PG8_MMA(0, 1, At, B1); } PG8_BAR; PG8_SCHED;
            PG8_LDA(At, 0, 1); PG8_STAGE(PG8_SB(0, 0), b2, voffB); PG8_STAGE(PG8_SB(0, 1), b2 + hB, voffB); PG8_STAGE(PG8_SA(0, 0), a2, voffA);
            PG8_WAIT_V(8); PG8_WAIT_L(0); PG8_BAR; if constexpr (HM != 1) { PG8_MMA(1, 0, At, B0); PG8_MMA(1, 1, At, B1); } PG8_BAR; PG8_SCHED;
            PG8_LDB(B0, 1, 0); PG8_LDB(B1, 1, 1); PG8_SCHED; PG8_LDA(At, 1, 0); PG8_STAGE(PG8_SA(0, 1), a2 + hA, voffA);
            PG8_WAIT_V(8); PG8_WAIT_L(0); PG8_BAR; if constexpr (HM != 2) { PG8_MMA(0, 0, At, B0); PG8_MMA(0, 1, At, B1); } PG8_BAR; PG8_SCHED;
            PG8_LDA(At, 1, 1); PG8_STAGE(PG8_SB(1, 0), b3, voffB); PG8_STAGE(PG8_SB(1, 1), b3 + hB, voffB); PG8_STAGE(PG8_SA(1, 0), a3, voffA);
            PG8_WAIT_V(8); PG8_WAIT_L(0); PG8_BAR; if constexpr (HM != 1) { PG8_MMA(1, 0, At, B0); PG8_MMA(1, 1, At, B1); } PG8_BAR; PG8_SCHED;
        }
        if (wr == 0) PG8_BAR;
        cur.half = HM; E(acc, cur, wr, wc, fr, fq, xl);
        if (!has_next) break;
#pragma unroll
        for (int a = 0; a < 2; ++a)
#pragma unroll
            for (int b = 0; b < 2; ++b)
#pragma unroll
                for (int m = 0; m < 4; ++m)
#pragma unroll
                    for (int n = 0; n < 2; ++n) acc[a][b][m][n] = (f32x4){0.f, 0.f, 0.f, 0.f};
        cur = nxt; cA = nA; cB = nB; ++ui;
        if (wr == 1) PG8_BAR;
    }
    PG8_WAIT_V(0);
    PG8_BAR;
#undef PG8_SA
#undef PG8_SB
#undef PG8_STAGE
#undef PG8_LDA
#undef PG8_LDB
#undef PG8_MMA
#undef PG8_WAIT_V
#undef PG8_WAIT_L
#undef PG8_BAR
#undef PG8_SCHED
}
}


#define XB_TMO      128
#define XB_XCNT(j)  (256  + 64 * (j))
#define XB_XSUB(j)  (1280 + 64 * (j))
#define XB_XGEN(j)  (2304 + 64 * (j))
#define XB_TOP      3328
#define XB_TOPGEN   3392
#define XCD_BAR_WORDS 3456
#define XB_SPIN_CAP (1u << 18)
__device__ __forceinline__ unsigned xb_ld(unsigned* p)              { return __hip_atomic_load(p, __ATOMIC_RELAXED, __HIP_MEMORY_SCOPE_AGENT); }
__device__ __forceinline__ unsigned xb_add(unsigned* p, unsigned v) { return __hip_atomic_fetch_add(p, v, __ATOMIC_RELAXED, __HIP_MEMORY_SCOPE_AGENT); }
__device__ __forceinline__ unsigned xb_xcc_id() { return (unsigned)__builtin_amdgcn_s_getreg((3 << 11) | 20) & 0xFu; }
#define XB_SPIN(cond, bar) do { unsigned _sp = 0; while (cond) { __builtin_amdgcn_s_sleep(1); \
    if ((++_sp & 255u) == 0u) { if (xb_ld(&(bar)[XB_TMO])) break; if (_sp > XB_SPIN_CAP) { atomicAdd(&(bar)[XB_TMO], 1u); break; } } } } while (0)
__device__ __forceinline__ void xcd_barrier_complete(unsigned* bar, unsigned x, unsigned& nloc, unsigned& nx) {
    const unsigned G = gridDim.x * gridDim.y * gridDim.z;
    unsigned sum, cnt, mine, sp = 0u;
    for (;;) {
        sum = 0u; cnt = 0u; mine = 0u;
#pragma unroll
        for (unsigned j = 0; j < 16; ++j) { const unsigned c = xb_ld(&bar[XB_XCNT(j)]); sum += c; cnt += (c > 0u) ? 1u : 0u; mine = (j == x) ? c : mine; }
        if (sum == G) break;
        __builtin_amdgcn_s_sleep(1);
        if ((++sp & 255u) == 0u) { if (xb_ld(&bar[XB_TMO])) break; if (sp > XB_SPIN_CAP) { atomicAdd(&bar[XB_TMO], 1u); break; } }
    }
    nloc = mine > 0u ? mine : 1u; nx = cnt > 0u ? cnt : 1u;
}
__device__ __forceinline__ void xcd_barrier(unsigned* bar, unsigned x, volatile LAS unsigned* st) {
    asm volatile("s_waitcnt vmcnt(0)" ::: "memory");
    __syncthreads();
    if (threadIdx.x == 0) {
        __builtin_amdgcn_s_waitcnt(0);
        unsigned nloc = st[0], nx = st[1];
        if (nloc == 0u) { xcd_barrier_complete(bar, x, nloc, nx); st[0] = nloc; st[1] = nx; }
        const unsigned old = xb_add(&bar[XB_XSUB(x)], 1u);
        const unsigned gen = old / nloc;
        if (old + 1u == (gen + 1u) * nloc) {
            __builtin_amdgcn_fence(__ATOMIC_RELEASE, "agent");
            asm volatile("s_waitcnt vmcnt(0)" ::: "memory");
            const unsigned og = xb_add(&bar[XB_TOP], 1u);
            const unsigned tg = og / nx;
            if (og + 1u == (tg + 1u) * nx) xb_add(&bar[XB_TOPGEN], 1u);
            else XB_SPIN(xb_ld(&bar[XB_TOPGEN]) == tg, bar);
            __builtin_amdgcn_fence(__ATOMIC_ACQUIRE, "agent");
            xb_add(&bar[XB_XGEN(x)], 1u);
            asm volatile("s_waitcnt vmcnt(0)" ::: "memory");
        } else {
            XB_SPIN(xb_ld(&bar[XB_XGEN(x)]) == gen, bar);
            __builtin_amdgcn_fence(__ATOMIC_ACQUIRE, "agent");
            asm volatile("s_waitcnt vmcnt(0)" ::: "memory");
        }
    }
    __syncthreads();
}

#define MFMA32(a, b, c) __builtin_amdgcn_mfma_f32_32x32x16_bf16((a), (b), (c), 0, 0, 0)
__device__ __forceinline__ int crow(int r, int hi) { return (r & 3) + 8 * (r >> 2) + 4 * hi; }

__device__ __forceinline__ void attn_phase(bf16_t* Q, const bf16_t* Kb, const bf16_t* VT, const bf16_t* CK, const bf16_t* CVT, const float* sink, int j, int vcu, int G, int wave, int lane) {
    const int r = lane & 31, h = lane >> 5;
    for (int u = vcu; u < 1280; u += G) {
        const bool lat = u < 1024;
        int b, kvh, qb, L, seqrow;
        if (lat) { b = u >> 7; kvh = (u >> 5) & 3; qb = u & 31; L = 4096; seqrow = NCTX + b * 4096; }
        else { const int v = u - 1024; b = v >> 3; kvh = (v >> 1) & 3; qb = v & 1; L = 256; seqrow = b * 256; }
        const int hq = kvh * 4 + (wave & 3), t0 = qb * 128 + (wave >> 2) * 64;
        bf16_t* Qp = Q + (size_t)(seqrow + t0) * DM + hq * 64;
        bf16x8 qf[2][4];
#pragma unroll
        for (int qi = 0; qi < 2; ++qi)
#pragma unroll
            for (int ks = 0; ks < 4; ++ks) qf[qi][ks] = *(const bf16x8*)(Qp + (size_t)(qi * 32 + r) * DM + ks * 16 + h * 8);
        const float m0 = sink[hq] * LOG2E;
        float mrow[2] = {m0, m0}, lrow[2] = {h == 0 ? 1.f : 0.f, h == 0 ? 1.f : 0.f};
        f32x16 O[2][2];
#pragma unroll
        for (int qi = 0; qi < 2; ++qi)
#pragma unroll
            for (int db = 0; db < 2; ++db)
#pragma unroll
                for (int i = 0; i < 16; ++i) O[qi][db][i] = 0.f;
        const int nseg = lat ? 2 : 1;
        for (int seg = 0; seg < nseg; ++seg) {
            const bf16_t* kb; const bf16_t* vb; int ldv, klo, khi; bool mask;
            if (seg == 0) { kb = Kb + (size_t)seqrow * K_LD + kvh * 64; ldv = lat ? VT_LDL : VT_LDC; vb = VT + (lat ? VT_LAT_BASE + (size_t)b * VT_LAT_SEQ : (size_t)b * VT_CTX_SEQ) + (size_t)kvh * 64 * ldv;
                if (lat) { klo = t0 - 128 < 0 ? 0 : t0 - 128; khi = t0 + 192 > L ? L : t0 + 192; mask = true; } else { klo = 0; khi = 256; mask = false; } }
            else { kb = CK + (size_t)(b * 2 + j) * 512 * K_LD + kvh * 64; vb = CVT + (size_t)((b * 2 + j) * 4 + kvh) * 64 * CVT_LD; ldv = CVT_LD; klo = 0; khi = 512; mask = false; }
            bf16x8 kf[4];
#pragma unroll
            for (int ks = 0; ks < 4; ++ks) kf[ks] = *(const bf16x8*)(kb + (size_t)(klo + r) * K_LD + ks * 16 + h * 8);
            bf16x8 vf[2][2];
#pragma unroll
            for (int db = 0; db < 2; ++db)
#pragma unroll
                for (int s = 0; s < 2; ++s) vf[db][s] = *(const bf16x8*)(vb + (size_t)(db * 32 + r) * ldv + klo + s * 16 + h * 8);
            for (int key = klo; key < khi; key += 32) {
                bf16x8 kn[4], vn[2][2];
                const int keyn = (key + 32 < khi) ? key + 32 : key;
#pragma unroll
                for (int db = 0; db < 2; ++db)
#pragma unroll
                    for (int s = 0; s < 2; ++s) vn[db][s] = *(const bf16x8*)(vb + (size_t)(db * 32 + r) * ldv + keyn + s * 16 + h * 8);
#pragma unroll
                for (int ks = 0; ks < 4; ++ks) kn[ks] = *(const bf16x8*)(kb + (size_t)(keyn + r) * K_LD + ks * 16 + h * 8);
                f32x16 S[2];
#pragma unroll
                for (int qi = 0; qi < 2; ++qi) {
#pragma unroll
                    for (int i = 0; i < 16; ++i) S[qi][i] = 0.f;
#pragma unroll
                    for (int ks = 0; ks < 4; ++ks) S[qi] = MFMA32(kf[ks], qf[qi][ks], S[qi]);
                }
                if (mask) {
#pragma unroll
                    for (int qi = 0; qi < 2; ++qi) { const int t = t0 + qi * 32 + r;
#pragma unroll
                        for (int i = 0; i < 16; ++i) { const int d = t - (key + crow(i, h)); if (d > 128 || d < -128) S[qi][i] = -1e30f; } }
                }
#pragma unroll
                for (int qi = 0; qi < 2; ++qi) {
                    float tm = S[qi][0];
#pragma unroll
                    for (int i = 1; i < 16; ++i) tm = fmaxf(tm, S[qi][i]);
                    tm = fmaxf(tm, __shfl_xor(tm, 32));
                    const float mn = fmaxf(mrow[qi], tm), alpha = __builtin_amdgcn_exp2f(mrow[qi] - mn);
                    mrow[qi] = mn;
                    float ps = 0.f;
#pragma unroll
                    for (int i = 0; i < 16; ++i) { S[qi][i] = __builtin_amdgcn_exp2f(S[qi][i] - mn); ps += S[qi][i]; }
                    lrow[qi] = lrow[qi] * alpha + ps;
#pragma unroll
                    for (int db = 0; db < 2; ++db)
#pragma unroll
                        for (int i = 0; i < 16; ++i) O[qi][db][i] *= alpha;
                    bf16x8 pk[2];
#pragma unroll
                    for (int s = 0; s < 2; ++s) { u32x4 w; w.x = cvtpk(S[qi][8 * s], S[qi][8 * s + 1]); w.y = cvtpk(S[qi][8 * s + 2], S[qi][8 * s + 3]); w.z = cvtpk(S[qi][8 * s + 4], S[qi][8 * s + 5]); w.w = cvtpk(S[qi][8 * s + 6], S[qi][8 * s + 7]); pk[s] = __builtin_bit_cast(bf16x8, w); }
#pragma unroll
                    for (int db = 0; db < 2; ++db)
#pragma unroll
                        for (int s = 0; s < 2; ++s) O[qi][db] = MFMA32(vf[db][s], pk[s], O[qi][db]);
                }
#pragma unroll
                for (int ks = 0; ks < 4; ++ks) kf[ks] = kn[ks];
#pragma unroll
                for (int db = 0; db < 2; ++db)
#pragma unroll
                    for (int s = 0; s < 2; ++s) vf[db][s] = vn[db][s];
            }
        }
#pragma unroll
        for (int qi = 0; qi < 2; ++qi) {
            const float lt = lrow[qi] + __shfl_xor(lrow[qi], 32), inv = 1.0f / lt;
#pragma unroll
            for (int db = 0; db < 2; ++db)
#pragma unroll
                for (int g4 = 0; g4 < 4; ++g4) { u32x2 w; w.x = cvtpk(O[qi][db][4 * g4] * inv, O[qi][db][4 * g4 + 1] * inv); w.y = cvtpk(O[qi][db][4 * g4 + 2] * inv, O[qi][db][4 * g4 + 3] * inv);
                    *(u32x2*)(Qp + (size_t)(qi * 32 + r) * DM + db * 32 + 8 * g4 + 4 * h) = w; }
        }
    }
}

__device__ __forceinline__ float wave_sum(float v) {
#pragma unroll
    for (int o = 1; o < 64; o <<= 1) v += __shfl_xor(v, o);
    return v;
}
__device__ __forceinline__ void prep_phase(const float* src0, const float* src1, const bf16_t* xb, bf16_t* H, const float* nw, const float* mods, int shoff, int scoff, int gw, int NGW, int lane) {
    for (int row = gw; row < NTOK; row += NGW) {
        const float* md = mods + (size_t)cond_of_row(row) * NMOD;
        f32x4 v[4]; float ss = 0.f;
        if (xb) {
#pragma unroll
            for (int q = 0; q < 2; ++q) { const u32x4 w = *(const u32x4*)(xb + (size_t)row * DM + 512 * q + 8 * lane);
                v[2 * q] = (f32x4){bf2f(w.x & 0xffffu), bf2f(w.x >> 16), bf2f(w.y & 0xffffu), bf2f(w.y >> 16)}; v[2 * q + 1] = (f32x4){bf2f(w.z & 0xffffu), bf2f(w.z >> 16), bf2f(w.w & 0xffffu), bf2f(w.w >> 16)}; }
        } else { const float* s = row < NCTX ? src0 + (size_t)row * DM : src1 + (size_t)(row - NCTX) * DM;
#pragma unroll
            for (int q = 0; q < 2; ++q) { v[2 * q] = *(const f32x4*)(s + 512 * q + 8 * lane); v[2 * q + 1] = *(const f32x4*)(s + 512 * q + 8 * lane + 4); } }
#pragma unroll
        for (int q = 0; q < 4; ++q) ss += (v[q][0] * v[q][0] + v[q][1] * v[q][1]) + (v[q][2] * v[q][2] + v[q][3] * v[q][3]);
        const float rstd = 1.0f / sqrtf(wave_sum(ss) * (1.0f / DM) + 1e-6f);
#pragma unroll
        for (int q = 0; q < 2; ++q) { const int c = 512 * q + 8 * lane; u32x4 w;
#pragma unroll
            for (int hh = 0; hh < 2; ++hh) { const f32x4 g4 = *(const f32x4*)(nw + c + 4 * hh), sc = *(const f32x4*)(md + scoff + c + 4 * hh), sh = *(const f32x4*)(md + shoff + c + 4 * hh);
                const f32x4 o = v[2 * q + hh] * rstd * g4 * (sc + 1.0f) + sh; w[2 * hh] = cvtpk(o[0], o[1]); w[2 * hh + 1] = cvtpk(o[2], o[3]); }
            *(u32x4*)(H + (size_t)row * DM + c) = w; }
    }
}
__device__ __forceinline__ void pool_phase(const bf16_t* H, bf16_t* P, int gw, int NGW, int lane) {
    for (int row = gw; row < NTOK; row += NGW) {
        int sb, t, L;
        if (row < NCTX) { sb = row & ~255; t = row & 255; L = 256; } else { const int lr = row - NCTX; sb = NCTX + (lr & ~4095); t = lr & 4095; L = 4096; }
#pragma unroll
        for (int q = 0; q < 2; ++q) { const int c8 = lane + 64 * q, grp = c8 >> 5, hw = 1 << grp;
            int st = t - hw; if (st < 0) st = 0; int en = t + hw; if (en > L) en = L;
            float a[8];
#pragma unroll
            for (int e = 0; e < 8; ++e) a[e] = 0.f;
            for (int jr = st; jr < en; ++jr) { const u32x4 w = *(const u32x4*)(H + (size_t)(sb + jr) * DM + c8 * 8);
#pragma unroll
                for (int e = 0; e < 4; ++e) { a[2 * e] += bf2f(w[e] & 0xffffu); a[2 * e + 1] += bf2f(w[e] >> 16); } }
            const float inv = 1.0f / (float)(en - st);
            const u32x4 w = *(const u32x4*)(H + (size_t)row * DM + c8 * 8); u32x4 o;
#pragma unroll
            for (int e = 0; e < 4; ++e) o[e] = cvtpk(a[2 * e] * inv - bf2f(w[e] & 0xffffu), a[2 * e + 1] * inv - bf2f(w[e] >> 16));
            *(u32x4*)(P + (size_t)row * DM + c8 * 8) = o; }
    }
}
__device__ __forceinline__ void fix_phase(const float* hal, bf16_t* A, const float* cw, const float* cb, int gt, int GT) {
    for (int it = gt; it < 120 * 704; it += GT) {
        const int bi = it / 704, c = (it % 704) * 4, b = bi / 15, i = bi % 15 + 1, pmh = 32 + b * 16 + i;
        const float* hl = hal + (size_t)(pmh - 1) * 4 * DFF2; const float* hh = hal + (size_t)pmh * 4 * DFF2;
        f32x4 cv1[2], cv2[2];
#pragma unroll
        for (int bj = 0; bj < 2; ++bj) { const int col = bj * DFF + c;
            const f32x4 uA = *(const f32x4*)(hl + 2 * DFF2 + col), uB = *(const f32x4*)(hl + 3 * DFF2 + col), uC = *(const f32x4*)(hh + col), uD = *(const f32x4*)(hh + DFF2 + col);
            const f32x4 w0 = *(const f32x4*)(cw + col), w1 = *(const f32x4*)(cw + DFF2 + col), w2 = *(const f32x4*)(cw + 2 * DFF2 + col), bb = *(const f32x4*)(cb + col);
            cv1[bj] = w0 * uA + w1 * uB + w2 * uC + bb; cv2[bj] = w0 * uB + w1 * uC + w2 * uD + bb; }
        const size_t R = (size_t)pmh * 256;
        u32x2 w; w.x = cvtpk(silu_mul(cv1[0][0], cv1[1][0]), silu_mul(cv1[0][1], cv1[1][1])); w.y = cvtpk(silu_mul(cv1[0][2], cv1[1][2]), silu_mul(cv1[0][3], cv1[1][3]));
        *(u32x2*)(A + (R - 1) * DFF + c) = w;
        w.x = cvtpk(silu_mul(cv2[0][0], cv2[1][0]), silu_mul(cv2[0][1], cv2[1][1])); w.y = cvtpk(silu_mul(cv2[0][2], cv2[1][2]), silu_mul(cv2[0][3], cv2[1][3]));
        *(u32x2*)(A + R * DFF + c) = w;
    }
}

__device__ __forceinline__ void transpose_item(const float* W, int K, int N, bf16_t* WT, int mapkind, LAS float* scr, int item, int lane) {
    const int nblk = N / 32, kb = item / nblk, nb = item % nblk, k0 = 64 * kb, n0 = 32 * nb;
    int d0 = n0;
    if (mapkind == 1) { const int head = n0 >> 6, bj = (n0 >> 5) & 1; d0 = 256 * (head >> 2) + 128 * bj + 32 * (head & 3); }
    else if (mapkind == 2) { const int bj = n0 >= DFF ? 1 : 0, cc = n0 - bj * DFF; d0 = 256 * (cc >> 7) + 128 * bj + (cc & 127); }
#pragma unroll 32
    for (int i = 0; i < 32; ++i) { const int kk = 2 * i + (lane >> 5); scr[kk * 33 + (lane & 31)] = W[(size_t)(k0 + kk) * N + n0 + (lane & 31)]; }
    asm volatile("s_waitcnt lgkmcnt(0)" ::: "memory");
    const int c = lane & 7;
#pragma unroll
    for (int jj = 0; jj < 4; ++jj) { const int n = (lane >> 3) + 8 * jj; const LAS float* s = scr + (8 * c) * 33 + n;
        u32x4 o; o.x = cvtpk(s[0 * 33], s[1 * 33]); o.y = cvtpk(s[2 * 33], s[3 * 33]); o.z = cvtpk(s[4 * 33], s[5 * 33]); o.w = cvtpk(s[6 * 33], s[7 * 33]);
        *(u32x4*)(WT + (size_t)(d0 + n) * K + k0 + 8 * c) = o; }
    asm volatile("s_waitcnt lgkmcnt(0)" ::: "memory");
}

enum { K_PRO = 0, K_PREP1, K_PREP2, K_QKV, K_ATTN, K_WO, K_POOLP, K_POOLG, K_CHAN, K_SEQC, K_SEQL, K_FFN1, K_FIX, K_FFN2, K_ST1, K_ST2, K_FFN2X };
#ifndef PROBE_DUP
#define PROBE_DUP(X, k)
#endif
#define PROG_LIST(X) X(K_PRO,0) \
    X(K_PREP1,0) X(K_QKV,0) X(K_ATTN,0) X(K_WO,0) X(K_PREP2,0) PROBE_DUP(X, 0) X(K_FFN1,0) X(K_FIX,0) X(K_FFN2,0) \
    X(K_PREP1,1) X(K_POOLP,1) X(K_POOLG,1) X(K_PREP2,1) PROBE_DUP(X, 1) X(K_FFN1,1) X(K_FIX,1) X(K_FFN2,1) \
    X(K_PREP1,2) X(K_CHAN,2) X(K_SEQC,2) X(K_ST1,2) X(K_ST2,2) X(K_PREP2,2) PROBE_DUP(X, 2) X(K_FFN1,2) X(K_FIX,2) X(K_FFN2,2) \
    X(K_PREP1,3) X(K_QKV,3) X(K_ATTN,3) X(K_WO,3) X(K_PREP2,3) PROBE_DUP(X, 3) X(K_FFN1,3) X(K_FIX,3) X(K_FFN2,3)
#define PROG_K(k, l) k,
#define PROG_L(k, l) l,
__constant__ unsigned char PROG_KIND[] = { PROG_LIST(PROG_K) };
__constant__ unsigned char PROG_LAYER[] = { PROG_LIST(PROG_L) };
static const unsigned char H_PROG_KIND[] = { PROG_LIST(PROG_K) };
constexpr int NSTEP = (int)sizeof(H_PROG_KIND);

struct Args { const float* in[22]; float* out; unsigned char* ws; int s_lo, s_hi; };

__global__ void __launch_bounds__(512, 2) mega_fwd(Args a) {
    extern __shared__ __attribute__((aligned(16))) unsigned char lds_raw[];
    LAS unsigned char* lds = (LAS unsigned char*)lds_raw;
    LAS unsigned char* xl = lds + LDS_X;
    cg::grid_group grid = cg::this_grid();
    volatile LAS unsigned* bst = (volatile LAS unsigned*)(lds + LDS_MISC);
    unsigned* bar = (unsigned*)(a.ws + WS_CTL);
    if (threadIdx.x < 4) bst[threadIdx.x] = 0u;
    __syncthreads();
    const unsigned xcc = xb_xcc_id();
    if (threadIdx.x == 0) (void)xb_add(&bar[XB_XCNT(xcc)], 1u);
    const int G = gridDim.x, NGW = G * 8, GT = G * 512;
    unsigned char* ws = a.ws; float* out = a.out;
    float* mods = (float*)(ws + WS_MODS);
    float* ropec = (float*)(ws + WS_ROPE); float* ropes = ropec + 1024;
    bf16_t* Hb = (bf16_t*)(ws + WS_H);
    bf16_t* BIG = (bf16_t*)(ws + WS_BIG);
    bf16_t* Qb = (bf16_t*)(ws + WS_Q); bf16_t* Kbuf = (bf16_t*)(ws + WS_K); bf16_t* VTb = (bf16_t*)(ws + WS_VT);
    float* hal = (float*)(ws + WS_HAL);

    for (int s = a.s_lo; s < a.s_hi; ++s) {
        int tid = threadIdx.x, bx = blockIdx.x;
        asm volatile("" : "+v"(tid), "+s"(bx));
        const int lane = tid & 63, wave = __builtin_amdgcn_readfirstlane(tid >> 6);
        const int vcu = (G % 8 == 0) ? (bx % 8) * (G / 8) + bx / 8 : bx;
        const int gw = vcu * 8 + wave, gt = bx * 512 + tid;
        const int kind = PROG_KIND[s], layer = PROG_LAYER[s], jl = layer / 3;
        const float* xs0 = a.in[0]; const float* xs1 = a.in[1];
        bf16_t* XB = (bf16_t*)(ws + WS_XB); const bf16_t* xbin = (s <= 4) ? nullptr : XB;
        const float* lmods = mods + (size_t)layer * 9 * NMOD;
        switch (kind) {
#ifndef NO_PRO
        case K_PRO: {
            LAS float* scond = (LAS float*)lds; LAS float* part = (LAS float*)(lds + 40960);
            for (int i = tid; i < 9 * 1024; i += 512) { const int cnd = i >> 10, k = i & 1023; const float v = cnd == 0 ? a.in[5][k] : a.in[4][(cnd - 1) * 1024 + k]; scond[i] = v / (1.0f + __expf(-v)); }
            __syncthreads();
            for (int item = bx; item < 384; item += G) {
                const int ly = item / 96, cb = item % 96;
                const float* w = a.in[8] + (size_t)ly * 1024 * NMOD + cb * 64 + lane;
                float ac[9];
#pragma unroll
                for (int c = 0; c < 9; ++c) ac[c] = 0.f;
                const int k0 = wave * 128;
#pragma unroll 32
                for (int kk = 0; kk < 128; ++kk) { const float wv = w[(size_t)(k0 + kk) * NMOD];
#pragma unroll
                    for (int c = 0; c < 9; ++c) ac[c] += wv * scond[c * 1024 + k0 + kk]; }
#pragma unroll
                for (int c = 0; c < 9; ++c) part[(wave * 9 + c) * 64 + lane] = ac[c];
                __syncthreads();
                for (int i = tid; i < 576; i += 512) { const int c = i >> 6, l = i & 63; float sm = a.in[9][ly * NMOD + cb * 64 + l];
#pragma unroll
                    for (int w8 = 0; w8 < 8; ++w8) sm += part[(w8 * 9 + c) * 64 + l];
                    mods[((size_t)ly * 9 + c) * NMOD + cb * 64 + l] = sm; }
                __syncthreads();
            }
            {
                LAS float* scr = (LAS float*)(lds + wave * 16384);
                constexpr int I_QKV = 16 * 48, I_WO = 16 * 32, I_POOL = 4 * 8, I_IN = 16 * 176, I_OUT = 44 * 32;
                constexpr int NIT = 2 * I_QKV + 2 * I_WO + 4 * I_POOL + 4 * I_IN + 4 * I_OUT;
                for (int it = gw; it < NIT; it += NGW) {
                    int r_ = it;
                    if (r_ < 4 * I_IN) { const int ly = r_ / I_IN; transpose_item(a.in[18] + (size_t)ly * DM * DFF2, DM, DFF2, (bf16_t*)(ws + WS_WIN) + (size_t)ly * DFF2 * DM, 2, scr, r_ % I_IN, lane); continue; } r_ -= 4 * I_IN;
                    if (r_ < 4 * I_OUT) { const int ly = r_ / I_OUT; transpose_item(a.in[21] + (size_t)ly * DFF * DM, DFF, DM, (bf16_t*)(ws + WS_WOUT) + (size_t)ly * DM * DFF, 0, scr, r_ % I_OUT, lane); continue; } r_ -= 4 * I_OUT;
                    if (r_ < 2 * I_QKV) { const int ly = r_ / I_QKV; transpose_item(a.in[10] + (size_t)ly * DM * NQKV, DM, NQKV, (bf16_t*)(ws + WS_WQKV) + (size_t)ly * NQKV * DM, 1, scr, r_ % I_QKV, lane); continue; } r_ -= 2 * I_QKV;
                    if (r_ < 2 * I_WO) { const int ly = r_ / I_WO; transpose_item(a.in[14] + (size_t)ly * DM * DM, DM, DM, (bf16_t*)(ws + WS_WO) + (size_t)ly * DM * DM, 0, scr, r_ % I_WO, lane); continue; } r_ -= 2 * I_WO;
                    { const int gp = r_ / I_POOL; transpose_item(a.in[15] + (size_t)gp * 65536, 256, 256, (bf16_t*)(ws + WS_WPOOL) + (size_t)gp * 65536, 0, scr, r_ % I_POOL, lane); }
                }
            }
            __syncthreads();
            LAS f32x2* TAB = (LAS f32x2*)lds;
            for (int k = tid; k < 4096; k += 512) { float sv, cv; sincospif((float)k * (1.0f / 2048.0f), &sv, &cv); TAB[k] = (f32x2){cv, sv}; }
            __syncthreads();
            { bf16_t* A1 = (bf16_t*)(ws + WS_A1);
                for (int it = gt; it < 32 * 256 * 32; it += GT) { const int p = it >> 13, j = (it >> 5) & 255, k0 = (it & 31) * 8, t1 = (j >> 1) & 63, bbl = j >> 7, ri = j & 1, part_ = (k0 >> 6) & 1, a0 = k0 & 63; float v[8];
#pragma unroll
                    for (int e = 0; e < 8; ++e) { const f32x2 cs = TAB[(t1 * (64 * (a0 + e) + 2 * p + bbl)) & 4095]; const float x = ri == 0 ? (part_ == 0 ? cs.x : -cs.y) : (part_ == 0 ? -cs.y : -cs.x); v[e] = ((k0 >> 7) == bbl) ? x * (1.0f / 64.0f) : 0.f; }
                    u32x4 o; o.x = cvtpk(v[0], v[1]); o.y = cvtpk(v[2], v[3]); o.z = cvtpk(v[4], v[5]); o.w = cvtpk(v[6], v[7]); *(u32x4*)(A1 + (size_t)it * 8) = o; }
                bf16_t* A2 = (bf16_t*)(ws + WS_A2);
                for (int it = gt; it < 256 * 64; it += GT) { const int r_ = it >> 6, k0 = (it & 63) * 8, t1l = r_ >> 6, t2 = r_ & 63; float v[8];
#pragma unroll
                    for (int e = 0; e < 8; ++e) { const int k = k0 + e, bb = k >> 3; const f32x2 cs = TAB[((t2 * bb) & 63) * 64]; v[e] = (((k >> 1) & 3) == t1l) ? ((k & 1) ? cs.y : cs.x) : 0.f; }
                    u32x4 o; o.x = cvtpk(v[0], v[1]); o.y = cvtpk(v[2], v[3]); o.z = cvtpk(v[4], v[5]); o.w = cvtpk(v[6], v[7]); *(u32x4*)(A2 + (size_t)it * 8) = o; }
                bf16_t* D2 = (bf16_t*)(ws + WS_DFT256);
                for (int it = gt; it < 256 * 64; it += GT) { const int t = it >> 6, j0 = (it & 63) * 8, part_ = j0 >= 256, jj = j0 & 255; float v[8];
#pragma unroll
                    for (int e = 0; e < 8; ++e) { const f32x2 cs = TAB[((t * (jj + e)) & 255) * 16]; v[e] = (part_ ? -cs.y : cs.x) * (1.0f / 16.0f); }
                    u32x4 o; o.x = cvtpk(v[0], v[1]); o.y = cvtpk(v[2], v[3]); o.z = cvtpk(v[4], v[5]); o.w = cvtpk(v[6], v[7]); *(u32x4*)(D2 + (size_t)t * 512 + j0) = o; }
            }
            { LAS float* wt = (LAS float*)(lds + 32768); bf16_t* WCS = (bf16_t*)(ws + WS_WCS);
                for (int item = bx; item < 256; item += G) {
                    const int gp = item >> 6, n0 = (item & 63) * 16;
                    for (int i = tid; i < 4096; i += 512) wt[i] = a.in[17][(size_t)(gp * 256 + (i >> 4)) * DM + n0 + (i & 15)];
                    __syncthreads();
                    const int nn = tid & 15, cg_ = tid >> 4;
                    float ac[8], as[8];
#pragma unroll
                    for (int e = 0; e < 8; ++e) { ac[e] = 0.f; as[e] = 0.f; }
                    for (int cp = 0; cp < 256; ++cp) { const float wv = wt[cp * 16 + nn];
#pragma unroll
                        for (int e = 0; e < 8; ++e) { const f32x2 cs = TAB[(((cg_ * 8 + e) * cp) & 255) * 16]; ac[e] += wv * cs.x; as[e] += wv * cs.y; } }
                    u32x4 o; o.x = cvtpk(ac[0] * 0.0625f, ac[1] * 0.0625f); o.y = cvtpk(ac[2] * 0.0625f, ac[3] * 0.0625f); o.z = cvtpk(ac[4] * 0.0625f, ac[5] * 0.0625f); o.w = cvtpk(ac[6] * 0.0625f, ac[7] * 0.0625f);
                    *(u32x4*)(WCS + (size_t)(n0 + nn) * DM + gp * 256 + cg_ * 8) = o;
                    o.x = cvtpk(as[0] * 0.0625f, as[1] * 0.0625f); o.y = cvtpk(as[2] * 0.0625f, as[3] * 0.0625f); o.z = cvtpk(as[4] * 0.0625f, as[5] * 0.0625f); o.w = cvtpk(as[6] * 0.0625f, as[7] * 0.0625f);
                    *(u32x4*)(WCS + (size_t)(1024 + n0 + nn) * DM + gp * 256 + cg_ * 8) = o;
                    __syncthreads();
                }
            }
            for (int i = gt; i < 1024; i += GT) { const int pos = i >> 4, f = i & 15; const float invf = 1.0f / powf(10000.0f, (float)f * (1.0f / 16.0f)); float sv, cv; sincosf((float)pos * invf, &sv, &cv); ropec[i] = cv; ropes[i] = sv; }
            { bf16_t* CKb = (bf16_t*)(ws + WS_CK); bf16_t* CVTb = (bf16_t*)(ws + WS_CVT);
                for (int it = gt; it < 262144; it += GT) { const f32x4 v0 = *(const f32x4*)(a.in[2] + (size_t)it * 8), v1 = *(const f32x4*)(a.in[2] + (size_t)it * 8 + 4);
                    u32x4 o; o.x = cvtpk(v0[0], v0[1]); o.y = cvtpk(v0[2], v0[3]); o.z = cvtpk(v1[0], v1[1]); o.w = cvtpk(v1[2], v1[3]); *(u32x4*)(CKb + (size_t)(it >> 5) * K_LD + (it & 31) * 8) = o; }
                for (int it = gt; it < 262144; it += GT) { const int d = it & 63, chunk = (it >> 6) & 63, kvh = (it >> 12) & 3, bj2 = it >> 14, g16 = chunk >> 1, hh = chunk & 1; float v[8];
#pragma unroll
                    for (int e = 0; e < 8; ++e) { const int pos = 16 * g16 + 4 * hh + (e & 3) + 8 * (e >> 2); v[e] = a.in[3][((size_t)(bj2 * 512 + pos) * 4 + kvh) * 64 + d]; }
                    u32x4 o; o.x = cvtpk(v[0], v[1]); o.y = cvtpk(v[2], v[3]); o.z = cvtpk(v[4], v[5]); o.w = cvtpk(v[6], v[7]); *(u32x4*)(CVTb + ((size_t)(bj2 * 4 + kvh) * 64 + d) * CVT_LD + chunk * 8) = o; }
            }
        } break;
#endif
        case K_PREP1: prep_phase(xs0, xs1, xbin, Hb, a.in[6] + layer * DM, lmods, 0, 1024, gw, NGW, lane); break;
        case K_PREP2: prep_phase(xs0, xs1, xbin, Hb, a.in[7] + layer * DM, lmods, 3072, 4096, gw, NGW, lane); break;
        case K_POOLP: pool_phase(Hb, BIG, gw, NGW, lane); break;
        case K_FIX: fix_phase(hal, BIG, a.in[19] + (size_t)layer * 3 * DFF2, a.in[20] + (size_t)layer * DFF2, gt, GT); break;
#ifndef NO_ATTN
        case K_ATTN: attn_phase(Qb, Kbuf, VTb, (const bf16_t*)(ws + WS_CK), (const bf16_t*)(ws + WS_CVT), a.in[13] + jl * 16, jl, vcu, G, wave, lane); break;
#endif
#ifndef NO_QKV
        case K_QKV: {
            pg8::Gemm g{(const char*)Hb, (const char*)(ws + WS_WQKV) + (size_t)jl * NQKV * DM * 2, DM, DM, DM, 160, 6, 160, 0, 0};
            pg8::Order S; S.init(160, 6, G, bx);
            pg8::EpiQKV E{Qb, Kbuf, VTb, out + OUT_CK + (size_t)jl * 65536, out + OUT_CV + (size_t)jl * 65536, a.in[11] + jl * 64, a.in[12] + jl * 64, ropec, ropes};
            pg8::gemm_phase<pg8::EpiQKV>(lds, xl, g, S, E, tid);
        } break;
#endif
#ifndef NO_CHAN
        case K_CHAN: {
            for (int v = 0; v < 2; ++v) {
                pg8::Gemm g{(const char*)(ws + WS_WCS), (const char*)(Hb + (size_t)(v ? NCTX : 0) * DM), DM, DM, DM, 8, v ? 128 : 32, 8, 0, 0};
                g.bperm = v;
                pg8::Order S; S.init(8, v ? 128 : 32, G, bx);
                pg8::EpiChan E{(bf16_t*)(ws + (v ? WS_PTL : WS_PTC)), v};
                pg8::gemm_phase<pg8::EpiChan>(lds, xl, g, S, E, tid);
            }
        } break;
#endif
        case K_ST1: {
            pg8::Gemm g{(const char*)(ws + WS_PTL), (const char*)(ws + WS_A1), 8192, 256, 256, 32, 32, 32, 512, 0};
            pg8::Order S; S.init(32, 32, G, bx);
            pg8::EpiY1 E{(bf16_t*)(ws + WS_YT)};
            pg8::gemm_phase<pg8::EpiY1>(lds, xl, g, S, E, tid);
        } break;
#ifndef NO_FFN1
        case K_FFN1: {
            pg8::Gemm g{(const char*)Hb, (const char*)(ws + WS_WIN) + (size_t)layer * DFF2 * DM * 2, DM, DM, DM, 160, 22, 160, 0, 0};
            pg8::Order S; S.init(160, 22, G, bx);
            pg8::EpiFfn1 E{BIG, hal, a.in[19] + (size_t)layer * 3 * DFF2, a.in[20] + (size_t)layer * DFF2};
            pg8::gemm_phase<pg8::EpiFfn1>(lds, xl, g, S, E, tid);
        } break;
#endif
#ifndef NO_RES
        default: {
            pg8::Gemm g; pg8::EpiRes E; E.src0 = xs0; E.src1 = xs1; E.xin = xbin; { const bool last_ = (kind == K_FFN2 && layer == 3); E.xout = last_ ? nullptr : XB; E.dst = last_ ? out : nullptr; } E.pscale = nullptr; E.pm0 = 0; E.rowmap = 0; E.gate = lmods + 2048;
            g.akoff = 0; g.bstride = 0;
            if (kind == K_WO) { g.A = (const char*)Qb; g.Bt = (const char*)(ws + WS_WO) + (size_t)jl * DM * DM * 2; g.lda = DM; g.ldb = DM; g.K = DM; g.nM = 160; g.nN = 4; g.amod = 160; }
            else if (kind == K_POOLG) { g.A = (const char*)BIG; g.Bt = (const char*)(ws + WS_WPOOL); g.lda = DM; g.ldb = 256; g.K = 256; g.nM = 160; g.nN = 4; g.amod = 160; g.akoff = 512; E.pscale = a.in[16]; }
            else if (kind == K_SEQC) { g.A = (const char*)(ws + WS_DFT256); g.Bt = (const char*)(ws + WS_PTC); g.lda = 512; g.ldb = 512; g.K = 512; g.nM = 32; g.nN = 4; g.amod = 1; g.bmod = 1; g.bstride = (size_t)256 * 2048 * 2; }
            else if (kind == K_ST2) { g.A = (const char*)(ws + WS_A2); g.Bt = (const char*)(ws + WS_YT); g.lda = 512; g.ldb = 8192; g.K = 512; g.nM = 128; g.nN = 4; g.amod = 1; g.bmod = 16; g.bstride = (size_t)1024 * 8192 * 2; g.bstride2 = 16; g.bkc = 256; E.rowmap = 1; }
            else { g.A = (const char*)BIG; g.Bt = (const char*)(ws + WS_WOUT) + (size_t)layer * DM * DFF * 2; g.lda = DFF; g.ldb = DFF; g.K = DFF; g.nM = 160; g.nN = 4; g.amod = 160; E.gate = lmods + 5120; }
            pg8::Order S; S.init(g.nM, g.nN, G, bx);
            const int nfull = (S.nwg / G) * G, rem = S.nwg - nfull;
            if (rem > 0 && 2 * rem <= G && (G & 1) == 0) {
                S.hi = nfull; if (nfull > 0) pg8::gemm_phase<pg8::EpiRes>(lds, xl, g, S, E, tid);
                S.lo = nfull; S.hi = S.nwg; S.G = G >> 1; S.c = bx >> 1;
                if (bx & 1) pg8::gemm_phase<pg8::EpiRes, 2>(lds, xl, g, S, E, tid); else pg8::gemm_phase<pg8::EpiRes, 1>(lds, xl, g, S, E, tid);
            } else pg8::gemm_phase<pg8::EpiRes>(lds, xl, g, S, E, tid);
        } break;
#endif
        }
        if (s + 1 < a.s_hi && kind != K_SEQC) { if (s == a.s_lo) grid.sync(); else xcd_barrier(bar, xcc, bst); }
    }
}

extern "C" void kernel_launch(void* const* d_in, const int* in_sizes, int n_in, void* d_out, int out_size, void* d_ws, size_t ws_size, hipStream_t stream) {
    static int grid = 0;
    if (grid == 0) {
        if (n_in != 22 || ws_size < WS_END) { fprintf(stderr, "kernel_launch: unexpected n_in %d or ws_size %zu (< %zu)\n", n_in, ws_size, (size_t)WS_END); grid = -1; return; }
        int dev = 0, cus = 0, per_cu = 0;
        hipGetDevice(&dev); hipDeviceGetAttribute(&cus, hipDeviceAttributeMultiprocessorCount, dev);
        if (hipFuncSetAttribute((const void*)mega_fwd, hipFuncAttributeMaxDynamicSharedMemorySize, LDS_BYTES) != hipSuccess) { fprintf(stderr, "kernel_launch: hipFuncSetAttribute failed\n"); grid = -1; return; }
        if (hipOccupancyMaxActiveBlocksPerMultiprocessor(&per_cu, (const void*)mega_fwd, 512, LDS_BYTES) != hipSuccess || per_cu < 1) { fprintf(stderr, "kernel_launch: occupancy query says %d\n", per_cu); per_cu = 1; }
        (void)hipGetLastError();
        grid = cus * 1;
    }
    if (grid < 0) return;
    if (hipMemsetAsync((char*)d_ws + WS_CTL, 0, CTL_BYTES, stream) != hipSuccess) { fprintf(stderr, "kernel_launch: memset failed\n"); return; }
    Args a{};
    for (int i = 0; i < 22; ++i) a.in[i] = (const float*)d_in[i];
    a.out = (float*)d_out; a.ws = (unsigned char*)d_ws;
#if MK_MULTI
    for (int s = 0; s < NSTEP;) {
        int e = s + 1; if (H_PROG_KIND[s] == K_SEQC) e = s + 2;
        a.s_lo = s; a.s_hi = e; void* args[] = {&a};
        hipError_t err = hipLaunchCooperativeKernel((const void*)mega_fwd, dim3(grid), dim3(512), args, LDS_BYTES, stream);
        if (err != hipSuccess) { fprintf(stderr, "kernel_launch: cooperative launch failed: %s\n", hipGetErrorString(err)); break; }
        s = e;
    }
#else
    a.s_lo = 0; a.s_hi = NSTEP; void* args[] = {&a};
    hipError_t err = hipLaunchCooperativeKernel((const void*)mega_fwd, dim3(grid), dim3(512), args, LDS_BYTES, stream);
    if (err != hipSuccess) fprintf(stderr, "kernel_launch: cooperative launch failed: %s (grid %d)\n", hipGetErrorString(err), grid);
#endif
}
```

```cpp
#include <hip/hip_runtime.h>
#include <hip/hip_cooperative_groups.h>
#include <cstdio>
#include <cstdint>
namespace cg = cooperative_groups;

#ifndef MK_MULTI
#define MK_MULTI 0
#endif

#define LAS __attribute__((address_space(3)))
typedef unsigned short bf16_t;
typedef short bf16x8 __attribute__((ext_vector_type(8)));
typedef float f32x2 __attribute__((ext_vector_type(2)));
typedef float f32x4 __attribute__((ext_vector_type(4)));
typedef float f32x16 __attribute__((ext_vector_type(16)));
typedef unsigned u32x2 __attribute__((ext_vector_type(2)));
typedef unsigned u32x4 __attribute__((ext_vector_type(4)));
typedef __bf16 bf16x2_t __attribute__((ext_vector_type(2)));

constexpr int DM = 1024, NCTX = 8192, NTOK = 40960, DFF = 2816, DFF2 = 5632, NQKV = 1536, NMOD = 6144;
constexpr float LOG2E = 1.4426950408889634f;
constexpr float QSCALE = 0.125f * LOG2E;

constexpr size_t MiB = 1u << 20;
constexpr size_t WS_MODS = 0;
constexpr size_t WS_ROPE = 1 * MiB;
constexpr size_t WS_DFT256 = 1 * MiB + 64 * 1024;
constexpr size_t WS_WQKV = 2 * MiB;
constexpr size_t WS_WO = 8 * MiB;
constexpr size_t WS_WPOOL = 12 * MiB;
constexpr size_t WS_WCS = 13 * MiB;
constexpr size_t WS_WIN = 17 * MiB;
constexpr size_t WS_WOUT = 61 * MiB;
constexpr size_t WS_CK = 83 * MiB;
constexpr size_t WS_CVT = 488 * MiB;
constexpr int K_LD = 272;
constexpr int VT_LDC = 288, VT_LDL = 4160, CVT_LD = 544;
constexpr size_t VT_CTX_SEQ = (size_t)256 * VT_LDC, VT_LAT_BASE = 32 * VT_CTX_SEQ, VT_LAT_SEQ = (size_t)256 * VT_LDL;
constexpr size_t WS_HAL = 88 * MiB;
constexpr size_t WS_A1 = 102 * MiB;
constexpr size_t WS_A2 = 106 * MiB;
constexpr size_t WS_XB = 107 * MiB;
constexpr size_t WS_YT = 187 * MiB;
constexpr size_t WS_H = 187 * MiB;
constexpr size_t WS_BIG = 267 * MiB;
constexpr size_t WS_PTC = WS_BIG + 60 * MiB, WS_PTL = WS_BIG + 92 * MiB;
constexpr size_t WS_Q = WS_BIG, WS_K = WS_BIG + 80 * MiB, WS_VT = WS_BIG + 104 * MiB;
constexpr size_t WS_CTL = 487 * MiB;
constexpr size_t CTL_BYTES = 64 * 1024;
constexpr size_t WS_END = 494 * MiB;

constexpr size_t OUT_CK = (size_t)NTOK * DM;
constexpr size_t OUT_CV = OUT_CK + (size_t)32 * 2 * 256 * 256;

constexpr int LDS_RING = 131072, LDS_X = 131072, LDS_MISC = 131072 + 8192, LDS_BYTES = 147456;

__device__ __forceinline__ unsigned cvtpk(float lo, float hi) { f32x2 v = {lo, hi}; bf16x2_t b = __builtin_convertvector(v, bf16x2_t); return __builtin_bit_cast(unsigned, b); }
__device__ __forceinline__ bf16_t f2bf(float f) { return (bf16_t)(cvtpk(f, 0.f) & 0xffffu); }
__device__ __forceinline__ float bf2f(unsigned v) { return __uint_as_float(v << 16); }
__device__ __forceinline__ float dpp_prev(float v) { return __int_as_float(__builtin_amdgcn_update_dpp(0, __float_as_int(v), 0x121, 0xf, 0xf, false)); }
__device__ __forceinline__ float dpp_next(float v) { return __int_as_float(__builtin_amdgcn_update_dpp(0, __float_as_int(v), 0x12F, 0xf, 0xf, false)); }
__device__ __forceinline__ f32x4 dpp_prev4(f32x4 v) { return (f32x4){dpp_prev(v[0]), dpp_prev(v[1]), dpp_prev(v[2]), dpp_prev(v[3])}; }
__device__ __forceinline__ f32x4 dpp_next4(f32x4 v) { return (f32x4){dpp_next(v[0]), dpp_next(v[1]), dpp_next(v[2]), dpp_next(v[3])}; }
__device__ __forceinline__ float silu_mul(float g, float v) { const float e = __builtin_amdgcn_exp2f(-g * LOG2E); return g * __builtin_amdgcn_rcpf(1.0f + e) * v; }
__device__ __forceinline__ int cond_of_row(int row) { return row < NCTX ? 0 : 1 + ((row - NCTX) >> 12); }

namespace pg8 {
constexpr int BM = 256, BK = 64, HALF = 128, HTB = HALF * BK * 2, NXCD = 8, WGM = 8;
__device__ __forceinline__ int lds_byte(int r, int c) { const int st = (r >> 4) * 2 + (c >> 5), rr = r & 15, cc = c & 31, ob = rr * 64 + cc * 2; return st * 1024 + (ob ^ (((ob >> 9) & 1) << 5)); }
__device__ __forceinline__ void stage_rc(int b, int& R, int& C) { const int st = b / 1024, sb = b % 1024, swz = sb ^ (((sb >> 9) & 1) << 5); R = (st >> 1) * 16 + swz / 64; C = (st & 1) * 32 + (swz % 64) / 2; }
__device__ __forceinline__ int perm32(int rho) { const int n = rho >> 4, i = rho & 15; return 8 * (i >> 2) + 4 * n + (i & 3); }

struct Unit { int pm, pn, half; };
struct Gemm { const char* A; const char* Bt; int lda, ldb, K, nM, nN, amod, akoff; size_t bstride; int bmod = 1 << 30; size_t bstride2 = 0; int bperm = 0; int bkc = 16; };
__device__ __forceinline__ const char* aptr(const Gemm& g, const Unit& u) { return g.A + (size_t)(u.pm % g.amod) * (size_t)512 * g.lda + (size_t)u.pn * g.akoff; }
__device__ __forceinline__ const char* bptr(const Gemm& g, const Unit& u) {
    if (g.bperm) return g.Bt + (size_t)((u.pn >> 4) * 4096 + 4 * (u.pn & 15)) * (size_t)2 * g.ldb;
    return g.Bt + (size_t)(u.pm / g.bmod) * g.bstride + (size_t)(u.pm % g.bmod) * g.bstride2 + (size_t)u.pn * (size_t)512 * g.ldb; }

struct Order {
    int nM, nN, nwg, G, c, lo, hi;
    __device__ __forceinline__ void init(int nM_, int nN_, int G_, int c_) { nM = nM_; nN = nN_; nwg = nM * nN; G = G_; c = c_; lo = 0; hi = nwg; }
    __device__ __forceinline__ bool next(int i, Unit& u) const {
        const long L = (long)lo + (long)i * G + c; if (L >= hi) return false;
        int wgid = (int)L; u.half = 0; { const int q = nwg / NXCD, r = nwg % NXCD, xcd = wgid % NXCD, off = wgid / NXCD; wgid = (xcd < r ? xcd * (q + 1) : r * (q + 1) + (xcd - r) * q) + off; }
        const int nig = WGM * nN, gid = wgid / nig, fm = gid * WGM, gsz = (nM - fm) < WGM ? (nM - fm) : WGM;
        u.pm = fm + ((wgid % nig) % gsz); u.pn = (wgid % nig) / gsz; return true;
    }
};


struct EpiRes {
    static constexpr bool PERM = true;
    const float* src0; const float* src1;
    const bf16_t* xin; bf16_t* xout;
    float* dst;
    const float* gate; const float* pscale; int pm0; int rowmap;
    __device__ __forceinline__ void operator()(f32x4 (&acc)[2][2][4][2], const Unit& u, int wr, int wc, int fr, int fq, LAS unsigned char*) const {
        asm volatile("" : "+v"(fr), "+v"(fq), "+s"(wr), "+s"(wc));
        const int rowt = rowmap ? NCTX + (u.pm >> 4) * 4096 + 4 * (u.pm & 15) : (pm0 + u.pm) * BM; const float* g = gate + (size_t)cond_of_row(rowt) * NMOD;
        const int col0 = u.pn * BM + wc * 32 + 8 * fq;
        f32x4 gv[2][2];
#pragma unroll
        for (int bj = 0; bj < 2; ++bj)
#pragma unroll
            for (int n = 0; n < 2; ++n) { gv[bj][n] = *(const f32x4*)(g + col0 + bj * HALF + n * 4); if (pscale) gv[bj][n] = gv[bj][n] * *(const f32x4*)(pscale + col0 + bj * HALF + n * 4); }
#pragma unroll
        for (int ai = 0; ai < 2; ++ai) { if (u.half == 2 - ai) continue;
#pragma unroll
            for (int m = 0; m < 4; ++m) {
                const int row = rowmap ? rowt + 2 * ai + wr + 64 * (16 * m + fr) : rowt + ai * HALF + wr * 64 + m * 16 + fr;
#pragma unroll
                for (int bj = 0; bj < 2; ++bj) {
                    f32x4 x0, x1;
                    if (xin) { const u32x4 w = *(const u32x4*)(xin + (size_t)row * DM + col0 + bj * HALF);
                        x0 = (f32x4){bf2f(w.x & 0xffffu), bf2f(w.x >> 16), bf2f(w.y & 0xffffu), bf2f(w.y >> 16)}; x1 = (f32x4){bf2f(w.z & 0xffffu), bf2f(w.z >> 16), bf2f(w.w & 0xffffu), bf2f(w.w >> 16)}; }
                    else { const float* s = (row < NCTX ? src0 + (size_t)row * DM : src1 + (size_t)(row - NCTX) * DM) + col0 + bj * HALF; x0 = *(const f32x4*)s; x1 = *(const f32x4*)(s + 4); }
                    x0 = x0 + gv[bj][0] * acc[ai][bj][m][0]; x1 = x1 + gv[bj][1] * acc[ai][bj][m][1];
                    if (xout) { u32x4 w; w.x = cvtpk(x0[0], x0[1]); w.y = cvtpk(x0[2], x0[3]); w.z = cvtpk(x1[0], x1[1]); w.w = cvtpk(x1[2], x1[3]); *(u32x4*)(xout + (size_t)row * DM + col0 + bj * HALF) = w; }
                    if (dst) { float* d = dst + (size_t)row * DM + col0 + bj * HALF; *(f32x4*)d = x0; *(f32x4*)(d + 4) = x1; }
                }
            } }
    }
};

struct EpiQKV {
    static constexpr bool PERM = false;
    bf16_t* Q; bf16_t* Kb; bf16_t* VT; float* ock; float* ocv; const float* qn; const float* kn; const float* ropec; const float* ropes;
    __device__ __forceinline__ void operator()(f32x4 (&acc)[2][2][4][2], const Unit& u, int wr, int wc, int fr, int fq, LAS unsigned char*) const {
        asm volatile("" : "+v"(fr), "+v"(fq), "+s"(wr), "+s"(wc));

        const int rowt = u.pm * BM; const bool lat = rowt >= NCTX; const int dl = 4 * fq;
        if (u.pn < 5) {
            const bool isq = u.pn < 4; const float* nw = isq ? qn : kn;
            f32x4 nwv[2][2];
#pragma unroll
            for (int bj = 0; bj < 2; ++bj)
#pragma unroll
                for (int n = 0; n < 2; ++n) nwv[bj][n] = *(const f32x4*)(nw + 32 * bj + 16 * n + dl);
#pragma unroll
            for (int ai = 0; ai < 2; ++ai)
#pragma unroll
                for (int m = 0; m < 4; ++m) {
                    const int row = rowt + ai * HALF + wr * 64 + m * 16 + fr;
                    float ss = 0.f;
#pragma unroll
                    for (int bj = 0; bj < 2; ++bj)
#pragma unroll
                        for (int n = 0; n < 2; ++n) { const f32x4 v = acc[ai][bj][m][n]; ss += (v[0] * v[0] + v[1] * v[1]) + (v[2] * v[2] + v[3] * v[3]); }
                    ss += __shfl_xor(ss, 16); ss += __shfl_xor(ss, 32);
                    const float rstd = 1.0f / sqrtf(ss * (1.0f / 64.0f) + 1e-6f);
                    f32x4 y[2][2];
#pragma unroll
                    for (int bj = 0; bj < 2; ++bj)
#pragma unroll
                        for (int n = 0; n < 2; ++n) y[bj][n] = acc[ai][bj][m][n] * rstd * nwv[bj][n];
                    if (!isq && !lat) {
                        float* p = ock + (size_t)(row >> 8) * 131072 + (size_t)(row & 255) * 256 + wc * 64 + dl;
#pragma unroll
                        for (int bj = 0; bj < 2; ++bj)
#pragma unroll
                            for (int n = 0; n < 2; ++n) *(f32x4*)(p + 32 * bj + 16 * n) = y[bj][n];
                    }
                    if (lat) {
                        const int lr = row - NCTX, pr = (lr & 4095) >> 6, pc = lr & 63;
#pragma unroll
                        for (int bj = 0; bj < 2; ++bj) {
                            const int pos = bj ? pc : pr;
                            const f32x4 c4 = *(const f32x4*)(ropec + pos * 16 + dl), s4 = *(const f32x4*)(ropes + pos * 16 + dl);
                            const f32x4 x1 = y[bj][0], x2 = y[bj][1];
                            y[bj][0] = x1 * c4 - x2 * s4; y[bj][1] = x1 * s4 + x2 * c4;
                        }
                    }
                    bf16_t* dstp;
                    if (isq) { dstp = Q + (size_t)row * DM + (4 * u.pn + wc) * 64 + dl;
#pragma unroll
                        for (int bj = 0; bj < 2; ++bj)
#pragma unroll
                            for (int n = 0; n < 2; ++n) y[bj][n] = y[bj][n] * QSCALE;
                    } else dstp = Kb + (size_t)row * K_LD + wc * 64 + dl;
#pragma unroll
                    for (int bj = 0; bj < 2; ++bj)
#pragma unroll
                        for (int n = 0; n < 2; ++n) { u32x2 w; w.x = cvtpk(y[bj][n][0], y[bj][n][1]); w.y = cvtpk(y[bj][n][2], y[bj][n][3]); *(u32x2*)(dstp + 32 * bj + 16 * n) = w; }
                }
        } else {
#pragma unroll
            for (int ai = 0; ai < 2; ++ai)
#pragma unroll
                for (int m = 0; m < 4; ++m) {
                    const int row = rowt + ai * HALF + wr * 64 + m * 16 + fr;
                    if (!lat) {
                        float* p = ocv + (size_t)(row >> 8) * 131072 + (size_t)(row & 255) * 256 + wc * 64 + dl;
#pragma unroll
                        for (int bj = 0; bj < 2; ++bj)
#pragma unroll
                            for (int n = 0; n < 2; ++n) *(f32x4*)(p + 32 * bj + 16 * n) = acc[ai][bj][m][n];
                    }
                    size_t sb; int pos, L;
                    if (lat) { const int lr = row - NCTX; sb = VT_LAT_BASE + (size_t)(lr >> 12) * VT_LAT_SEQ; pos = lr & 4095; L = VT_LDL; } else { sb = (size_t)(row >> 8) * VT_CTX_SEQ; pos = row & 255; L = VT_LDC; }
                    const int k16 = pos & 15, pp = (pos & ~15) + 8 * ((k16 >> 2) & 1) + (k16 & 3) + 4 * (k16 >> 3);
                    bf16_t* base = VT + sb + (size_t)(wc * 64 + dl) * L + pp;
#pragma unroll
                    for (int bj = 0; bj < 2; ++bj)
#pragma unroll
                        for (int n = 0; n < 2; ++n)
#pragma unroll
                            for (int e = 0; e < 4; ++e) base[(size_t)(32 * bj + 16 * n + e) * L] = f2bf(acc[ai][bj][m][n][e]);
                }
        }
    }
};

struct EpiChan {
    static constexpr bool PERM = true;
    bf16_t* PT; int lat;
    __device__ __forceinline__ void operator()(f32x4 (&acc)[2][2][4][2], const Unit& u, int wr, int wc, int fr, int fq, LAS unsigned char*) const {
        asm volatile("" : "+v"(fr), "+v"(fq), "+s"(wr), "+s"(wc));
#pragma unroll
        for (int ai = 0; ai < 2; ++ai)
#pragma unroll
            for (int m = 0; m < 4; ++m) {
                const int row = u.pm * BM + ai * HALF + wr * 64 + m * 16 + fr, part = row >> 10, n_ = row & 1023;
#pragma unroll
                for (int bj = 0; bj < 2; ++bj) {
                    bf16_t* d;
                    if (lat) d = PT + (size_t)(u.pn >> 4) * (1024 * 8192) + (size_t)n_ * 8192 + (4 * (u.pn & 15) + 2 * bj + (wc >> 1)) * 128 + part * 64 + (wc & 1) * 32 + 8 * fq;
                    else d = PT + (size_t)u.pn * (256 * 2048) + (size_t)n_ * 512 + part * 256 + bj * HALF + wc * 32 + 8 * fq;
                    const f32x4 v0 = acc[ai][bj][m][0], v1 = acc[ai][bj][m][1]; u32x4 w; w.x = cvtpk(v0[0], v0[1]); w.y = cvtpk(v0[2], v0[3]); w.z = cvtpk(v1[0], v1[1]); w.w = cvtpk(v1[2], v1[3]); *(u32x4*)d = w; }
            }
    }
};

struct EpiY1 {
    static constexpr bool PERM = true;
    bf16_t* YT;
    __device__ __forceinline__ void operator()(f32x4 (&acc)[2][2][4][2], const Unit& u, int wr, int wc, int fr, int fq, LAS unsigned char*) const {
        asm volatile("" : "+v"(fr), "+v"(fq), "+s"(wr), "+s"(wc));
#pragma unroll
        for (int ai = 0; ai < 2; ++ai)
#pragma unroll
            for (int m = 0; m < 4; ++m) {
                bf16_t* d = YT + (size_t)(u.pm * BM + ai * HALF + wr * 64 + m * 16 + fr) * 8192 + u.pn * BM + wc * 32 + 8 * fq;
#pragma unroll
                for (int bj = 0; bj < 2; ++bj) { const f32x4 v0 = acc[ai][bj][m][0], v1 = acc[ai][bj][m][1]; u32x4 w; w.x = cvtpk(v0[0], v0[1]); w.y = cvtpk(v0[2], v0[3]); w.z = cvtpk(v1[0], v1[1]); w.w = cvtpk(v1[2], v1[3]); *(u32x4*)(d + bj * HALF) = w; }
            }
    }
};

struct EpiFfn1 {
    static constexpr bool PERM = true;
    bf16_t* Aout; float* hal; const float* cw; const float* cb;
    __device__ __forceinline__ void operator()(f32x4 (&acc)[2][2][4][2], const Unit& u, int wr, int wc, int fr, int fq, LAS unsigned char* xl) const {
        asm volatile("" : "+v"(fr), "+v"(fq), "+s"(wr), "+s"(wc));

        LAS float* X = (LAS float*)xl;
        const int chl = wc * 32 + 8 * fq;
        LAS float* WL = (LAS float*)(xl + 9216);
        { const int t2 = (wr * 4 + wc) * 64 + fq * 16 + fr;
#pragma unroll
            for (int q = 0; q < 2; ++q) { const int idx = t2 + 512 * q, k = idx >> 8, c = idx & 255, col = (c >> 7) * DFF + u.pn * 128 + (c & 127); WL[idx] = (k < 3) ? cw[(size_t)k * DFF2 + col] : cb[col]; } }
#pragma unroll
        for (int ai = 0; ai < 2; ++ai) { const int blk = 2 * ai + wr;
            if (fr == 0) {
#pragma unroll
                for (int bj = 0; bj < 2; ++bj)
#pragma unroll
                    for (int n = 0; n < 2; ++n) *(LAS f32x4*)(X + ((blk * 2 + 0) * 2 + bj) * 128 + chl + 4 * n) = acc[ai][bj][0][n]; }
            if (fr == 15) {
#pragma unroll
                for (int bj = 0; bj < 2; ++bj)
#pragma unroll
                    for (int n = 0; n < 2; ++n) *(LAS f32x4*)(X + ((blk * 2 + 1) * 2 + bj) * 128 + chl + 4 * n) = acc[ai][bj][3][n]; }
        }
        { float* hp = hal + (size_t)u.pm * 4 * DFF2 + u.pn * 128 + chl;
            if (wr == 0 && fr < 2) {
#pragma unroll
                for (int bj = 0; bj < 2; ++bj)
#pragma unroll
                    for (int n = 0; n < 2; ++n) *(f32x4*)(hp + (size_t)fr * DFF2 + bj * DFF + 4 * n) = acc[0][bj][0][n]; }
            if (wr == 1 && fr >= 14) {
#pragma unroll
                for (int bj = 0; bj < 2; ++bj)
#pragma unroll
                    for (int n = 0; n < 2; ++n) *(f32x4*)(hp + (size_t)(fr - 12) * DFF2 + bj * DFF + 4 * n) = acc[1][bj][3][n]; }
        }
        asm volatile("s_waitcnt lgkmcnt(0)" ::: "memory"); __builtin_amdgcn_s_barrier(); asm volatile("" ::: "memory");
        const f32x4 z4 = {0.f, 0.f, 0.f, 0.f};
#pragma unroll
        for (int n = 0; n < 2; ++n) {
            const LAS float* wl = WL + chl + 4 * n;
#define CW_(k, bj) (*(const LAS f32x4*)(wl + (k) * 256 + (bj) * 128))
#pragma unroll
            for (int ai = 0; ai < 2; ++ai) { const int blk = 2 * ai + wr;
                f32x4 top[2], bot[2];
#pragma unroll
                for (int bj = 0; bj < 2; ++bj) {
                    top[bj] = blk > 0 ? *(LAS f32x4*)(X + (((blk - 1) * 2 + 1) * 2 + bj) * 128 + chl + 4 * n) : z4;
                    bot[bj] = blk < 3 ? *(LAS f32x4*)(X + (((blk + 1) * 2 + 0) * 2 + bj) * 128 + chl + 4 * n) : z4; }
#pragma unroll
                for (int m = 0; m < 4; ++m) {
                    f32x4 cv[2];
#pragma unroll
                    for (int bj = 0; bj < 2; ++bj) {
                        const f32x4 cur = acc[ai][bj][m][n];
                        f32x4 pr = dpp_prev4(cur), nx = dpp_next4(cur);
                        const f32x4 pe = (m > 0) ? dpp_prev4(acc[ai][bj][m > 0 ? m - 1 : 0][n]) : top[bj];
                        const f32x4 ne = (m < 3) ? dpp_next4(acc[ai][bj][m < 3 ? m + 1 : 3][n]) : bot[bj];
                        if (fr == 0) pr = pe;
                        if (fr == 15) nx = ne;
                        cv[bj] = CW_(0, bj) * pr + CW_(1, bj) * cur + CW_(2, bj) * nx + CW_(3, bj);
                    }
                    u32x2 w; w.x = cvtpk(silu_mul(cv[0][0], cv[1][0]), silu_mul(cv[0][1], cv[1][1])); w.y = cvtpk(silu_mul(cv[0][2], cv[1][2]), silu_mul(cv[0][3], cv[1][3]));
                    *(u32x2*)(Aout + (size_t)(u.pm * BM + ai * HALF + wr * 64 + m * 16 + fr) * DFF + u.pn * 128 + chl + 4 * n) = w;
                }
            }
        }
    }
};

template <class Epi, int HM = 0>
__device__ __forceinline__ void gemm_phase(LAS unsigned char* lds, LAS unsigned char* xl, const Gemm g, const Order& S, const Epi& E, const int tid) {
    const int wid = __builtin_amdgcn_readfirstlane(tid >> 6), lane = tid & 63, wr = wid >> 2, wc = wid & 3, fr = lane & 15, fq = lane >> 4;
    const int nt = g.K / BK;
    unsigned voffA[2], voffB[2];
#pragma unroll
    for (int i = 0; i < 2; ++i) { int R, C; stage_rc(tid * 16 + i * 8192, R, C); const int Rb = Epi::PERM ? ((R & ~31) + perm32(R & 31)) : R;
        const int Rt = g.bperm ? 64 * (Rb & 63) + (Rb >> 6) : Rb;
        voffA[i] = (unsigned)(R * g.lda + C) * 2u; voffB[i] = (unsigned)(Rt * g.ldb) * 2u + (unsigned)((C >> 3) * g.bkc); }
    const size_t kstep = (size_t)(BK * 2), kstepB = (size_t)(8 * g.bkc);
    const size_t hA = (size_t)HALF * g.lda * 2, hB = g.bperm ? (size_t)4 * g.ldb : (size_t)HALF * g.ldb * 2;
    const unsigned ldsw = (unsigned)wid * 1024u;
    const int aoff = lds_byte(wr * 64 + fr, fq * 8), boff = lds_byte(wc * 32 + fr, fq * 8);
#define PG8_SA(b, h) (((b) * 2 + (h)) * HTB)
#define PG8_SB(b, h) ((4 + (b) * 2 + (h)) * HTB)
#define PG8_STAGE(bufoff, gbase, voff) do { _Pragma("unroll") for (int _i = 0; _i < 2; ++_i) \
        __builtin_amdgcn_global_load_lds((const unsigned*)((const char*)(gbase) + (voff)[_i]), (LAS unsigned*)(lds + (bufoff) + ldsw + _i * 8192), 16, 0, 0); } while (0)
#define PG8_LDA(dst, b, h) do { _Pragma("unroll") for (int m = 0; m < 4; ++m) _Pragma("unroll") for (int k = 0; k < 2; ++k) dst[m][k] = *(const LAS bf16x8*)(lds + PG8_SA(b, h) + aoff + m * 2048 + k * 1024); } while (0)
#define PG8_LDB(dst, b, h) do { _Pragma("unroll") for (int n = 0; n < 2; ++n) _Pragma("unroll") for (int k = 0; k < 2; ++k) dst[n][k] = *(const LAS bf16x8*)(lds + PG8_SB(b, h) + boff + n * 2048 + k * 1024); } while (0)
#define PG8_MMA(ai, bj, At, Bt) do { __builtin_amdgcn_s_setprio(1); _Pragma("unroll") for (int m = 0; m < 4; ++m) _Pragma("unroll") for (int n = 0; n < 2; ++n) _Pragma("unroll") for (int k = 0; k < 2; ++k) \
        acc[ai][bj][m][n] = __builtin_amdgcn_mfma_f32_16x16x32_bf16(Bt[n][k], At[m][k], acc[ai][bj][m][n], 0, 0, 0); __builtin_amdgcn_s_setprio(0); } while (0)
#define PG8_WAIT_V(n) asm volatile("s_waitcnt vmcnt(" #n ")" ::: "memory")
#define PG8_WAIT_L(n) asm volatile("s_waitcnt lgkmcnt(" #n ")" ::: "memory")
#define PG8_BAR __builtin_amdgcn_s_barrier()
#define PG8_SCHED __builtin_amdgcn_sched_barrier(0)
    Unit cur, nxt; int ui = 0;
    if (!S.next(0, cur)) return;
    f32x4 acc[2][2][4][2];
#pragma unroll
    for (int a = 0; a < 2; ++a)
#pragma unroll
        for (int b = 0; b < 2; ++b)
#pragma unroll
            for (int m = 0; m < 4; ++m)
#pragma unroll
                for (int n = 0; n < 2; ++n) acc[a][b][m][n] = (f32x4){0.f, 0.f, 0.f, 0.f};
    bf16x8 At[4][2], B0[2][2], B1[2][2];
    const char* cA = aptr(g, cur); const char* cB = bptr(g, cur);
    PG8_STAGE(PG8_SB(0, 0), cB, voffB); PG8_STAGE(PG8_SB(0, 1), cB + hB, voffB); PG8_STAGE(PG8_SA(0, 0), cA, voffA); PG8_STAGE(PG8_SA(0, 1), cA + hA, voffA);
    if (wr == 1) PG8_BAR;
    PG8_WAIT_V(2); PG8_BAR;
    PG8_STAGE(PG8_SB(1, 0), cB + kstepB, voffB); PG8_STAGE(PG8_SA(1, 0), cA + kstep, voffA); PG8_STAGE(PG8_SB(1, 1), cB + hB + kstepB, voffB);
    PG8_WAIT_V(6); PG8_BAR;
    for (;;) {
        const bool has_next = S.next(ui + 1, nxt);
        const char* nA = has_next ? aptr(g, nxt) : cA; const char* nB = has_next ? bptr(g, nxt) : cB;
        for (int t = 0; t < nt; t += 2) {
            const bool last = (t == nt - 2);
            const char* a1 = cA + (size_t)(t + 1) * kstep;
            const char* a2 = last ? nA : cA + (size_t)(t + 2) * kstep; const char* b2 = last ? nB : cB + (size_t)(t + 2) * kstepB;
            const char* a3 = a2 + kstep; const char* b3 = b2 + kstepB;
            PG8_LDB(B0, 0, 0); PG8_LDB(B1, 0, 1); PG8_SCHED; PG8_LDA(At, 0, 0); PG8_STAGE(PG8_SA(1, 1), a1 + hA, voffA);
            PG8_WAIT_V(8); PG8_WAIT_L(0); PG8_BAR; if constexpr (HM != 2) { PG8_MMA(0, 0, At, B0); PG8_MMA(0, 1, At, B1); } PG8_BAR; PG8_SCHED;
            PG8_LDA(At, 0, 1); PG8_STAGE(PG8_SB(0, 0), b2, voffB); PG8_STAGE(PG8_SB(0, 1), b2 + hB, voffB); PG8_STAGE(PG8_SA(0, 0), a2, voffA);
            PG8_WAIT_V(8); PG8_WAIT_L(0); PG8_BAR; if constexpr (HM != 1) { PG8_MMA(1, 0, At, B0); PG8_MMA(1, 1, At, B1); } PG8_BAR; PG8_SCHED;
            PG8_LDB(B0, 1, 0); PG8_LDB(B1, 1, 1); PG8_SCHED; PG8_LDA(At, 1, 0); PG8_STAGE(PG8_SA(0, 1), a2 + hA, voffA);
            PG8_WAIT_V(8); PG8_WAIT_L(0); PG8_BAR; if constexpr (HM != 2) { PG8_MMA(0, 0, At, B0); PG8_MMA(0, 1, At, B1); } PG8_BAR; PG8_SCHED;
            PG8_LDA(At, 1, 1); PG8_STAGE(PG8_SB(1, 0), b3, voffB); PG8_STAGE(PG8_SB(1, 1), b3 + hB, voffB); PG8_STAGE(PG8_SA(1, 0), a3, voffA);
            PG8_WAIT_V(8); PG8_WAIT_L(0); PG8_BAR; if constexpr (HM != 1) { PG8_MMA(1, 0, At, B0); PG8_MMA(1, 1, At, B1); } PG8_BAR; PG8_SCHED;
        }
        if (wr == 0) PG8_BAR;
        cur.half = HM; E(acc, cur, wr, wc, fr, fq, xl);
        if (!has_next) break;
#pragma unroll
        for (int a = 0; a < 2; ++a)
#pragma unroll
            for (int b = 0; b < 2; ++b)
#pragma unroll
                for (int m = 0; m < 4; ++m)
#pragma unroll
                    for (int n = 0; n < 2; ++n) acc[a][b][m][n] = (f32x4){0.f, 0.f, 0.f, 0.f};
        cur = nxt; cA = nA; cB = nB; ++ui;
        if (wr == 1) PG8_BAR;
    }
    PG8_WAIT_V(0);
    PG8_BAR;
#undef PG8_SA
#undef PG8_SB
#undef PG8_STAGE
#undef PG8_LDA
#undef PG8_LDB
#undef PG8_MMA
#undef PG8_WAIT_V
#undef PG8_WAIT_L
#undef PG8_BAR
#undef PG8_SCHED
}
}


#define XB_TMO      128
#define XB_XCNT(j)  (256  + 64 * (j))
#define XB_XSUB(j)  (1280 + 64 * (j))
#define XB_XGEN(j)  (2304 + 64 * (j))
#define XB_TOP      3328
#define XB_TOPGEN   3392
#define XCD_BAR_WORDS 3456
#define XB_SPIN_CAP (1u << 18)
__device__ __forceinline__ unsigned xb_ld(unsigned* p)              { return __hip_atomic_load(p, __ATOMIC_RELAXED, __HIP_MEMORY_SCOPE_AGENT); }
__device__ __forceinline__ unsigned xb_add(unsigned* p, unsigned v) { return __hip_atomic_fetch_add(p, v, __ATOMIC_RELAXED, __HIP_MEMORY_SCOPE_AGENT); }
__device__ __forceinline__ unsigned xb_xcc_id() { return (unsigned)__builtin_amdgcn_s_getreg((3 << 11) | 20) & 0xFu; }
#define XB_SPIN(cond, bar) do { unsigned _sp = 0; while (cond) { __builtin_amdgcn_s_sleep(1); \
    if ((++_sp & 255u) == 0u) { if (xb_ld(&(bar)[XB_TMO])) break; if (_sp > XB_SPIN_CAP) { atomicAdd(&(bar)[XB_TMO], 1u); break; } } } } while (0)
__device__ __forceinline__ void xcd_barrier_complete(unsigned* bar, unsigned x, unsigned& nloc, unsigned& nx) {
    const unsigned G = gridDim.x * gridDim.y * gridDim.z;
    unsigned sum, cnt, mine, sp = 0u;
    for (;;) {
        sum = 0u; cnt = 0u; mine = 0u;
#pragma unroll
        for (unsigned j = 0; j < 16; ++j) { const unsigned c = xb_ld(&bar[XB_XCNT(j)]); sum += c; cnt += (c > 0u) ? 1u : 0u; mine = (j == x) ? c : mine; }
        if (sum == G) break;
        __builtin_amdgcn_s_sleep(1);
        if ((++sp & 255u) == 0u) { if (xb_ld(&bar[XB_TMO])) break; if (sp > XB_SPIN_CAP) { atomicAdd(&bar[XB_TMO], 1u); break; } }
    }
    nloc = mine > 0u ? mine : 1u; nx = cnt > 0u ? cnt : 1u;
}
__device__ __forceinline__ void xcd_barrier(unsigned* bar, unsigned x, volatile LAS unsigned* st) {
    asm volatile("s_waitcnt vmcnt(0)" ::: "memory");
    __syncthreads();
    if (threadIdx.x == 0) {
        __builtin_amdgcn_s_waitcnt(0);
        unsigned nloc = st[0], nx = st[1];
        if (nloc == 0u) { xcd_barrier_complete(bar, x, nloc, nx); st[0] = nloc; st[1] = nx; }
        const unsigned old = xb_add(&bar[XB_XSUB(x)], 1u);
        const unsigned gen = old / nloc;
        if (old + 1u == (gen + 1u) * nloc) {
            __builtin_amdgcn_fence(__ATOMIC_RELEASE, "agent");
            asm volatile("s_waitcnt vmcnt(0)" ::: "memory");
            const unsigned og = xb_add(&bar[XB_TOP], 1u);
            const unsigned tg = og / nx;
            if (og + 1u == (tg + 1u) * nx) xb_add(&bar[XB_TOPGEN], 1u);
            else XB_SPIN(xb_ld(&bar[XB_TOPGEN]) == tg, bar);
            __builtin_amdgcn_fence(__ATOMIC_ACQUIRE, "agent");
            xb_add(&bar[XB_XGEN(x)], 1u);
            asm volatile("s_waitcnt vmcnt(0)" ::: "memory");
        } else {
            XB_SPIN(xb_ld(&bar[XB_XGEN(x)]) == gen, bar);
            __builtin_amdgcn_fence(__ATOMIC_ACQUIRE, "agent");
            asm volatile("s_waitcnt vmcnt(0)" ::: "memory");
        }
    }
    __syncthreads();
}

#define MFMA32(a, b, c) __builtin_amdgcn_mfma_f32_32x32x16_bf16((a), (b), (c), 0, 0, 0)
__device__ __forceinline__ int crow(int r, int hi) { return (r & 3) + 8 * (r >> 2) + 4 * hi; }

__device__ __forceinline__ void attn_phase(bf16_t* Q, const bf16_t* Kb, const bf16_t* VT, const bf16_t* CK, const bf16_t* CVT, const float* sink, int j, int vcu, int G, int wave, int lane) {
    const int r = lane & 31, h = lane >> 5;
    for (int u = vcu; u < 1280; u += G) {
        const bool lat = u < 1024;
        int b, kvh, qb, L, seqrow;
        if (lat) { b = u >> 7; kvh = (u >> 5) & 3; qb = u & 31; L = 4096; seqrow = NCTX + b * 4096; }
        else { const int v = u - 1024; b = v >> 3; kvh = (v >> 1) & 3; qb = v & 1; L = 256; seqrow = b * 256; }
        const int hq = kvh * 4 + (wave & 3), t0 = qb * 128 + (wave >> 2) * 64;
        bf16_t* Qp = Q + (size_t)(seqrow + t0) * DM + hq * 64;
        bf16x8 qf[2][4];
#pragma unroll
        for (int qi = 0; qi < 2; ++qi)
#pragma unroll
            for (int ks = 0; ks < 4; ++ks) qf[qi][ks] = *(const bf16x8*)(Qp + (size_t)(qi * 32 + r) * DM + ks * 16 + h * 8);
        const float m0 = sink[hq] * LOG2E;
        float mrow[2] = {m0, m0}, lrow[2] = {h == 0 ? 1.f : 0.f, h == 0 ? 1.f : 0.f};
        f32x16 O[2][2];
#pragma unroll
        for (int qi = 0; qi < 2; ++qi)
#pragma unroll
            for (int db = 0; db < 2; ++db)
#pragma unroll
                for (int i = 0; i < 16; ++i) O[qi][db][i] = 0.f;
        const int nseg = lat ? 2 : 1;
        for (int seg = 0; seg < nseg; ++seg) {
            const bf16_t* kb; const bf16_t* vb; int ldv, klo, khi; bool mask;
            if (seg == 0) { kb = Kb + (size_t)seqrow * K_LD + kvh * 64; ldv = lat ? VT_LDL : VT_LDC; vb = VT + (lat ? VT_LAT_BASE + (size_t)b * VT_LAT_SEQ : (size_t)b * VT_CTX_SEQ) + (size_t)kvh * 64 * ldv;
                if (lat) { klo = t0 - 128 < 0 ? 0 : t0 - 128; khi = t0 + 192 > L ? L : t0 + 192; mask = true; } else { klo = 0; khi = 256; mask = false; } }
            else { kb = CK + (size_t)(b * 2 + j) * 512 * K_LD + kvh * 64; vb = CVT + (size_t)((b * 2 + j) * 4 + kvh) * 64 * CVT_LD; ldv = CVT_LD; klo = 0; khi = 512; mask = false; }
            bf16x8 kf[4];
#pragma unroll
            for (int ks = 0; ks < 4; ++ks) kf[ks] = *(const bf16x8*)(kb + (size_t)(klo + r) * K_LD + ks * 16 + h * 8);
            bf16x8 vf[2][2];
#pragma unroll
            for (int db = 0; db < 2; ++db)
#pragma unroll
                for (int s = 0; s < 2; ++s) vf[db][s] = *(const bf16x8*)(vb + (size_t)(db * 32 + r) * ldv + klo + s * 16 + h * 8);
            for (int key = klo; key < khi; key += 32) {
                bf16x8 kn[4], vn[2][2];
                const int keyn = (key + 32 < khi) ? key + 32 : key;
#pragma unroll
                for (int db = 0; db < 2; ++db)
#pragma unroll
                    for (int s = 0; s < 2; ++s) vn[db][s] = *(const bf16x8*)(vb + (size_t)(db * 32 + r) * ldv + keyn + s * 16 + h * 8);
#pragma unroll
                for (int ks = 0; ks < 4; ++ks) kn[ks] = *(const bf16x8*)(kb + (size_t)(keyn + r) * K_LD + ks * 16 + h * 8);
                f32x16 S[2];
#pragma unroll
                for (int qi = 0; qi < 2; ++qi) {
#pragma unroll
                    for (int i = 0; i < 16; ++i) S[qi][i] = 0.f;
#pragma unroll
                    for (int ks = 0; ks < 4; ++ks) S[qi] = MFMA32(kf[ks], qf[qi][ks], S[qi]);
                }
                if (mask) {
#pragma unroll
                    for (int qi = 0; qi < 2; ++qi) { const int t = t0 + qi * 32 + r;
#pragma unroll
                        for (int i = 0; i < 16; ++i) { const int d = t - (key + crow(i, h)); if (d > 128 || d < -128) S[qi][i] = -1e30f; } }
                }
#pragma unroll
                for (int qi = 0; qi < 2; ++qi) {
                    float tm = S[qi][0];
#pragma unroll
                    for (int i = 1; i < 16; ++i) tm = fmaxf(tm, S[qi][i]);
                    tm = fmaxf(tm, __shfl_xor(tm, 32));
                    if (__any(tm > mrow[qi] + 8.0f)) {
                        const float mn = fmaxf(mrow[qi], tm), alpha = __builtin_amdgcn_exp2f(mrow[qi] - mn);
                        mrow[qi] = mn; lrow[qi] *= alpha;
#pragma unroll
                        for (int db = 0; db < 2; ++db)
#pragma unroll
                            for (int i = 0; i < 16; ++i) O[qi][db][i] *= alpha;
                    }
                    const float mn = mrow[qi];
                    float ps = 0.f;
#pragma unroll
                    for (int i = 0; i < 16; ++i) { S[qi][i] = __builtin_amdgcn_exp2f(S[qi][i] - mn); ps += S[qi][i]; }
                    lrow[qi] += ps;
                    bf16x8 pk[2];
#pragma unroll
                    for (int s = 0; s < 2; ++s) { u32x4 w; w.x = cvtpk(S[qi][8 * s], S[qi][8 * s + 1]); w.y = cvtpk(S[qi][8 * s + 2], S[qi][8 * s + 3]); w.z = cvtpk(S[qi][8 * s + 4], S[qi][8 * s + 5]); w.w = cvtpk(S[qi][8 * s + 6], S[qi][8 * s + 7]); pk[s] = __builtin_bit_cast(bf16x8, w); }
#pragma unroll
                    for (int db = 0; db < 2; ++db)
#pragma unroll
                        for (int s = 0; s < 2; ++s) O[qi][db] = MFMA32(vf[db][s], pk[s], O[qi][db]);
                }
#pragma unroll
                for (int ks = 0; ks < 4; ++ks) kf[ks] = kn[ks];
#pragma unroll
                for (int db = 0; db < 2; ++db)
#pragma unroll
                    for (int s = 0; s < 2; ++s) vf[db][s] = vn[db][s];
            }
        }
#pragma unroll
        for (int qi = 0; qi < 2; ++qi) {
            const float lt = lrow[qi] + __shfl_xor(lrow[qi], 32), inv = 1.0f / lt;
#pragma unroll
            for (int db = 0; db < 2; ++db)
#pragma unroll
                for (int g4 = 0; g4 < 4; ++g4) { u32x2 w; w.x = cvtpk(O[qi][db][4 * g4] * inv, O[qi][db][4 * g4 + 1] * inv); w.y = cvtpk(O[qi][db][4 * g4 + 2] * inv, O[qi][db][4 * g4 + 3] * inv);
                    *(u32x2*)(Qp + (size_t)(qi * 32 + r) * DM + db * 32 + 8 * g4 + 4 * h) = w; }
        }
    }
}

__device__ __forceinline__ float wave_sum(float v) {
#pragma unroll
    for (int o = 1; o < 64; o <<= 1) v += __shfl_xor(v, o);
    return v;
}
__device__ __forceinline__ void prep_phase(const float* src0, const float* src1, const bf16_t* xb, bf16_t* H, const float* nw, const float* mods, int shoff, int scoff, int gw, int NGW, int lane) {
    for (int row = gw; row < NTOK; row += NGW) {
        const float* md = mods + (size_t)cond_of_row(row) * NMOD;
        f32x4 v[4]; float ss = 0.f;
        if (xb) {
#pragma unroll
            for (int q = 0; q < 2; ++q) { const u32x4 w = *(const u32x4*)(xb + (size_t)row * DM + 512 * q + 8 * lane);
                v[2 * q] = (f32x4){bf2f(w.x & 0xffffu), bf2f(w.x >> 16), bf2f(w.y & 0xffffu), bf2f(w.y >> 16)}; v[2 * q + 1] = (f32x4){bf2f(w.z & 0xffffu), bf2f(w.z >> 16), bf2f(w.w & 0xffffu), bf2f(w.w >> 16)}; }
        } else { const float* s = row < NCTX ? src0 + (size_t)row * DM : src1 + (size_t)(row - NCTX) * DM;
#pragma unroll
            for (int q = 0; q < 2; ++q) { v[2 * q] = *(const f32x4*)(s + 512 * q + 8 * lane); v[2 * q + 1] = *(const f32x4*)(s + 512 * q + 8 * lane + 4); } }
#pragma unroll
        for (int q = 0; q < 4; ++q) ss += (v[q][0] * v[q][0] + v[q][1] * v[q][1]) + (v[q][2] * v[q][2] + v[q][3] * v[q][3]);
        const float rstd = 1.0f / sqrtf(wave_sum(ss) * (1.0f / DM) + 1e-6f);
#pragma unroll
        for (int q = 0; q < 2; ++q) { const int c = 512 * q + 8 * lane; u32x4 w;
#pragma unroll
            for (int hh = 0; hh < 2; ++hh) { const f32x4 g4 = *(const f32x4*)(nw + c + 4 * hh), sc = *(const f32x4*)(md + scoff + c + 4 * hh), sh = *(const f32x4*)(md + shoff + c + 4 * hh);
                const f32x4 o = v[2 * q + hh] * rstd * g4 * (sc + 1.0f) + sh; w[2 * hh] = cvtpk(o[0], o[1]); w[2 * hh + 1] = cvtpk(o[2], o[3]); }
            *(u32x4*)(H + (size_t)row * DM + c) = w; }
    }
}
__device__ __forceinline__ void pool_phase(const bf16_t* H, bf16_t* P, int gw, int NGW, int lane) {
    for (int row = gw; row < NTOK; row += NGW) {
        int sb, t, L;
        if (row < NCTX) { sb = row & ~255; t = row & 255; L = 256; } else { const int lr = row - NCTX; sb = NCTX + (lr & ~4095); t = lr & 4095; L = 4096; }
#pragma unroll
        for (int q = 0; q < 2; ++q) { const int c8 = lane + 64 * q, grp = c8 >> 5, hw = 1 << grp;
            int st = t - hw; if (st < 0) st = 0; int en = t + hw; if (en > L) en = L;
            float a[8];
#pragma unroll
            for (int e = 0; e < 8; ++e) a[e] = 0.f;
            for (int jr = st; jr < en; ++jr) { const u32x4 w = *(const u32x4*)(H + (size_t)(sb + jr) * DM + c8 * 8);
#pragma unroll
                for (int e = 0; e < 4; ++e) { a[2 * e] += bf2f(w[e] & 0xffffu); a[2 * e + 1] += bf2f(w[e] >> 16); } }
            const float inv = 1.0f / (float)(en - st);
            const u32x4 w = *(const u32x4*)(H + (size_t)row * DM + c8 * 8); u32x4 o;
#pragma unroll
            for (int e = 0; e < 4; ++e) o[e] = cvtpk(a[2 * e] * inv - bf2f(w[e] & 0xffffu), a[2 * e + 1] * inv - bf2f(w[e] >> 16));
            *(u32x4*)(P + (size_t)row * DM + c8 * 8) = o; }
    }
}
__device__ __forceinline__ void fix_phase(const float* hal, bf16_t* A, const float* cw, const float* cb, int gt, int GT) {
    for (int it = gt; it < 120 * 704; it += GT) {
        const int bi = it / 704, c = (it % 704) * 4, b = bi / 15, i = bi % 15 + 1, pmh = 32 + b * 16 + i;
        const float* hl = hal + (size_t)(pmh - 1) * 4 * DFF2; const float* hh = hal + (size_t)pmh * 4 * DFF2;
        f32x4 cv1[2], cv2[2];
#pragma unroll
        for (int bj = 0; bj < 2; ++bj) { const int col = bj * DFF + c;
            const f32x4 uA = *(const f32x4*)(hl + 2 * DFF2 + col), uB = *(const f32x4*)(hl + 3 * DFF2 + col), uC = *(const f32x4*)(hh + col), uD = *(const f32x4*)(hh + DFF2 + col);
            const f32x4 w0 = *(const f32x4*)(cw + col), w1 = *(const f32x4*)(cw + DFF2 + col), w2 = *(const f32x4*)(cw + 2 * DFF2 + col), bb = *(const f32x4*)(cb + col);
            cv1[bj] = w0 * uA + w1 * uB + w2 * uC + bb; cv2[bj] = w0 * uB + w1 * uC + w2 * uD + bb; }
        const size_t R = (size_t)pmh * 256;
        u32x2 w; w.x = cvtpk(silu_mul(cv1[0][0], cv1[1][0]), silu_mul(cv1[0][1], cv1[1][1])); w.y = cvtpk(silu_mul(cv1[0][2], cv1[1][2]), silu_mul(cv1[0][3], cv1[1][3]));
        *(u32x2*)(A + (R - 1) * DFF + c) = w;
        w.x = cvtpk(silu_mul(cv2[0][0], cv2[1][0]), silu_mul(cv2[0][1], cv2[1][1])); w.y = cvtpk(silu_mul(cv2[0][2], cv2[1][2]), silu_mul(cv2[0][3], cv2[1][3]));
        *(u32x2*)(A + R * DFF + c) = w;
    }
}

__device__ __forceinline__ void transpose_item(const float* W, int K, int N, bf16_t* WT, int mapkind, LAS float* scr, int item, int lane) {
    const int nblk = N / 32, kb = item / nblk, nb = item % nblk, k0 = 64 * kb, n0 = 32 * nb;
    int d0 = n0;
    if (mapkind == 1) { const int head = n0 >> 6, bj = (n0 >> 5) & 1; d0 = 256 * (head >> 2) + 128 * bj + 32 * (head & 3); }
    else if (mapkind == 2) { const int bj = n0 >= DFF ? 1 : 0, cc = n0 - bj * DFF; d0 = 256 * (cc >> 7) + 128 * bj + (cc & 127); }
#pragma unroll 32
    for (int i = 0; i < 32; ++i) { const int kk = 2 * i + (lane >> 5); scr[kk * 33 + (lane & 31)] = W[(size_t)(k0 + kk) * N + n0 + (lane & 31)]; }
    asm volatile("s_waitcnt lgkmcnt(0)" ::: "memory");
    const int c = lane & 7;
#pragma unroll
    for (int jj = 0; jj < 4; ++jj) { const int n = (lane >> 3) + 8 * jj; const LAS float* s = scr + (8 * c) * 33 + n;
        u32x4 o; o.x = cvtpk(s[0 * 33], s[1 * 33]); o.y = cvtpk(s[2 * 33], s[3 * 33]); o.z = cvtpk(s[4 * 33], s[5 * 33]); o.w = cvtpk(s[6 * 33], s[7 * 33]);
        *(u32x4*)(WT + (size_t)(d0 + n) * K + k0 + 8 * c) = o; }
    asm volatile("s_waitcnt lgkmcnt(0)" ::: "memory");
}

enum { K_PRO = 0, K_PREP1, K_PREP2, K_QKV, K_ATTN, K_WO, K_POOLP, K_POOLG, K_CHAN, K_SEQC, K_SEQL, K_FFN1, K_FIX, K_FFN2, K_ST1, K_ST2, K_FFN2X };
#ifndef PROBE_DUP
#define PROBE_DUP(X, k)
#endif
#define PROG_LIST(X) X(K_PRO,0) \
    X(K_PREP1,0) X(K_QKV,0) X(K_ATTN,0) X(K_WO,0) X(K_PREP2,0) PROBE_DUP(X, 0) X(K_FFN1,0) X(K_FIX,0) X(K_FFN2,0) \
    X(K_PREP1,1) X(K_POOLP,1) X(K_POOLG,1) X(K_PREP2,1) PROBE_DUP(X, 1) X(K_FFN1,1) X(K_FIX,1) X(K_FFN2,1) \
    X(K_PREP1,2) X(K_CHAN,2) X(K_SEQC,2) X(K_ST1,2) X(K_ST2,2) X(K_PREP2,2) PROBE_DUP(X, 2) X(K_FFN1,2) X(K_FIX,2) X(K_FFN2,2) \
    X(K_PREP1,3) X(K_QKV,3) X(K_ATTN,3) X(K_WO,3) X(K_PREP2,3) PROBE_DUP(X, 3) X(K_FFN1,3) X(K_FIX,3) X(K_FFN2,3)
#define PROG_K(k, l) k,
#define PROG_L(k, l) l,
__constant__ unsigned char PROG_KIND[] = { PROG_LIST(PROG_K) };
__constant__ unsigned char PROG_LAYER[] = { PROG_LIST(PROG_L) };
static const unsigned char H_PROG_KIND[] = { PROG_LIST(PROG_K) };
constexpr int NSTEP = (int)sizeof(H_PROG_KIND);

struct Args { const float* in[22]; float* out; unsigned char* ws; int s_lo, s_hi; };

__global__ void __launch_bounds__(512, 2) mega_fwd(Args a) {
    extern __shared__ __attribute__((aligned(16))) unsigned char lds_raw[];
    LAS unsigned char* lds = (LAS unsigned char*)lds_raw;
    LAS unsigned char* xl = lds + LDS_X;
    cg::grid_group grid = cg::this_grid();
    volatile LAS unsigned* bst = (volatile LAS unsigned*)(lds + LDS_MISC);
    unsigned* bar = (unsigned*)(a.ws + WS_CTL);
    if (threadIdx.x < 4) bst[threadIdx.x] = 0u;
    __syncthreads();
    const unsigned xcc = xb_xcc_id();
    if (threadIdx.x == 0) (void)xb_add(&bar[XB_XCNT(xcc)], 1u);
    const int G = gridDim.x, NGW = G * 8, GT = G * 512;
    unsigned char* ws = a.ws; float* out = a.out;
    float* mods = (float*)(ws + WS_MODS);
    float* ropec = (float*)(ws + WS_ROPE); float* ropes = ropec + 1024;
    bf16_t* Hb = (bf16_t*)(ws + WS_H);
    bf16_t* BIG = (bf16_t*)(ws + WS_BIG);
    bf16_t* Qb = (bf16_t*)(ws + WS_Q); bf16_t* Kbuf = (bf16_t*)(ws + WS_K); bf16_t* VTb = (bf16_t*)(ws + WS_VT);
    float* hal = (float*)(ws + WS_HAL);

    for (int s = a.s_lo; s < a.s_hi; ++s) {
        int tid = threadIdx.x, bx = blockIdx.x;
        asm volatile("" : "+v"(tid), "+s"(bx));
        const int lane = tid & 63, wave = __builtin_amdgcn_readfirstlane(tid >> 6);
        const int vcu = (G % 8 == 0) ? (bx % 8) * (G / 8) + bx / 8 : bx;
        const int gw = vcu * 8 + wave, gt = bx * 512 + tid;
        const int kind = PROG_KIND[s], layer = PROG_LAYER[s], jl = layer / 3;
        const float* xs0 = a.in[0]; const float* xs1 = a.in[1];
        bf16_t* XB = (bf16_t*)(ws + WS_XB); const bf16_t* xbin = (s <= 4) ? nullptr : XB;
        const float* lmods = mods + (size_t)layer * 9 * NMOD;
        switch (kind) {
#ifndef NO_PRO
        case K_PRO: {
            LAS float* scond = (LAS float*)lds; LAS float* part = (LAS float*)(lds + 40960);
            for (int i = tid; i < 9 * 1024; i += 512) { const int cnd = i >> 10, k = i & 1023; const float v = cnd == 0 ? a.in[5][k] : a.in[4][(cnd - 1) * 1024 + k]; scond[i] = v / (1.0f + __expf(-v)); }
            __syncthreads();
            for (int item = bx; item < 384; item += G) {
                const int ly = item / 96, cb = item % 96;
                const float* w = a.in[8] + (size_t)ly * 1024 * NMOD + cb * 64 + lane;
                float ac[9];
#pragma unroll
                for (int c = 0; c < 9; ++c) ac[c] = 0.f;
                const int k0 = wave * 128;
#pragma unroll 32
                for (int kk = 0; kk < 128; ++kk) { const float wv = w[(size_t)(k0 + kk) * NMOD];
#pragma unroll
                    for (int c = 0; c < 9; ++c) ac[c] += wv * scond[c * 1024 + k0 + kk]; }
#pragma unroll
                for (int c = 0; c < 9; ++c) part[(wave * 9 + c) * 64 + lane] = ac[c];
                __syncthreads();
                for (int i = tid; i < 576; i += 512) { const int c = i >> 6, l = i & 63; float sm = a.in[9][ly * NMOD + cb * 64 + l];
#pragma unroll
                    for (int w8 = 0; w8 < 8; ++w8) sm += part[(w8 * 9 + c) * 64 + l];
                    mods[((size_t)ly * 9 + c) * NMOD + cb * 64 + l] = sm; }
                __syncthreads();
            }
            {
                LAS float* scr = (LAS float*)(lds + wave * 16384);
                constexpr int I_QKV = 16 * 48, I_WO = 16 * 32, I_POOL = 4 * 8, I_IN = 16 * 176, I_OUT = 44 * 32;
                constexpr int NIT = 2 * I_QKV + 2 * I_WO + 4 * I_POOL + 4 * I_IN + 4 * I_OUT;
                for (int it = gw; it < NIT; it += NGW) {
                    int r_ = it;
                    if (r_ < 4 * I_IN) { const int ly = r_ / I_IN; transpose_item(a.in[18] + (size_t)ly * DM * DFF2, DM, DFF2, (bf16_t*)(ws + WS_WIN) + (size_t)ly * DFF2 * DM, 2, scr, r_ % I_IN, lane); continue; } r_ -= 4 * I_IN;
                    if (r_ < 4 * I_OUT) { const int ly = r_ / I_OUT; transpose_item(a.in[21] + (size_t)ly * DFF * DM, DFF, DM, (bf16_t*)(ws + WS_WOUT) + (size_t)ly * DM * DFF, 0, scr, r_ % I_OUT, lane); continue; } r_ -= 4 * I_OUT;
                    if (r_ < 2 * I_QKV) { const int ly = r_ / I_QKV; transpose_item(a.in[10] + (size_t)ly * DM * NQKV, DM, NQKV, (bf16_t*)(ws + WS_WQKV) + (size_t)ly * NQKV * DM, 1, scr, r_ % I_QKV, lane); continue; } r_ -= 2 * I_QKV;
                    if (r_ < 2 * I_WO) { const int ly = r_ / I_WO; transpose_item(a.in[14] + (size_t)ly * DM * DM, DM, DM, (bf16_t*)(ws + WS_WO) + (size_t)ly * DM * DM, 0, scr, r_ % I_WO, lane); continue; } r_ -= 2 * I_WO;
                    { const int gp = r_ / I_POOL; transpose_item(a.in[15] + (size_t)gp * 65536, 256, 256, (bf16_t*)(ws + WS_WPOOL) + (size_t)gp * 65536, 0, scr, r_ % I_POOL, lane); }
                }
            }
            __syncthreads();
            LAS f32x2* TAB = (LAS f32x2*)lds;
            for (int k = tid; k < 4096; k += 512) { float sv, cv; sincospif((float)k * (1.0f / 2048.0f), &sv, &cv); TAB[k] = (f32x2){cv, sv}; }
            __syncthreads();
            { bf16_t* A1 = (bf16_t*)(ws + WS_A1);
                for (int it = gt; it < 32 * 256 * 32; it += GT) { const int p = it >> 13, j = (it >> 5) & 255, k0 = (it & 31) * 8, t1 = (j >> 1) & 63, bbl = j >> 7, ri = j & 1, part_ = (k0 >> 6) & 1, a0 = k0 & 63; float v[8];
#pragma unroll
                    for (int e = 0; e < 8; ++e) { const f32x2 cs = TAB[(t1 * (64 * (a0 + e) + 2 * p + bbl)) & 4095]; const float x = ri == 0 ? (part_ == 0 ? cs.x : -cs.y) : (part_ == 0 ? -cs.y : -cs.x); v[e] = ((k0 >> 7) == bbl) ? x * (1.0f / 64.0f) : 0.f; }
                    u32x4 o; o.x = cvtpk(v[0], v[1]); o.y = cvtpk(v[2], v[3]); o.z = cvtpk(v[4], v[5]); o.w = cvtpk(v[6], v[7]); *(u32x4*)(A1 + (size_t)it * 8) = o; }
                bf16_t* A2 = (bf16_t*)(ws + WS_A2);
                for (int it = gt; it < 256 * 64; it += GT) { const int r_ = it >> 6, k0 = (it & 63) * 8, t1l = r_ >> 6, t2 = r_ & 63; float v[8];
#pragma unroll
                    for (int e = 0; e < 8; ++e) { const int k = k0 + e, bb = k >> 3; const f32x2 cs = TAB[((t2 * bb) & 63) * 64]; v[e] = (((k >> 1) & 3) == t1l) ? ((k & 1) ? cs.y : cs.x) : 0.f; }
                    u32x4 o; o.x = cvtpk(v[0], v[1]); o.y = cvtpk(v[2], v[3]); o.z = cvtpk(v[4], v[5]); o.w = cvtpk(v[6], v[7]); *(u32x4*)(A2 + (size_t)it * 8) = o; }
                bf16_t* D2 = (bf16_t*)(ws + WS_DFT256);
                for (int it = gt; it < 256 * 64; it += GT) { const int t = it >> 6, j0 = (it & 63) * 8, part_ = j0 >= 256, jj = j0 & 255; float v[8];
#pragma unroll
                    for (int e = 0; e < 8; ++e) { const f32x2 cs = TAB[((t * (jj + e)) & 255) * 16]; v[e] = (part_ ? -cs.y : cs.x) * (1.0f / 16.0f); }
                    u32x4 o; o.x = cvtpk(v[0], v[1]); o.y = cvtpk(v[2], v[3]); o.z = cvtpk(v[4], v[5]); o.w = cvtpk(v[6], v[7]); *(u32x4*)(D2 + (size_t)t * 512 + j0) = o; }
            }
            { LAS float* wt = (LAS float*)(lds + 32768); bf16_t* WCS = (bf16_t*)(ws + WS_WCS);
                for (int item = bx; item < 256; item += G) {
                    const int gp = item >> 6, n0 = (item & 63) * 16;
                    for (int i = tid; i < 4096; i += 512) wt[i] = a.in[17][(size_t)(gp * 256 + (i >> 4)) * DM + n0 + (i & 15)];
                    __syncthreads();
                    const int nn = tid & 15, cg_ = tid >> 4;
                    float ac[8], as[8];
#pragma unroll
                    for (int e = 0; e < 8; ++e) { ac[e] = 0.f; as[e] = 0.f; }
                    for (int cp = 0; cp < 256; ++cp) { const float wv = wt[cp * 16 + nn];
#pragma unroll
                        for (int e = 0; e < 8; ++e) { const f32x2 cs = TAB[(((cg_ * 8 + e) * cp) & 255) * 16]; ac[e] += wv * cs.x; as[e] += wv * cs.y; } }
                    u32x4 o; o.x = cvtpk(ac[0] * 0.0625f, ac[1] * 0.0625f); o.y = cvtpk(ac[2] * 0.0625f, ac[3] * 0.0625f); o.z = cvtpk(ac[4] * 0.0625f, ac[5] * 0.0625f); o.w = cvtpk(ac[6] * 0.0625f, ac[7] * 0.0625f);
                    *(u32x4*)(WCS + (size_t)(n0 + nn) * DM + gp * 256 + cg_ * 8) = o;
                    o.x = cvtpk(as[0] * 0.0625f, as[1] * 0.0625f); o.y = cvtpk(as[2] * 0.0625f, as[3] * 0.0625f); o.z = cvtpk(as[4] * 0.0625f, as[5] * 0.0625f); o.w = cvtpk(as[6] * 0.0625f, as[7] * 0.0625f);
                    *(u32x4*)(WCS + (size_t)(1024 + n0 + nn) * DM + gp * 256 + cg_ * 8) = o;
                    __syncthreads();
                }
            }
            for (int i = gt; i < 1024; i += GT) { const int pos = i >> 4, f = i & 15; const float invf = 1.0f / powf(10000.0f, (float)f * (1.0f / 16.0f)); float sv, cv; sincosf((float)pos * invf, &sv, &cv); ropec[i] = cv; ropes[i] = sv; }
            { bf16_t* CKb = (bf16_t*)(ws + WS_CK); bf16_t* CVTb = (bf16_t*)(ws + WS_CVT);
                for (int it = gt; it < 262144; it += GT) { const f32x4 v0 = *(const f32x4*)(a.in[2] + (size_t)it * 8), v1 = *(const f32x4*)(a.in[2] + (size_t)it * 8 + 4);
                    u32x4 o; o.x = cvtpk(v0[0], v0[1]); o.y = cvtpk(v0[2], v0[3]); o.z = cvtpk(v1[0], v1[1]); o.w = cvtpk(v1[2], v1[3]); *(u32x4*)(CKb + (size_t)(it >> 5) * K_LD + (it & 31) * 8) = o; }
                for (int it = gt; it < 262144; it += GT) { const int d = it & 63, chunk = (it >> 6) & 63, kvh = (it >> 12) & 3, bj2 = it >> 14, g16 = chunk >> 1, hh = chunk & 1; float v[8];
#pragma unroll
                    for (int e = 0; e < 8; ++e) { const int pos = 16 * g16 + 4 * hh + (e & 3) + 8 * (e >> 2); v[e] = a.in[3][((size_t)(bj2 * 512 + pos) * 4 + kvh) * 64 + d]; }
                    u32x4 o; o.x = cvtpk(v[0], v[1]); o.y = cvtpk(v[2], v[3]); o.z = cvtpk(v[4], v[5]); o.w = cvtpk(v[6], v[7]); *(u32x4*)(CVTb + ((size_t)(bj2 * 4 + kvh) * 64 + d) * CVT_LD + chunk * 8) = o; }
            }
        } break;
#endif
        case K_PREP1: prep_phase(xs0, xs1, xbin, Hb, a.in[6] + layer * DM, lmods, 0, 1024, gw, NGW, lane); break;
        case K_PREP2: prep_phase(xs0, xs1, xbin, Hb, a.in[7] + layer * DM, lmods, 3072, 4096, gw, NGW, lane); break;
        case K_POOLP: pool_phase(Hb, BIG, gw, NGW, lane); break;
        case K_FIX: fix_phase(hal, BIG, a.in[19] + (size_t)layer * 3 * DFF2, a.in[20] + (size_t)layer * DFF2, gt, GT); break;
#ifndef NO_ATTN
        case K_ATTN: attn_phase(Qb, Kbuf, VTb, (const bf16_t*)(ws + WS_CK), (const bf16_t*)(ws + WS_CVT), a.in[13] + jl * 16, jl, vcu, G, wave, lane); break;
#endif
#ifndef NO_QKV
        case K_QKV: {
            pg8::Gemm g{(const char*)Hb, (const char*)(ws + WS_WQKV) + (size_t)jl * NQKV * DM * 2, DM, DM, DM, 160, 6, 160, 0, 0};
            pg8::Order S; S.init(160, 6, G, bx);
            pg8::EpiQKV E{Qb, Kbuf, VTb, out + OUT_CK + (size_t)jl * 65536, out + OUT_CV + (size_t)jl * 65536, a.in[11] + jl * 64, a.in[12] + jl * 64, ropec, ropes};
            pg8::gemm_phase<pg8::EpiQKV>(lds, xl, g, S, E, tid);
        } break;
#endif
#ifndef NO_CHAN
        case K_CHAN: {
            for (int v = 0; v < 2; ++v) {
                pg8::Gemm g{(const char*)(ws + WS_WCS), (const char*)(Hb + (size_t)(v ? NCTX : 0) * DM), DM, DM, DM, 8, v ? 128 : 32, 8, 0, 0};
                g.bperm = v;
                pg8::Order S; S.init(8, v ? 128 : 32, G, bx);
                pg8::EpiChan E{(bf16_t*)(ws + (v ? WS_PTL : WS_PTC)), v};
                pg8::gemm_phase<pg8::EpiChan>(lds, xl, g, S, E, tid);
            }
        } break;
#endif
        case K_ST1: {
            pg8::Gemm g{(const char*)(ws + WS_PTL), (const char*)(ws + WS_A1), 8192, 256, 256, 32, 32, 32, 512, 0};
            pg8::Order S; S.init(32, 32, G, bx);
            pg8::EpiY1 E{(bf16_t*)(ws + WS_YT)};
            pg8::gemm_phase<pg8::EpiY1>(lds, xl, g, S, E, tid);
        } break;
#ifndef NO_FFN1
        case K_FFN1: {
            pg8::Gemm g{(const char*)Hb, (const char*)(ws + WS_WIN) + (size_t)layer * DFF2 * DM * 2, DM, DM, DM, 160, 22, 160, 0, 0};
            pg8::Order S; S.init(160, 22, G, bx);
            pg8::EpiFfn1 E{BIG, hal, a.in[19] + (size_t)layer * 3 * DFF2, a.in[20] + (size_t)layer * DFF2};
            pg8::gemm_phase<pg8::EpiFfn1>(lds, xl, g, S, E, tid);
        } break;
#endif
#ifndef NO_RES
        default: {
            pg8::Gemm g; pg8::EpiRes E; E.src0 = xs0; E.src1 = xs1; E.xin = xbin; { const bool last_ = (kind == K_FFN2 && layer == 3); E.xout = last_ ? nullptr : XB; E.dst = last_ ? out : nullptr; } E.pscale = nullptr; E.pm0 = 0; E.rowmap = 0; E.gate = lmods + 2048;
            g.akoff = 0; g.bstride = 0;
            if (kind == K_WO) { g.A = (const char*)Qb; g.Bt = (const char*)(ws + WS_WO) + (size_t)jl * DM * DM * 2; g.lda = DM; g.ldb = DM; g.K = DM; g.nM = 160; g.nN = 4; g.amod = 160; }
            else if (kind == K_POOLG) { g.A = (const char*)BIG; g.Bt = (const char*)(ws + WS_WPOOL); g.lda = DM; g.ldb = 256; g.K = 256; g.nM = 160; g.nN = 4; g.amod = 160; g.akoff = 512; E.pscale = a.in[16]; }
            else if (kind == K_SEQC) { g.A = (const char*)(ws + WS_DFT256); g.Bt = (const char*)(ws + WS_PTC); g.lda = 512; g.ldb = 512; g.K = 512; g.nM = 32; g.nN = 4; g.amod = 1; g.bmod = 1; g.bstride = (size_t)256 * 2048 * 2; }
            else if (kind == K_ST2) { g.A = (const char*)(ws + WS_A2); g.Bt = (const char*)(ws + WS_YT); g.lda = 512; g.ldb = 8192; g.K = 512; g.nM = 128; g.nN = 4; g.amod = 1; g.bmod = 16; g.bstride = (size_t)1024 * 8192 * 2; g.bstride2 = 16; g.bkc = 256; E.rowmap = 1; }
            else { g.A = (const char*)BIG; g.Bt = (const char*)(ws + WS_WOUT) + (size_t)layer * DM * DFF * 2; g.lda = DFF; g.ldb = DFF; g.K = DFF; g.nM = 160; g.nN = 4; g.amod = 160; E.gate = lmods + 5120; }
            pg8::Order S; S.init(g.nM, g.nN, G, bx);
            const int nfull = (S.nwg / G) * G, rem = S.nwg - nfull;
            if (rem > 0 && 2 * rem <= G && (G & 1) == 0) {
                S.hi = nfull; if (nfull > 0) pg8::gemm_phase<pg8::EpiRes>(lds, xl, g, S, E, tid);
                S.lo = nfull; S.hi = S.nwg; S.G = G >> 1; S.c = bx >> 1;
                if (bx & 1) pg8::gemm_phase<pg8::EpiRes, 2>(lds, xl, g, S, E, tid); else pg8::gemm_phase<pg8::EpiRes, 1>(lds, xl, g, S, E, tid);
            } else pg8::gemm_phase<pg8::EpiRes>(lds, xl, g, S, E, tid);
        } break;
#endif
        }
        if (s + 1 < a.s_hi && kind != K_SEQC) { if (s == a.s_lo) grid.sync(); else xcd_barrier(bar, xcc, bst); }
    }
}

extern "C" void kernel_launch(void* const* d_in, const int* in_sizes, int n_in, void* d_out, int out_size, void* d_ws, size_t ws_size, hipStream_t stream) {
    static int grid = 0;
    if (grid == 0) {
        if (n_in != 22 || ws_size < WS_END) { fprintf(stderr, "kernel_launch: unexpected n_in %d or ws_size %zu (< %zu)\n", n_in, ws_size, (size_t)WS_END); grid = -1; return; }
        int dev = 0, cus = 0, per_cu = 0;
        hipGetDevice(&dev); hipDeviceGetAttribute(&cus, hipDeviceAttributeMultiprocessorCount, dev);
        if (hipFuncSetAttribute((const void*)mega_fwd, hipFuncAttributeMaxDynamicSharedMemorySize, LDS_BYTES) != hipSuccess) { fprintf(stderr, "kernel_launch: hipFuncSetAttribute failed\n"); grid = -1; return; }
        if (hipOccupancyMaxActiveBlocksPerMultiprocessor(&per_cu, (const void*)mega_fwd, 512, LDS_BYTES) != hipSuccess || per_cu < 1) { fprintf(stderr, "kernel_launch: occupancy query says %d\n", per_cu); per_cu = 1; }
        (void)hipGetLastError();
        grid = cus * 1;
    }
    if (grid < 0) return;
    if (hipMemsetAsync((char*)d_ws + WS_CTL, 0, CTL_BYTES, stream) != hipSuccess) { fprintf(stderr, "kernel_launch: memset failed\n"); return; }
    Args a{};
    for (int i = 0; i < 22; ++i) a.in[i] = (const float*)d_in[i];
    a.out = (float*)d_out; a.ws = (unsigned char*)d_ws;
#if MK_MULTI
    for (int s = 0; s < NSTEP;) {
        int e = s + 1; if (H_PROG_KIND[s] == K_SEQC) e = s + 2;
        a.s_lo = s; a.s_hi = e; void* args[] = {&a};
        hipError_t err = hipLaunchCooperativeKernel((const void*)mega_fwd, dim3(grid), dim3(512), args, LDS_BYTES, stream);
        if (err != hipSuccess) { fprintf(stderr, "kernel_launch: cooperative launch failed: %s\n", hipGetErrorString(err)); break; }
        s = e;
    }
#else
    a.s_lo = 0; a.s_hi = NSTEP; void* args[] = {&a};
    hipError_t err = hipLaunchCooperativeKernel((const void*)mega_fwd, dim3(grid), dim3(512), args, LDS_BYTES, stream);
    if (err != hipSuccess) fprintf(stderr, "kernel_launch: cooperative launch failed: %s (grid %d)\n", hipGetErrorString(err), grid);
#endif
}
```

```cpp
#include <hip/hip_runtime.h>
#include <hip/hip_cooperative_groups.h>
#include <cstdio>
#include <cstdint>
namespace cg = cooperative_groups;

#ifndef MK_MULTI
#define MK_MULTI 0
#endif

#define LAS __attribute__((address_space(3)))
typedef unsigned short bf16_t;
typedef short bf16x8 __attribute__((ext_vector_type(8)));
typedef float f32x2 __attribute__((ext_vector_type(2)));
typedef float f32x4 __attribute__((ext_vector_type(4)));
typedef float f32x16 __attribute__((ext_vector_type(16)));
typedef unsigned u32x2 __attribute__((ext_vector_type(2)));
typedef unsigned u32x4 __attribute__((ext_vector_type(4)));
typedef __bf16 bf16x2_t __attribute__((ext_vector_type(2)));

constexpr int DM = 1024, NCTX = 8192, NTOK = 40960, DFF = 2816, DFF2 = 5632, NQKV = 1536, NMOD = 6144;
constexpr float LOG2E = 1.4426950408889634f;
constexpr float QSCALE = 0.125f * LOG2E;

constexpr size_t MiB = 1u << 20;
constexpr size_t WS_MODS = 0;
constexpr size_t WS_ROPE = 1 * MiB;
constexpr size_t WS_DFT256 = 1 * MiB + 64 * 1024;
constexpr size_t WS_WQKV = 2 * MiB;
constexpr size_t WS_WO = 8 * MiB;
constexpr size_t WS_WPOOL = 12 * MiB;
constexpr size_t WS_WCS = 13 * MiB;
constexpr size_t WS_WIN = 17 * MiB;
constexpr size_t WS_WOUT = 61 * MiB;
constexpr size_t WS_CK = 83 * MiB;
constexpr size_t WS_CVT = 488 * MiB;
constexpr int K_LD = 272;
constexpr int VT_LDC = 288, VT_LDL = 4160, CVT_LD = 544;
constexpr size_t VT_CTX_SEQ = (size_t)256 * VT_LDC, VT_LAT_BASE = 32 * VT_CTX_SEQ, VT_LAT_SEQ = (size_t)256 * VT_LDL;
constexpr size_t WS_HAL = 88 * MiB;
constexpr size_t WS_A1 = 102 * MiB;
constexpr size_t WS_A2 = 106 * MiB;
constexpr size_t WS_XB = 107 * MiB;
constexpr size_t WS_YT = 187 * MiB;
constexpr size_t WS_H = 187 * MiB;
constexpr size_t WS_BIG = 267 * MiB;
constexpr size_t WS_PTC = WS_BIG + 60 * MiB, WS_PTL = WS_BIG + 92 * MiB;
constexpr size_t WS_Q = WS_BIG, WS_K = WS_BIG + 80 * MiB, WS_VT = WS_BIG + 104 * MiB;
constexpr size_t WS_CTL = 487 * MiB;
constexpr size_t CTL_BYTES = 64 * 1024;
constexpr size_t WS_END = 494 * MiB;

constexpr size_t OUT_CK = (size_t)NTOK * DM;
constexpr size_t OUT_CV = OUT_CK + (size_t)32 * 2 * 256 * 256;

constexpr int LDS_RING = 131072, LDS_X = 131072, LDS_MISC = 131072 + 8192, LDS_BYTES = 147456;

__device__ __forceinline__ unsigned cvtpk(float lo, float hi) { f32x2 v = {lo, hi}; bf16x2_t b = __builtin_convertvector(v, bf16x2_t); return __builtin_bit_cast(unsigned, b); }
__device__ __forceinline__ bf16_t f2bf(float f) { return (bf16_t)(cvtpk(f, 0.f) & 0xffffu); }
__device__ __forceinline__ float bf2f(unsigned v) { return __uint_as_float(v << 16); }
__device__ __forceinline__ float dpp_prev(float v) { return __int_as_float(__builtin_amdgcn_update_dpp(0, __float_as_int(v), 0x121, 0xf, 0xf, false)); }
__device__ __forceinline__ float dpp_next(float v) { return __int_as_float(__builtin_amdgcn_update_dpp(0, __float_as_int(v), 0x12F, 0xf, 0xf, false)); }
__device__ __forceinline__ f32x4 dpp_prev4(f32x4 v) { return (f32x4){dpp_prev(v[0]), dpp_prev(v[1]), dpp_prev(v[2]), dpp_prev(v[3])}; }
__device__ __forceinline__ f32x4 dpp_next4(f32x4 v) { return (f32x4){dpp_next(v[0]), dpp_next(v[1]), dpp_next(v[2]), dpp_next(v[3])}; }
__device__ __forceinline__ float silu_mul(float g, float v) { const float e = __builtin_amdgcn_exp2f(-g * LOG2E); return g * __builtin_amdgcn_rcpf(1.0f + e) * v; }
__device__ __forceinline__ int cond_of_row(int row) { return row < NCTX ? 0 : 1 + ((row - NCTX) >> 12); }

namespace pg8 {
constexpr int BM = 256, BK = 64, HALF = 128, HTB = HALF * BK * 2, NXCD = 8, WGM = 8;
__device__ __forceinline__ int lds_byte(int r, int c) { const int st = (r >> 4) * 2 + (c >> 5), rr = r & 15, cc = c & 31, ob = rr * 64 + cc * 2; return st * 1024 + (ob ^ (((ob >> 9) & 1) << 5)); }
__device__ __forceinline__ void stage_rc(int b, int& R, int& C) { const int st = b / 1024, sb = b % 1024, swz = sb ^ (((sb >> 9) & 1) << 5); R = (st >> 1) * 16 + swz / 64; C = (st & 1) * 32 + (swz % 64) / 2; }
__device__ __forceinline__ int perm32(int rho) { const int n = rho >> 4, i = rho & 15; return 8 * (i >> 2) + 4 * n + (i & 3); }

struct Unit { int pm, pn, half; };
struct Gemm { const char* A; const char* Bt; int lda, ldb, K, nM, nN, amod, akoff; size_t bstride; int bmod = 1 << 30; size_t bstride2 = 0; int bperm = 0; int bkc = 16; };
__device__ __forceinline__ const char* aptr(const Gemm& g, const Unit& u) { return g.A + (size_t)(u.pm % g.amod) * (size_t)512 * g.lda + (size_t)u.pn * g.akoff; }
__device__ __forceinline__ const char* bptr(const Gemm& g, const Unit& u) {
    if (g.bperm) return g.Bt + (size_t)((u.pn >> 4) * 4096 + 4 * (u.pn & 15)) * (size_t)2 * g.ldb;
    return g.Bt + (size_t)(u.pm / g.bmod) * g.bstride + (size_t)(u.pm % g.bmod) * g.bstride2 + (size_t)u.pn * (size_t)512 * g.ldb; }

struct Order {
    int nM, nN, nwg, G, c, lo, hi;
    __device__ __forceinline__ void init(int nM_, int nN_, int G_, int c_) { nM = nM_; nN = nN_; nwg = nM * nN; G = G_; c = c_; lo = 0; hi = nwg; }
    __device__ __forceinline__ bool next(int i, Unit& u) const {
        const long L = (long)lo + (long)i * G + c; if (L >= hi) return false;
        int wgid = (int)L; u.half = 0; { const int q = nwg / NXCD, r = nwg % NXCD, xcd = wgid % NXCD, off = wgid / NXCD; wgid = (xcd < r ? xcd * (q + 1) : r * (q + 1) + (xcd - r) * q) + off; }
        const int nig = WGM * nN, gid = wgid / nig, fm = gid * WGM, gsz = (nM - fm) < WGM ? (nM - fm) : WGM;
        u.pm = fm + ((wgid % nig) % gsz); u.pn = (wgid % nig) / gsz; return true;
    }
};


struct EpiRes {
    static constexpr bool PERM = true;
    const float* src0; const float* src1;
    const bf16_t* xin; bf16_t* xout;
    float* dst;
    const float* gate; const float* pscale; int pm0; int rowmap;
    __device__ __forceinline__ void operator()(f32x4 (&acc)[2][2][4][2], const Unit& u, int wr, int wc, int fr, int fq, LAS unsigned char*) const {
        asm volatile("" : "+v"(fr), "+v"(fq), "+s"(wr), "+s"(wc));
        const int rowt = rowmap ? NCTX + (u.pm >> 4) * 4096 + 4 * (u.pm & 15) : (pm0 + u.pm) * BM; const float* g = gate + (size_t)cond_of_row(rowt) * NMOD;
        const int col0 = u.pn * BM + wc * 32 + 8 * fq;
        f32x4 gv[2][2];
#pragma unroll
        for (int bj = 0; bj < 2; ++bj)
#pragma unroll
            for (int n = 0; n < 2; ++n) { gv[bj][n] = *(const f32x4*)(g + col0 + bj * HALF + n * 4); if (pscale) gv[bj][n] = gv[bj][n] * *(const f32x4*)(pscale + col0 + bj * HALF + n * 4); }
#pragma unroll
        for (int ai = 0; ai < 2; ++ai) { if (u.half == 2 - ai) continue;
#pragma unroll
            for (int m = 0; m < 4; ++m) {
                const int row = rowmap ? rowt + 2 * ai + wr + 64 * (16 * m + fr) : rowt + ai * HALF + wr * 64 + m * 16 + fr;
#pragma unroll
                for (int bj = 0; bj < 2; ++bj) {
                    f32x4 x0, x1;
                    if (xin) { const u32x4 w = *(const u32x4*)(xin + (size_t)row * DM + col0 + bj * HALF);
                        x0 = (f32x4){bf2f(w.x & 0xffffu), bf2f(w.x >> 16), bf2f(w.y & 0xffffu), bf2f(w.y >> 16)}; x1 = (f32x4){bf2f(w.z & 0xffffu), bf2f(w.z >> 16), bf2f(w.w & 0xffffu), bf2f(w.w >> 16)}; }
                    else { const float* s = (row < NCTX ? src0 + (size_t)row * DM : src1 + (size_t)(row - NCTX) * DM) + col0 + bj * HALF; x0 = *(const f32x4*)s; x1 = *(const f32x4*)(s + 4); }
                    x0 = x0 + gv[bj][0] * acc[ai][bj][m][0]; x1 = x1 + gv[bj][1] * acc[ai][bj][m][1];
                    if (xout) { u32x4 w; w.x = cvtpk(x0[0], x0[1]); w.y = cvtpk(x0[2], x0[3]); w.z = cvtpk(x1[0], x1[1]); w.w = cvtpk(x1[2], x1[3]); *(u32x4*)(xout + (size_t)row * DM + col0 + bj * HALF) = w; }
                    if (dst) { float* d = dst + (size_t)row * DM + col0 + bj * HALF; *(f32x4*)d = x0; *(f32x4*)(d + 4) = x1; }
                }
            } }
    }
};

struct EpiQKV {
    static constexpr bool PERM = false;
    bf16_t* Q; bf16_t* Kb; bf16_t* VT; float* ock; float* ocv; const float* qn; const float* kn; const float* ropec; const float* ropes;
    __device__ __forceinline__ void operator()(f32x4 (&acc)[2][2][4][2], const Unit& u, int wr, int wc, int fr, int fq, LAS unsigned char*) const {
        asm volatile("" : "+v"(fr), "+v"(fq), "+s"(wr), "+s"(wc));

        const int rowt = u.pm * BM; const bool lat = rowt >= NCTX; const int dl = 4 * fq;
        if (u.pn < 5) {
            const bool isq = u.pn < 4; const float* nw = isq ? qn : kn;
            f32x4 nwv[2][2];
#pragma unroll
            for (int bj = 0; bj < 2; ++bj)
#pragma unroll
                for (int n = 0; n < 2; ++n) nwv[bj][n] = *(const f32x4*)(nw + 32 * bj + 16 * n + dl);
#pragma unroll
            for (int ai = 0; ai < 2; ++ai)
#pragma unroll
                for (int m = 0; m < 4; ++m) {
                    const int row = rowt + ai * HALF + wr * 64 + m * 16 + fr;
                    float ss = 0.f;
#pragma unroll
                    for (int bj = 0; bj < 2; ++bj)
#pragma unroll
                        for (int n = 0; n < 2; ++n) { const f32x4 v = acc[ai][bj][m][n]; ss += (v[0] * v[0] + v[1] * v[1]) + (v[2] * v[2] + v[3] * v[3]); }
                    ss += __shfl_xor(ss, 16); ss += __shfl_xor(ss, 32);
                    const float rstd = 1.0f / sqrtf(ss * (1.0f / 64.0f) + 1e-6f);
                    f32x4 y[2][2];
#pragma unroll
                    for (int bj = 0; bj < 2; ++bj)
#pragma unroll
                        for (int n = 0; n < 2; ++n) y[bj][n] = acc[ai][bj][m][n] * rstd * nwv[bj][n];
                    if (!isq && !lat) {
                        float* p = ock + (size_t)(row >> 8) * 131072 + (size_t)(row & 255) * 256 + wc * 64 + dl;
#pragma unroll
                        for (int bj = 0; bj < 2; ++bj)
#pragma unroll
                            for (int n = 0; n < 2; ++n) *(f32x4*)(p + 32 * bj + 16 * n) = y[bj][n];
                    }
                    if (lat) {
                        const int lr = row - NCTX, pr = (lr & 4095) >> 6, pc = lr & 63;
#pragma unroll
                        for (int bj = 0; bj < 2; ++bj) {
                            const int pos = bj ? pc : pr;
                            const f32x4 c4 = *(const f32x4*)(ropec + pos * 16 + dl), s4 = *(const f32x4*)(ropes + pos * 16 + dl);
                            const f32x4 x1 = y[bj][0], x2 = y[bj][1];
                            y[bj][0] = x1 * c4 - x2 * s4; y[bj][1] = x1 * s4 + x2 * c4;
                        }
                    }
                    bf16_t* dstp;
                    if (isq) { dstp = Q + (size_t)row * DM + (4 * u.pn + wc) * 64 + dl;
#pragma unroll
                        for (int bj = 0; bj < 2; ++bj)
#pragma unroll
                            for (int n = 0; n < 2; ++n) y[bj][n] = y[bj][n] * QSCALE;
                    } else dstp = Kb + (size_t)row * K_LD + wc * 64 + dl;
#pragma unroll
                    for (int bj = 0; bj < 2; ++bj)
#pragma unroll
                        for (int n = 0; n < 2; ++n) { u32x2 w; w.x = cvtpk(y[bj][n][0], y[bj][n][1]); w.y = cvtpk(y[bj][n][2], y[bj][n][3]); *(u32x2*)(dstp + 32 * bj + 16 * n) = w; }
                }
        } else {
#pragma unroll
            for (int ai = 0; ai < 2; ++ai)
#pragma unroll
                for (int m = 0; m < 4; ++m) {
                    const int row = rowt + ai * HALF + wr * 64 + m * 16 + fr;
                    if (!lat) {
                        float* p = ocv + (size_t)(row >> 8) * 131072 + (size_t)(row & 255) * 256 + wc * 64 + dl;
#pragma unroll
                        for (int bj = 0; bj < 2; ++bj)
#pragma unroll
                            for (int n = 0; n < 2; ++n) *(f32x4*)(p + 32 * bj + 16 * n) = acc[ai][bj][m][n];
                    }
                    size_t sb; int pos, L;
                    if (lat) { const int lr = row - NCTX; sb = VT_LAT_BASE + (size_t)(lr >> 12) * VT_LAT_SEQ; pos = lr & 4095; L = VT_LDL; } else { sb = (size_t)(row >> 8) * VT_CTX_SEQ; pos = row & 255; L = VT_LDC; }
                    const int k16 = pos & 15, pp = (pos & ~15) + 8 * ((k16 >> 2) & 1) + (k16 & 3) + 4 * (k16 >> 3);
                    bf16_t* base = VT + sb + (size_t)(wc * 64 + dl) * L + pp;
#pragma unroll
                    for (int bj = 0; bj < 2; ++bj)
#pragma unroll
                        for (int n = 0; n < 2; ++n)
#pragma unroll
                            for (int e = 0; e < 4; ++e) base[(size_t)(32 * bj + 16 * n + e) * L] = f2bf(acc[ai][bj][m][n][e]);
                }
        }
    }
};

struct EpiChan {
    static constexpr bool PERM = true;
    bf16_t* PT; int lat;
    __device__ __forceinline__ void operator()(f32x4 (&acc)[2][2][4][2], const Unit& u, int wr, int wc, int fr, int fq, LAS unsigned char*) const {
        asm volatile("" : "+v"(fr), "+v"(fq), "+s"(wr), "+s"(wc));
#pragma unroll
        for (int ai = 0; ai < 2; ++ai)
#pragma unroll
            for (int m = 0; m < 4; ++m) {
                const int row = u.pm * BM + ai * HALF + wr * 64 + m * 16 + fr, part = row >> 10, n_ = row & 1023;
#pragma unroll
                for (int bj = 0; bj < 2; ++bj) {
                    bf16_t* d;
                    if (lat) d = PT + (size_t)(u.pn >> 4) * (1024 * 8192) + (size_t)n_ * 8192 + (4 * (u.pn & 15) + 2 * bj + (wc >> 1)) * 128 + part * 64 + (wc & 1) * 32 + 8 * fq;
                    else d = PT + (size_t)u.pn * (256 * 2048) + (size_t)n_ * 512 + part * 256 + bj * HALF + wc * 32 + 8 * fq;
                    const f32x4 v0 = acc[ai][bj][m][0], v1 = acc[ai][bj][m][1]; u32x4 w; w.x = cvtpk(v0[0], v0[1]); w.y = cvtpk(v0[2], v0[3]); w.z = cvtpk(v1[0], v1[1]); w.w = cvtpk(v1[2], v1[3]); *(u32x4*)d = w; }
            }
    }
};

struct EpiY1 {
    static constexpr bool PERM = true;
    bf16_t* YT;
    __device__ __forceinline__ void operator()(f32x4 (&acc)[2][2][4][2], const Unit& u, int wr, int wc, int fr, int fq, LAS unsigned char*) const {
        asm volatile("" : "+v"(fr), "+v"(fq), "+s"(wr), "+s"(wc));
#pragma unroll
        for (int ai = 0; ai < 2; ++ai)
#pragma unroll
            for (int m = 0; m < 4; ++m) {
                bf16_t* d = YT + (size_t)(u.pm * BM + ai * HALF + wr * 64 + m * 16 + fr) * 8192 + u.pn * BM + wc * 32 + 8 * fq;
#pragma unroll
                for (int bj = 0; bj < 2; ++bj) { const f32x4 v0 = acc[ai][bj][m][0], v1 = acc[ai][bj][m][1]; u32x4 w; w.x = cvtpk(v0[0], v0[1]); w.y = cvtpk(v0[2], v0[3]); w.z = cvtpk(v1[0], v1[1]); w.w = cvtpk(v1[2], v1[3]); *(u32x4*)(d + bj * HALF) = w; }
            }
    }
};

struct EpiFfn1 {
    static constexpr bool PERM = true;
    bf16_t* Aout; float* hal; const float* cw; const float* cb;
    __device__ __forceinline__ void operator()(f32x4 (&acc)[2][2][4][2], const Unit& u, int wr, int wc, int fr, int fq, LAS unsigned char* xl) const {
        asm volatile("" : "+v"(fr), "+v"(fq), "+s"(wr), "+s"(wc));

        LAS float* X = (LAS float*)xl;
        const int chl = wc * 32 + 8 * fq;
        LAS float* WL = (LAS float*)(xl + 9216);
        { const int t2 = (wr * 4 + wc) * 64 + fq * 16 + fr;
#pragma unroll
            for (int q = 0; q < 2; ++q) { const int idx = t2 + 512 * q, k = idx >> 8, c = idx & 255, col = (c >> 7) * DFF + u.pn * 128 + (c & 127); WL[idx] = (k < 3) ? cw[(size_t)k * DFF2 + col] : cb[col]; } }
#pragma unroll
        for (int ai = 0; ai < 2; ++ai) { const int blk = 2 * ai + wr;
            if (fr == 0) {
#pragma unroll
                for (int bj = 0; bj < 2; ++bj)
#pragma unroll
                    for (int n = 0; n < 2; ++n) *(LAS f32x4*)(X + ((blk * 2 + 0) * 2 + bj) * 128 + chl + 4 * n) = acc[ai][bj][0][n]; }
            if (fr == 15) {
#pragma unroll
                for (int bj = 0; bj < 2; ++bj)
#pragma unroll
                    for (int n = 0; n < 2; ++n) *(LAS f32x4*)(X + ((blk * 2 + 1) * 2 + bj) * 128 + chl + 4 * n) = acc[ai][bj][3][n]; }
        }
        { float* hp = hal + (size_t)u.pm * 4 * DFF2 + u.pn * 128 + chl;
            if (wr == 0 && fr < 2) {
#pragma unroll
                for (int bj = 0; bj < 2; ++bj)
#pragma unroll
                    for (int n = 0; n < 2; ++n) *(f32x4*)(hp + (size_t)fr * DFF2 + bj * DFF + 4 * n) = acc[0][bj][0][n]; }
            if (wr == 1 && fr >= 14) {
#pragma unroll
                for (int bj = 0; bj < 2; ++bj)
#pragma unroll
                    for (int n = 0; n < 2; ++n) *(f32x4*)(hp + (size_t)(fr - 12) * DFF2 + bj * DFF + 4 * n) = acc[1][bj][3][n]; }
        }
        asm volatile("s_waitcnt lgkmcnt(0)" ::: "memory"); __builtin_amdgcn_s_barrier(); asm volatile("" ::: "memory");
        const f32x4 z4 = {0.f, 0.f, 0.f, 0.f};
#pragma unroll
        for (int n = 0; n < 2; ++n) {
            const LAS float* wl = WL + chl + 4 * n;
#define CW_(k, bj) (*(const LAS f32x4*)(wl + (k) * 256 + (bj) * 128))
#pragma unroll
            for (int ai = 0; ai < 2; ++ai) { const int blk = 2 * ai + wr;
                f32x4 top[2], bot[2];
#pragma unroll
                for (int bj = 0; bj < 2; ++bj) {
                    top[bj] = blk > 0 ? *(LAS f32x4*)(X + (((blk - 1) * 2 + 1) * 2 + bj) * 128 + chl + 4 * n) : z4;
                    bot[bj] = blk < 3 ? *(LAS f32x4*)(X + (((blk + 1) * 2 + 0) * 2 + bj) * 128 + chl + 4 * n) : z4; }
#pragma unroll
                for (int m = 0; m < 4; ++m) {
                    f32x4 cv[2];
#pragma unroll
                    for (int bj = 0; bj < 2; ++bj) {
                        const f32x4 cur = acc[ai][bj][m][n];
                        f32x4 pr = dpp_prev4(cur), nx = dpp_next4(cur);
                        const f32x4 pe = (m > 0) ? dpp_prev4(acc[ai][bj][m > 0 ? m - 1 : 0][n]) : top[bj];
                        const f32x4 ne = (m < 3) ? dpp_next4(acc[ai][bj][m < 3 ? m + 1 : 3][n]) : bot[bj];
                        if (fr == 0) pr = pe;
                        if (fr == 15) nx = ne;
                        cv[bj] = CW_(0, bj) * pr + CW_(1, bj) * cur + CW_(2, bj) * nx + CW_(3, bj);
                    }
                    u32x2 w; w.x = cvtpk(silu_mul(cv[0][0], cv[1][0]), silu_mul(cv[0][1], cv[1][1])); w.y = cvtpk(silu_mul(cv[0][2], cv[1][2]), silu_mul(cv[0][3], cv[1][3]));
                    *(u32x2*)(Aout + (size_t)(u.pm * BM + ai * HALF + wr * 64 + m * 16 + fr) * DFF + u.pn * 128 + chl + 4 * n) = w;
                }
            }
        }
    }
};

template <class Epi, int HM = 0>
__device__ __forceinline__ void gemm_phase(LAS unsigned char* lds, LAS unsigned char* xl, const Gemm g, const Order& S, const Epi& E, const int tid) {
    const int wid = __builtin_amdgcn_readfirstlane(tid >> 6), lane = tid & 63, wr = wid >> 2, wc = wid & 3, fr = lane & 15, fq = lane >> 4;
    const int nt = g.K / BK;
    unsigned voffA[2], voffB[2];
#pragma unroll
    for (int i = 0; i < 2; ++i) { int R, C; stage_rc(tid * 16 + i * 8192, R, C); const int Rb = Epi::PERM ? ((R & ~31) + perm32(R & 31)) : R;
        const int Rt = g.bperm ? 64 * (Rb & 63) + (Rb >> 6) : Rb;
        voffA[i] = (unsigned)(R * g.lda + C) * 2u; voffB[i] = (unsigned)(Rt * g.ldb) * 2u + (unsigned)((C >> 3) * g.bkc); }
    const size_t kstep = (size_t)(BK * 2), kstepB = (size_t)(8 * g.bkc);
    const size_t hA = (size_t)HALF * g.lda * 2, hB = g.bperm ? (size_t)4 * g.ldb : (size_t)HALF * g.ldb * 2;
    const unsigned ldsw = (unsigned)wid * 1024u;
    const int aoff = lds_byte(wr * 64 + fr, fq * 8), boff = lds_byte(wc * 32 + fr, fq * 8);
#define PG8_SA(b, h) (((b) * 2 + (h)) * HTB)
#define PG8_SB(b, h) ((4 + (b) * 2 + (h)) * HTB)
#define PG8_STAGE(bufoff, gbase, voff) do { _Pragma("unroll") for (int _i = 0; _i < 2; ++_i) \
        __builtin_amdgcn_global_load_lds((const unsigned*)((const char*)(gbase) + (voff)[_i]), (LAS unsigned*)(lds + (bufoff) + ldsw + _i * 8192), 16, 0, 0); } while (0)
#define PG8_LDA(dst, b, h) do { _Pragma("unroll") for (int m = 0; m < 4; ++m) _Pragma("unroll") for (int k = 0; k < 2; ++k) dst[m][k] = *(const LAS bf16x8*)(lds + PG8_SA(b, h) + aoff + m * 2048 + k * 1024); } while (0)
#define PG8_LDB(dst, b, h) do { _Pragma("unroll") for (int n = 0; n < 2; ++n) _Pragma("unroll") for (int k = 0; k < 2; ++k) dst[n][k] = *(const LAS bf16x8*)(lds + PG8_SB(b, h) + boff + n * 2048 + k * 1024); } while (0)
#define PG8_MMA(ai, bj, At, Bt) do { __builtin_amdgcn_s_setprio(1); _Pragma("unroll") for (int m = 0; m < 4; ++m) _Pragma("unroll") for (int n = 0; n < 2; ++n) _Pragma("unroll") for (int k = 0; k < 2; ++k) \
        acc[ai][bj][m][n] = __builtin_amdgcn_mfma_f32_16x16x32_bf16(Bt[n][k], At[m][k], acc[ai][bj][m][n], 0, 0, 0); __builtin_amdgcn_s_setprio(0); } while (0)
#define PG8_WAIT_V(n) asm volatile("s_waitcnt vmcnt(" #n ")" ::: "memory")
#define PG8_WAIT_L(n) asm volatile("s_waitcnt lgkmcnt(" #n ")" ::: "memory")
#define PG8_BAR __builtin_amdgcn_s_barrier()
#define PG8_SCHED __builtin_amdgcn_sched_barrier(0)
    Unit cur, nxt; int ui = 0;
    if (!S.next(0, cur)) return;
    f32x4 acc[2][2][4][2];
#pragma unroll
    for (int a = 0; a < 2; ++a)
#pragma unroll
        for (int b = 0; b < 2; ++b)
#pragma unroll
            for (int m = 0; m < 4; ++m)
#pragma unroll
                for (int n = 0; n < 2; ++n) acc[a][b][m][n] = (f32x4){0.f, 0.f, 0.f, 0.f};
    bf16x8 At[4][2], B0[2][2], B1[2][2];
    const char* cA = aptr(g, cur); const char* cB = bptr(g, cur);
    PG8_STAGE(PG8_SB(0, 0), cB, voffB); PG8_STAGE(PG8_SB(0, 1), cB + hB, voffB); PG8_STAGE(PG8_SA(0, 0), cA, voffA); PG8_STAGE(PG8_SA(0, 1), cA + hA, voffA);
    if (wr == 1) PG8_BAR;
    PG8_WAIT_V(2); PG8_BAR;
    PG8_STAGE(PG8_SB(1, 0), cB + kstepB, voffB); PG8_STAGE(PG8_SA(1, 0), cA + kstep, voffA); PG8_STAGE(PG8_SB(1, 1), cB + hB + kstepB, voffB);
    PG8_WAIT_V(6); PG8_BAR;
    for (;;) {
        const bool has_next = S.next(ui + 1, nxt);
        const char* nA = has_next ? aptr(g, nxt) : cA; const char* nB = has_next ? bptr(g, nxt) : cB;
        for (int t = 0; t < nt; t += 2) {
            const bool last = (t == nt - 2);
            const char* a1 = cA + (size_t)(t + 1) * kstep;
            const char* a2 = last ? nA : cA + (size_t)(t + 2) * kstep; const char* b2 = last ? nB : cB + (size_t)(t + 2) * kstepB;
            const char* a3 = a2 + kstep; const char* b3 = b2 + kstepB;
            PG8_LDB(B0, 0, 0); PG8_LDB(B1, 0, 1); PG8_SCHED; PG8_LDA(At, 0, 0); PG8_STAGE(PG8_SA(1, 1), a1 + hA, voffA);
            PG8_WAIT_V(8); PG8_WAIT_L(0); PG8_BAR; if constexpr (HM != 2) { PG8_MMA(0, 0, At, B0); PG8_MMA(0, 1, At, B1); } PG8_BAR; PG8_SCHED;
            PG8_LDA(At, 0, 1); PG8_STAGE(PG8_SB(0, 0), b2, voffB); PG8_STAGE(PG8_SB(0, 1), b2 + hB, voffB); PG8_STAGE(PG8_SA(0, 0), a2, voffA);
            PG8_WAIT_V(8); PG8_WAIT_L(0); PG8_BAR; if constexpr (HM != 1) { PG8_MMA(1, 0, At, B0); PG8_MMA(1, 1, At, B1); } PG8_BAR; PG8_SCHED;
            PG8_LDB(B0, 1, 0); PG8_LDB(B1, 1, 1); PG8_SCHED; PG8_LDA(At, 1, 0); PG8_STAGE(PG8_SA(0, 1), a2 + hA, voffA);
            PG8_WAIT_V(8); PG8_WAIT_L(0); PG8_BAR; if constexpr (HM != 2) { PG8_MMA(0, 0, At, B0); PG8_MMA(0, 1, At, B1); } PG8_BAR; PG8_SCHED;
            PG8_LDA(At, 1, 1); PG8_STAGE(PG8_SB(1, 0), b3, voffB); PG8_STAGE(PG8_SB(1, 1), b3 + hB, voffB); PG8_STAGE(PG8_SA(1, 0), a3, voffA);
            PG8_WAIT_V(8); PG8_WAIT_L(0); PG8_BAR; if constexpr (HM != 1) { PG8_MMA(1, 0, At, B0); PG8_MMA(1, 1, At, B1); } PG8_BAR; PG8_SCHED;
        }
        if (wr == 0) PG8_BAR;
        cur.half = HM; E(acc, cur, wr, wc, fr, fq, xl);
        if (!has_next) break;
#pragma unroll
        for (int a = 0; a < 2; ++a)
#pragma unroll
            for (int b = 0; b < 2; ++b)
#pragma unroll
                for (int m = 0; m < 4; ++m)
#pragma unroll
                    for (int n = 0; n < 2; ++n) acc[a][b][m][n] = (f32x4){0.f, 0.f, 0.f, 0.f};
        cur = nxt; cA = nA; cB = nB; ++ui;
        if (wr == 1) PG8_BAR;
    }
    PG8_WAIT_V(0);
    PG8_BAR;
#undef PG8_SA
#undef PG8_SB
#undef PG8_STAGE
#undef PG8_LDA
#undef PG8_LDB
#undef PG8_MMA
#undef PG8_WAIT_V
#undef PG8_WAIT_L
#undef PG8_BAR
#undef PG8_SCHED
}
}


#define XB_TMO      128
#define XB_XCNT(j)  (256  + 64 * (j))
#define XB_XSUB(j)  (1280 + 64 * (j))
#define XB_XGEN(j)  (2304 + 64 * (j))
#define XB_TOP      3328
#define XB_TOPGEN   3392
#define XCD_BAR_WORDS 3456
#define XB_SPIN_CAP (1u << 18)
__device__ __forceinline__ unsigned xb_ld(unsigned* p)              { return __hip_atomic_load(p, __ATOMIC_RELAXED, __HIP_MEMORY_SCOPE_AGENT); }
__device__ __forceinline__ unsigned xb_add(unsigned* p, unsigned v) { return __hip_atomic_fetch_add(p, v, __ATOMIC_RELAXED, __HIP_MEMORY_SCOPE_AGENT); }
__device__ __forceinline__ unsigned xb_xcc_id() { return (unsigned)__builtin_amdgcn_s_getreg((3 << 11) | 20) & 0xFu; }
#define XB_SPIN(cond, bar) do { unsigned _sp = 0; while (cond) { __builtin_amdgcn_s_sleep(1); \
    if ((++_sp & 255u) == 0u) { if (xb_ld(&(bar)[XB_TMO])) break; if (_sp > XB_SPIN_CAP) { atomicAdd(&(bar)[XB_TMO], 1u); break; } } } } while (0)
__device__ __forceinline__ void xcd_barrier_complete(unsigned* bar, unsigned x, unsigned& nloc, unsigned& nx) {
    const unsigned G = gridDim.x * gridDim.y * gridDim.z;
    unsigned sum, cnt, mine, sp = 0u;
    for (;;) {
        sum = 0u; cnt = 0u; mine = 0u;
#pragma unroll
        for (unsigned j = 0; j < 16; ++j) { const unsigned c = xb_ld(&bar[XB_XCNT(j)]); sum += c; cnt += (c > 0u) ? 1u : 0u; mine = (j == x) ? c : mine; }
        if (sum == G) break;
        __builtin_amdgcn_s_sleep(1);
        if ((++sp & 255u) == 0u) { if (xb_ld(&bar[XB_TMO])) break; if (sp > XB_SPIN_CAP) { atomicAdd(&bar[XB_TMO], 1u); break; } }
    }
    nloc = mine > 0u ? mine : 1u; nx = cnt > 0u ? cnt : 1u;
}
__device__ __forceinline__ void xcd_barrier(unsigned* bar, unsigned x, volatile LAS unsigned* st) {
    asm volatile("s_waitcnt vmcnt(0)" ::: "memory");
    __syncthreads();
    if (threadIdx.x == 0) {
        __builtin_amdgcn_s_waitcnt(0);
        unsigned nloc = st[0], nx = st[1];
        if (nloc == 0u) { xcd_barrier_complete(bar, x, nloc, nx); st[0] = nloc; st[1] = nx; }
        const unsigned old = xb_add(&bar[XB_XSUB(x)], 1u);
        const unsigned gen = old / nloc;
        if (old + 1u == (gen + 1u) * nloc) {
            __builtin_amdgcn_fence(__ATOMIC_RELEASE, "agent");
            asm volatile("s_waitcnt vmcnt(0)" ::: "memory");
            const unsigned og = xb_add(&bar[XB_TOP], 1u);
            const unsigned tg = og / nx;
            if (og + 1u == (tg + 1u) * nx) xb_add(&bar[XB_TOPGEN], 1u);
            else XB_SPIN(xb_ld(&bar[XB_TOPGEN]) == tg, bar);
            __builtin_amdgcn_fence(__ATOMIC_ACQUIRE, "agent");
            xb_add(&bar[XB_XGEN(x)], 1u);
            asm volatile("s_waitcnt vmcnt(0)" ::: "memory");
        } else {
            XB_SPIN(xb_ld(&bar[XB_XGEN(x)]) == gen, bar);
            __builtin_amdgcn_fence(__ATOMIC_ACQUIRE, "agent");
            asm volatile("s_waitcnt vmcnt(0)" ::: "memory");
        }
    }
    __syncthreads();
}

#define MFMA32(a, b, c) __builtin_amdgcn_mfma_f32_32x32x16_bf16((a), (b), (c), 0, 0, 0)
__device__ __forceinline__ int crow(int r, int hi) { return (r & 3) + 8 * (r >> 2) + 4 * hi; }

__device__ __forceinline__ void attn_phase(bf16_t* Q, const bf16_t* Kb, const bf16_t* VT, const bf16_t* CK, const bf16_t* CVT, const float* sink, int j, int vcu, int G, int wave, int lane) {
    const int r = lane & 31, h = lane >> 5;
    for (int u = vcu; u < 1280; u += G) {
        const bool lat = u < 1024;
        int b, kvh, qb, L, seqrow;
        if (lat) { b = u >> 7; kvh = (u >> 5) & 3; qb = u & 31; L = 4096; seqrow = NCTX + b * 4096; }
        else { const int v = u - 1024; b = v >> 3; kvh = (v >> 1) & 3; qb = v & 1; L = 256; seqrow = b * 256; }
        const int hq = kvh * 4 + (wave & 3), t0 = qb * 128 + (wave >> 2) * 64;
        bf16_t* Qp = Q + (size_t)(seqrow + t0) * DM + hq * 64;
        bf16x8 qf[2][4];
#pragma unroll
        for (int qi = 0; qi < 2; ++qi)
#pragma unroll
            for (int ks = 0; ks < 4; ++ks) qf[qi][ks] = *(const bf16x8*)(Qp + (size_t)(qi * 32 + r) * DM + ks * 16 + h * 8);
        const float m0 = sink[hq] * LOG2E;
        float mrow[2] = {m0, m0}, lrow[2] = {h == 0 ? 1.f : 0.f, h == 0 ? 1.f : 0.f};
        f32x16 O[2][2];
#pragma unroll
        for (int qi = 0; qi < 2; ++qi)
#pragma unroll
            for (int db = 0; db < 2; ++db)
#pragma unroll
                for (int i = 0; i < 16; ++i) O[qi][db][i] = 0.f;
        const int nseg = lat ? 2 : 1;
        for (int seg = 0; seg < nseg; ++seg) {
            const bf16_t* kb; const bf16_t* vb; int ldv, klo, khi; bool mask;
            if (seg == 0) { kb = Kb + (size_t)seqrow * K_LD + kvh * 64; ldv = lat ? VT_LDL : VT_LDC; vb = VT + (lat ? VT_LAT_BASE + (size_t)b * VT_LAT_SEQ : (size_t)b * VT_CTX_SEQ) + (size_t)kvh * 64 * ldv;
                if (lat) { klo = t0 - 128 < 0 ? 0 : t0 - 128; khi = t0 + 192 > L ? L : t0 + 192; mask = true; } else { klo = 0; khi = 256; mask = false; } }
            else { kb = CK + (size_t)(b * 2 + j) * 512 * K_LD + kvh * 64; vb = CVT + (size_t)((b * 2 + j) * 4 + kvh) * 64 * CVT_LD; ldv = CVT_LD; klo = 0; khi = 512; mask = false; }
            bf16x8 kf[4];
#pragma unroll
            for (int ks = 0; ks < 4; ++ks) kf[ks] = *(const bf16x8*)(kb + (size_t)(klo + r) * K_LD + ks * 16 + h * 8);
            bf16x8 vf[2][2];
#pragma unroll
            for (int db = 0; db < 2; ++db)
#pragma unroll
                for (int s = 0; s < 2; ++s) vf[db][s] = *(const bf16x8*)(vb + (size_t)(db * 32 + r) * ldv + klo + s * 16 + h * 8);
            for (int key = klo; key < khi; key += 32) {
                bf16x8 kn[4], vn[2][2];
                const int keyn = (key + 32 < khi) ? key + 32 : key;
#pragma unroll
                for (int db = 0; db < 2; ++db)
#pragma unroll
                    for (int s = 0; s < 2; ++s) vn[db][s] = *(const bf16x8*)(vb + (size_t)(db * 32 + r) * ldv + keyn + s * 16 + h * 8);
#pragma unroll
                for (int ks = 0; ks < 4; ++ks) kn[ks] = *(const bf16x8*)(kb + (size_t)(keyn + r) * K_LD + ks * 16 + h * 8);
                f32x16 S[2];
#pragma unroll
                for (int qi = 0; qi < 2; ++qi) {
#pragma unroll
                    for (int i = 0; i < 16; ++i) S[qi][i] = 0.f;
#pragma unroll
                    for (int ks = 0; ks < 4; ++ks) S[qi] = MFMA32(kf[ks], qf[qi][ks], S[qi]);
                }
                if (mask) {
#pragma unroll
                    for (int qi = 0; qi < 2; ++qi) { const int t = t0 + qi * 32 + r;
#pragma unroll
                        for (int i = 0; i < 16; ++i) { const int d = t - (key + crow(i, h)); if (d > 128 || d < -128) S[qi][i] = -1e30f; } }
                }
#pragma unroll
                for (int qi = 0; qi < 2; ++qi) {
                    float tm = S[qi][0];
#pragma unroll
                    for (int i = 1; i < 16; ++i) tm = fmaxf(tm, S[qi][i]);
                    tm = fmaxf(tm, __shfl_xor(tm, 32));
                    if (__any(tm > mrow[qi] + 8.0f)) {
                        const float mn = fmaxf(mrow[qi], tm), alpha = __builtin_amdgcn_exp2f(mrow[qi] - mn);
                        mrow[qi] = mn; lrow[qi] *= alpha;
#pragma unroll
                        for (int db = 0; db < 2; ++db)
#pragma unroll
                            for (int i = 0; i < 16; ++i) O[qi][db][i] *= alpha;
                    }
                    const float mn = mrow[qi];
                    float ps = 0.f;
#pragma unroll
                    for (int i = 0; i < 16; ++i) { S[qi][i] = __builtin_amdgcn_exp2f(S[qi][i] - mn); ps += S[qi][i]; }
                    lrow[qi] += ps;
                    bf16x8 pk[2];
#pragma unroll
                    for (int s = 0; s < 2; ++s) { u32x4 w; w.x = cvtpk(S[qi][8 * s], S[qi][8 * s + 1]); w.y = cvtpk(S[qi][8 * s + 2], S[qi][8 * s + 3]); w.z = cvtpk(S[qi][8 * s + 4], S[qi][8 * s + 5]); w.w = cvtpk(S[qi][8 * s + 6], S[qi][8 * s + 7]); pk[s] = __builtin_bit_cast(bf16x8, w); }
#pragma unroll
                    for (int db = 0; db < 2; ++db)
#pragma unroll
                        for (int s = 0; s < 2; ++s) O[qi][db] = MFMA32(vf[db][s], pk[s], O[qi][db]);
                }
#pragma unroll
                for (int ks = 0; ks < 4; ++ks) kf[ks] = kn[ks];
#pragma unroll
                for (int db = 0; db < 2; ++db)
#pragma unroll
                    for (int s = 0; s < 2; ++s) vf[db][s] = vn[db][s];
            }
        }
#pragma unroll
        for (int qi = 0; qi < 2; ++qi) {
            const float lt = lrow[qi] + __shfl_xor(lrow[qi], 32), inv = 1.0f / lt;
#pragma unroll
            for (int db = 0; db < 2; ++db)
#pragma unroll
                for (int g4 = 0; g4 < 4; ++g4) { u32x2 w; w.x = cvtpk(O[qi][db][4 * g4] * inv, O[qi][db][4 * g4 + 1] * inv); w.y = cvtpk(O[qi][db][4 * g4 + 2] * inv, O[qi][db][4 * g4 + 3] * inv);
                    *(u32x2*)(Qp + (size_t)(qi * 32 + r) * DM + db * 32 + 8 * g4 + 4 * h) = w; }
        }
    }
}

__device__ __forceinline__ float wave_sum(float v) {
#pragma unroll
    for (int o = 1; o < 64; o <<= 1) v += __shfl_xor(v, o);
    return v;
}
__device__ __forceinline__ void prep_phase(const float* src0, const float* src1, const bf16_t* xb, bf16_t* H, const float* nw, const float* mods, int shoff, int scoff, int gw, int NGW, int lane) {
    for (int row = gw; row < NTOK; row += NGW) {
        const float* md = mods + (size_t)cond_of_row(row) * NMOD;
        f32x4 v[4]; float ss = 0.f;
        if (xb) {
#pragma unroll
            for (int q = 0; q < 2; ++q) { const u32x4 w = *(const u32x4*)(xb + (size_t)row * DM + 512 * q + 8 * lane);
                v[2 * q] = (f32x4){bf2f(w.x & 0xffffu), bf2f(w.x >> 16), bf2f(w.y & 0xffffu), bf2f(w.y >> 16)}; v[2 * q + 1] = (f32x4){bf2f(w.z & 0xffffu), bf2f(w.z >> 16), bf2f(w.w & 0xffffu), bf2f(w.w >> 16)}; }
        } else { const float* s = row < NCTX ? src0 + (size_t)row * DM : src1 + (size_t)(row - NCTX) * DM;
#pragma unroll
            for (int q = 0; q < 2; ++q) { v[2 * q] = *(const f32x4*)(s + 512 * q + 8 * lane); v[2 * q + 1] = *(const f32x4*)(s + 512 * q + 8 * lane + 4); } }
#pragma unroll
        for (int q = 0; q < 4; ++q) ss += (v[q][0] * v[q][0] + v[q][1] * v[q][1]) + (v[q][2] * v[q][2] + v[q][3] * v[q][3]);
        const float rstd = 1.0f / sqrtf(wave_sum(ss) * (1.0f / DM) + 1e-6f);
#pragma unroll
        for (int q = 0; q < 2; ++q) { const int c = 512 * q + 8 * lane; u32x4 w;
#pragma unroll
            for (int hh = 0; hh < 2; ++hh) { const f32x4 g4 = *(const f32x4*)(nw + c + 4 * hh), sc = *(const f32x4*)(md + scoff + c + 4 * hh), sh = *(const f32x4*)(md + shoff + c + 4 * hh);
                const f32x4 o = v[2 * q + hh] * rstd * g4 * (sc + 1.0f) + sh; w[2 * hh] = cvtpk(o[0], o[1]); w[2 * hh + 1] = cvtpk(o[2], o[3]); }
            *(u32x4*)(H + (size_t)row * DM + c) = w; }
    }
}
__device__ __forceinline__ void pool_phase(const bf16_t* H, bf16_t* P, int gw, int NGW, int lane) {
    for (int row = gw; row < NTOK; row += NGW) {
        int sb, t, L;
        if (row < NCTX) { sb = row & ~255; t = row & 255; L = 256; } else { const int lr = row - NCTX; sb = NCTX + (lr & ~4095); t = lr & 4095; L = 4096; }
#pragma unroll
        for (int q = 0; q < 2; ++q) { const int c8 = lane + 64 * q, grp = c8 >> 5, hw = 1 << grp;
            int st = t - hw; if (st < 0) st = 0; int en = t + hw; if (en > L) en = L;
            float a[8];
#pragma unroll
            for (int e = 0; e < 8; ++e) a[e] = 0.f;
            for (int jr = st; jr < en; ++jr) { const u32x4 w = *(const u32x4*)(H + (size_t)(sb + jr) * DM + c8 * 8);
#pragma unroll
                for (int e = 0; e < 4; ++e) { a[2 * e] += bf2f(w[e] & 0xffffu); a[2 * e + 1] += bf2f(w[e] >> 16); } }
            const float inv = 1.0f / (float)(en - st);
            const u32x4 w = *(const u32x4*)(H + (size_t)row * DM + c8 * 8); u32x4 o;
#pragma unroll
            for (int e = 0; e < 4; ++e) o[e] = cvtpk(a[2 * e] * inv - bf2f(w[e] & 0xffffu), a[2 * e + 1] * inv - bf2f(w[e] >> 16));
            *(u32x4*)(P + (size_t)row * DM + c8 * 8) = o; }
    }
}
__device__ __forceinline__ void fix_phase(const float* hal, bf16_t* A, const float* cw, const float* cb, int gt, int GT) {
    for (int it = gt; it < 120 * 704; it += GT) {
        const int bi = it / 704, c = (it % 704) * 4, b = bi / 15, i = bi % 15 + 1, pmh = 32 + b * 16 + i;
        const float* hl = hal + (size_t)(pmh - 1) * 4 * DFF2; const float* hh = hal + (size_t)pmh * 4 * DFF2;
        f32x4 cv1[2], cv2[2];
#pragma unroll
        for (int bj = 0; bj < 2; ++bj) { const int col = bj * DFF + c;
            const f32x4 uA = *(const f32x4*)(hl + 2 * DFF2 + col), uB = *(const f32x4*)(hl + 3 * DFF2 + col), uC = *(const f32x4*)(hh + col), uD = *(const f32x4*)(hh + DFF2 + col);
            const f32x4 w0 = *(const f32x4*)(cw + col), w1 = *(const f32x4*)(cw + DFF2 + col), w2 = *(const f32x4*)(cw + 2 * DFF2 + col), bb = *(const f32x4*)(cb + col);
            cv1[bj] = w0 * uA + w1 * uB + w2 * uC + bb; cv2[bj] = w0 * uB + w1 * uC + w2 * uD + bb; }
        const size_t R = (size_t)pmh * 256;
        u32x2 w; w.x = cvtpk(silu_mul(cv1[0][0], cv1[1][0]), silu_mul(cv1[0][1], cv1[1][1])); w.y = cvtpk(silu_mul(cv1[0][2], cv1[1][2]), silu_mul(cv1[0][3], cv1[1][3]));
        *(u32x2*)(A + (R - 1) * DFF + c) = w;
        w.x = cvtpk(silu_mul(cv2[0][0], cv2[1][0]), silu_mul(cv2[0][1], cv2[1][1])); w.y = cvtpk(silu_mul(cv2[0][2], cv2[1][2]), silu_mul(cv2[0][3], cv2[1][3]));
        *(u32x2*)(A + R * DFF + c) = w;
    }
}

__device__ __forceinline__ void transpose_item(const float* W, int K, int N, bf16_t* WT, int mapkind, LAS float* scr, int item, int lane) {
    const int nblk = N / 32, kb = item / nblk, nb = item % nblk, k0 = 64 * kb, n0 = 32 * nb;
    int d0 = n0;
    if (mapkind == 1) { const int head = n0 >> 6, bj = (n0 >> 5) & 1; d0 = 256 * (head >> 2) + 128 * bj + 32 * (head & 3); }
    else if (mapkind == 2) { const int bj = n0 >= DFF ? 1 : 0, cc = n0 - bj * DFF; d0 = 256 * (cc >> 7) + 128 * bj + (cc & 127); }
#pragma unroll 32
    for (int i = 0; i < 32; ++i) { const int kk = 2 * i + (lane >> 5); scr[kk * 33 + (lane & 31)] = W[(size_t)(k0 + kk) * N + n0 + (lane & 31)]; }
    asm volatile("s_waitcnt lgkmcnt(0)" ::: "memory");
    const int c = lane & 7;
#pragma unroll
    for (int jj = 0; jj < 4; ++jj) { const int n = (lane >> 3) + 8 * jj; const LAS float* s = scr + (8 * c) * 33 + n;
        u32x4 o; o.x = cvtpk(s[0 * 33], s[1 * 33]); o.y = cvtpk(s[2 * 33], s[3 * 33]); o.z = cvtpk(s[4 * 33], s[5 * 33]); o.w = cvtpk(s[6 * 33], s[7 * 33]);
        *(u32x4*)(WT + (size_t)(d0 + n) * K + k0 + 8 * c) = o; }
    asm volatile("s_waitcnt lgkmcnt(0)" ::: "memory");
}

enum { K_PRO = 0, K_PREP1, K_PREP2, K_QKV, K_ATTN, K_WO, K_POOLP, K_POOLG, K_CHAN, K_SEQC, K_SEQL, K_FFN1, K_FIX, K_FFN2, K_ST1, K_ST2, K_FFN2X };
#ifndef PROBE_DUP
#define PROBE_DUP(X, k)
#endif
#define PROG_LIST(X) X(K_PRO,0) \
    X(K_PREP1,0) X(K_QKV,0) X(K_ATTN,0) X(K_WO,0) X(K_PREP2,0) PROBE_DUP(X, 0) X(K_FFN1,0) X(K_FIX,0) X(K_FFN2,0) \
    X(K_PREP1,1) X(K_POOLP,1) X(K_POOLG,1) X(K_PREP2,1) PROBE_DUP(X, 1) X(K_FFN1,1) X(K_FIX,1) X(K_FFN2,1) \
    X(K_PREP1,2) X(K_CHAN,2) X(K_SEQC,2) X(K_ST1,2) X(K_ST2,2) X(K_PREP2,2) PROBE_DUP(X, 2) X(K_FFN1,2) X(K_FIX,2) X(K_FFN2,2) \
    X(K_PREP1,3) X(K_QKV,3) X(K_ATTN,3) X(K_WO,3) X(K_PREP2,3) PROBE_DUP(X, 3) X(K_FFN1,3) X(K_FIX,3) X(K_FFN2,3)
#define PROG_K(k, l) k,
#define PROG_L(k, l) l,
__constant__ unsigned char PROG_KIND[] = { PROG_LIST(PROG_K) };
__constant__ unsigned char PROG_LAYER[] = { PROG_LIST(PROG_L) };
static const unsigned char H_PROG_KIND[] = { PROG_LIST(PROG_K) };
constexpr int NSTEP = (int)sizeof(H_PROG_KIND);

struct Args { const float* in[22]; float* out; unsigned char* ws; int s_lo, s_hi; };

__global__ void __launch_bounds__(512, 2) mega_fwd(Args a) {
    extern __shared__ __attribute__((aligned(16))) unsigned char lds_raw[];
    LAS unsigned char* lds = (LAS unsigned char*)lds_raw;
    LAS unsigned char* xl = lds + LDS_X;
    cg::grid_group grid = cg::this_grid();
    volatile LAS unsigned* bst = (volatile LAS unsigned*)(lds + LDS_MISC);
    unsigned* bar = (unsigned*)(a.ws + WS_CTL);
    if (threadIdx.x < 4) bst[threadIdx.x] = 0u;
    __syncthreads();
    const unsigned xcc = xb_xcc_id();
    if (threadIdx.x == 0) (void)xb_add(&bar[XB_XCNT(xcc)], 1u);
    const int G = gridDim.x, NGW = G * 8, GT = G * 512;
    unsigned char* ws = a.ws; float* out = a.out;
    float* mods = (float*)(ws + WS_MODS);
    float* ropec = (float*)(ws + WS_ROPE); float* ropes = ropec + 1024;
    bf16_t* Hb = (bf16_t*)(ws + WS_H);
    bf16_t* BIG = (bf16_t*)(ws + WS_BIG);
    bf16_t* Qb = (bf16_t*)(ws + WS_Q); bf16_t* Kbuf = (bf16_t*)(ws + WS_K); bf16_t* VTb = (bf16_t*)(ws + WS_VT);
    float* hal = (float*)(ws + WS_HAL);

    for (int s = a.s_lo; s < a.s_hi; ++s) {
        int tid = threadIdx.x, bx = blockIdx.x;
        asm volatile("" : "+v"(tid), "+s"(bx));
        const int lane = tid & 63, wave = __builtin_amdgcn_readfirstlane(tid >> 6);
        const int vcu = (G % 8 == 0) ? (bx % 8) * (G / 8) + bx / 8 : bx;
        const int gw = vcu * 8 + wave, gt = bx * 512 + tid;
        const int kind = PROG_KIND[s], layer = PROG_LAYER[s], jl = layer / 3;
        const float* xs0 = a.in[0]; const float* xs1 = a.in[1];
        bf16_t* XB = (bf16_t*)(ws + WS_XB); const bf16_t* xbin = (s <= 4) ? nullptr : XB;
        const float* lmods = mods + (size_t)layer * 9 * NMOD;
        switch (kind) {
#ifndef NO_PRO
        case K_PRO: {
            LAS float* scond = (LAS float*)lds; LAS float* part = (LAS float*)(lds + 40960);
            for (int i = tid; i < 9 * 1024; i += 512) { const int cnd = i >> 10, k = i & 1023; const float v = cnd == 0 ? a.in[5][k] : a.in[4][(cnd - 1) * 1024 + k];
                scond[((k & 1) * 9 + cnd) * 512 + (k >> 7) * 64 + ((k & 127) >> 1)] = v / (1.0f + __expf(-v)); }
            __syncthreads();
            for (int item = bx; item < 768; item += G) {
                const int ly = item / 192, cb = item % 192, col = lane & 31, hk = lane >> 5;
                const float* w = a.in[8] + (size_t)ly * 1024 * NMOD + cb * 32 + col + (size_t)(wave * 128 + hk) * NMOD;
                const LAS float* sc = scond + (hk * 9) * 512 + wave * 64;
                float ac[9];
#pragma unroll
                for (int c = 0; c < 9; ++c) ac[c] = 0.f;
#pragma unroll 4
                for (int kk = 0; kk < 64; kk += 4) {
                    const float w0 = w[(size_t)(2 * kk) * NMOD], w1 = w[(size_t)(2 * kk + 2) * NMOD], w2 = w[(size_t)(2 * kk + 4) * NMOD], w3 = w[(size_t)(2 * kk + 6) * NMOD];
#pragma unroll
                    for (int c = 0; c < 9; ++c) { const f32x4 s = *(const LAS f32x4*)(sc + c * 512 + kk); ac[c] += (w0 * s[0] + w1 * s[1]) + (w2 * s[2] + w3 * s[3]); }
                }
#pragma unroll
                for (int c = 0; c < 9; ++c) part[((wave * 2 + hk) * 9 + c) * 32 + col] = ac[c];
                __syncthreads();
                for (int i = tid; i < 288; i += 512) { const int c = i >> 5, l = i & 31; float sm = a.in[9][ly * NMOD + cb * 32 + l];
#pragma unroll
                    for (int p = 0; p < 16; ++p) sm += part[(p * 9 + c) * 32 + l];
                    mods[((size_t)ly * 9 + c) * NMOD + cb * 32 + l] = sm; }
                __syncthreads();
            }
            {
                LAS float* scr = (LAS float*)(lds + wave * 16384);
                constexpr int I_QKV = 16 * 48, I_WO = 16 * 32, I_POOL = 4 * 8, I_IN = 16 * 176, I_OUT = 44 * 32;
                constexpr int NIT = 2 * I_QKV + 2 * I_WO + 4 * I_POOL + 4 * I_IN + 4 * I_OUT;
                for (int it = gw; it < NIT; it += NGW) {
                    int r_ = it;
                    if (r_ < 4 * I_IN) { const int ly = r_ / I_IN; transpose_item(a.in[18] + (size_t)ly * DM * DFF2, DM, DFF2, (bf16_t*)(ws + WS_WIN) + (size_t)ly * DFF2 * DM, 2, scr, r_ % I_IN, lane); continue; } r_ -= 4 * I_IN;
                    if (r_ < 4 * I_OUT) { const int ly = r_ / I_OUT; transpose_item(a.in[21] + (size_t)ly * DFF * DM, DFF, DM, (bf16_t*)(ws + WS_WOUT) + (size_t)ly * DM * DFF, 0, scr, r_ % I_OUT, lane); continue; } r_ -= 4 * I_OUT;
                    if (r_ < 2 * I_QKV) { const int ly = r_ / I_QKV; transpose_item(a.in[10] + (size_t)ly * DM * NQKV, DM, NQKV, (bf16_t*)(ws + WS_WQKV) + (size_t)ly * NQKV * DM, 1, scr, r_ % I_QKV, lane); continue; } r_ -= 2 * I_QKV;
                    if (r_ < 2 * I_WO) { const int ly = r_ / I_WO; transpose_item(a.in[14] + (size_t)ly * DM * DM, DM, DM, (bf16_t*)(ws + WS_WO) + (size_t)ly * DM * DM, 0, scr, r_ % I_WO, lane); continue; } r_ -= 2 * I_WO;
                    { const int gp = r_ / I_POOL; transpose_item(a.in[15] + (size_t)gp * 65536, 256, 256, (bf16_t*)(ws + WS_WPOOL) + (size_t)gp * 65536, 0, scr, r_ % I_POOL, lane); }
                }
            }
            __syncthreads();
            LAS f32x2* TAB = (LAS f32x2*)lds;
            for (int k = tid; k < 4096; k += 512) { float sv, cv; sincospif((float)k * (1.0f / 2048.0f), &sv, &cv); TAB[k] = (f32x2){cv, sv}; }
            __syncthreads();
            { bf16_t* A1 = (bf16_t*)(ws + WS_A1);
                for (int it = gt; it < 32 * 256 * 32; it += GT) { const int p = it >> 13, j = (it >> 5) & 255, k0 = (it & 31) * 8, t1 = (j >> 1) & 63, bbl = j >> 7, ri = j & 1, part_ = (k0 >> 6) & 1, a0 = k0 & 63; float v[8];
#pragma unroll
                    for (int e = 0; e < 8; ++e) { const f32x2 cs = TAB[(t1 * (64 * (a0 + e) + 2 * p + bbl)) & 4095]; const float x = ri == 0 ? (part_ == 0 ? cs.x : -cs.y) : (part_ == 0 ? -cs.y : -cs.x); v[e] = ((k0 >> 7) == bbl) ? x * (1.0f / 64.0f) : 0.f; }
                    u32x4 o; o.x = cvtpk(v[0], v[1]); o.y = cvtpk(v[2], v[3]); o.z = cvtpk(v[4], v[5]); o.w = cvtpk(v[6], v[7]); *(u32x4*)(A1 + (size_t)it * 8) = o; }
                bf16_t* A2 = (bf16_t*)(ws + WS_A2);
                for (int it = gt; it < 256 * 64; it += GT) { const int r_ = it >> 6, k0 = (it & 63) * 8, t1l = r_ >> 6, t2 = r_ & 63; float v[8];
#pragma unroll
                    for (int e = 0; e < 8; ++e) { const int k = k0 + e, bb = k >> 3; const f32x2 cs = TAB[((t2 * bb) & 63) * 64]; v[e] = (((k >> 1) & 3) == t1l) ? ((k & 1) ? cs.y : cs.x) : 0.f; }
                    u32x4 o; o.x = cvtpk(v[0], v[1]); o.y = cvtpk(v[2], v[3]); o.z = cvtpk(v[4], v[5]); o.w = cvtpk(v[6], v[7]); *(u32x4*)(A2 + (size_t)it * 8) = o; }
                bf16_t* D2 = (bf16_t*)(ws + WS_DFT256);
                for (int it = gt; it < 256 * 64; it += GT) { const int t = it >> 6, j0 = (it & 63) * 8, part_ = j0 >= 256, jj = j0 & 255; float v[8];
#pragma unroll
                    for (int e = 0; e < 8; ++e) { const f32x2 cs = TAB[((t * (jj + e)) & 255) * 16]; v[e] = (part_ ? -cs.y : cs.x) * (1.0f / 16.0f); }
                    u32x4 o; o.x = cvtpk(v[0], v[1]); o.y = cvtpk(v[2], v[3]); o.z = cvtpk(v[4], v[5]); o.w = cvtpk(v[6], v[7]); *(u32x4*)(D2 + (size_t)t * 512 + j0) = o; }
            }
            { LAS float* wt = (LAS float*)(lds + 32768); bf16_t* WCS = (bf16_t*)(ws + WS_WCS);
                for (int item = bx; item < 256; item += G) {
                    const int gp = item >> 6, n0 = (item & 63) * 16;
                    for (int i = tid; i < 4096; i += 512) wt[i] = a.in[17][(size_t)(gp * 256 + (i >> 4)) * DM + n0 + (i & 15)];
                    __syncthreads();
                    const int nn = tid & 15, cg_ = tid >> 4;
                    float ac[8], as[8];
#pragma unroll
                    for (int e = 0; e < 8; ++e) { ac[e] = 0.f; as[e] = 0.f; }
                    for (int cp = 0; cp < 256; ++cp) { const float wv = wt[cp * 16 + nn];
#pragma unroll
                        for (int e = 0; e < 8; ++e) { const f32x2 cs = TAB[(((cg_ * 8 + e) * cp) & 255) * 16]; ac[e] += wv * cs.x; as[e] += wv * cs.y; } }
                    u32x4 o; o.x = cvtpk(ac[0] * 0.0625f, ac[1] * 0.0625f); o.y = cvtpk(ac[2] * 0.0625f, ac[3] * 0.0625f); o.z = cvtpk(ac[4] * 0.0625f, ac[5] * 0.0625f); o.w = cvtpk(ac[6] * 0.0625f, ac[7] * 0.0625f);
                    *(u32x4*)(WCS + (size_t)(n0 + nn) * DM + gp * 256 + cg_ * 8) = o;
                    o.x = cvtpk(as[0] * 0.0625f, as[1] * 0.0625f); o.y = cvtpk(as[2] * 0.0625f, as[3] * 0.0625f); o.z = cvtpk(as[4] * 0.0625f, as[5] * 0.0625f); o.w = cvtpk(as[6] * 0.0625f, as[7] * 0.0625f);
                    *(u32x4*)(WCS + (size_t)(1024 + n0 + nn) * DM + gp * 256 + cg_ * 8) = o;
                    __syncthreads();
                }
            }
            for (int i = gt; i < 1024; i += GT) { const int pos = i >> 4, f = i & 15; const float invf = 1.0f / powf(10000.0f, (float)f * (1.0f / 16.0f)); float sv, cv; sincosf((float)pos * invf, &sv, &cv); ropec[i] = cv; ropes[i] = sv; }
            { bf16_t* CKb = (bf16_t*)(ws + WS_CK); bf16_t* CVTb = (bf16_t*)(ws + WS_CVT);
                for (int it = gt; it < 262144; it += GT) { const f32x4 v0 = *(const f32x4*)(a.in[2] + (size_t)it * 8), v1 = *(const f32x4*)(a.in[2] + (size_t)it * 8 + 4);
                    u32x4 o; o.x = cvtpk(v0[0], v0[1]); o.y = cvtpk(v0[2], v0[3]); o.z = cvtpk(v1[0], v1[1]); o.w = cvtpk(v1[2], v1[3]); *(u32x4*)(CKb + (size_t)(it >> 5) * K_LD + (it & 31) * 8) = o; }
                for (int it = gt; it < 262144; it += GT) { const int d = it & 63, chunk = (it >> 6) & 63, kvh = (it >> 12) & 3, bj2 = it >> 14, g16 = chunk >> 1, hh = chunk & 1; float v[8];
#pragma unroll
                    for (int e = 0; e < 8; ++e) { const int pos = 16 * g16 + 4 * hh + (e & 3) + 8 * (e >> 2); v[e] = a.in[3][((size_t)(bj2 * 512 + pos) * 4 + kvh) * 64 + d]; }
                    u32x4 o; o.x = cvtpk(v[0], v[1]); o.y = cvtpk(v[2], v[3]); o.z = cvtpk(v[4], v[5]); o.w = cvtpk(v[6], v[7]); *(u32x4*)(CVTb + ((size_t)(bj2 * 4 + kvh) * 64 + d) * CVT_LD + chunk * 8) = o; }
            }
        } break;
#endif
        case K_PREP1: prep_phase(xs0, xs1, xbin, Hb, a.in[6] + layer * DM, lmods, 0, 1024, gw, NGW, lane); break;
        case K_PREP2: prep_phase(xs0, xs1, xbin, Hb, a.in[7] + layer * DM, lmods, 3072, 4096, gw, NGW, lane); break;
        case K_POOLP: pool_phase(Hb, BIG, gw, NGW, lane); break;
        case K_FIX: fix_phase(hal, BIG, a.in[19] + (size_t)layer * 3 * DFF2, a.in[20] + (size_t)layer * DFF2, gt, GT); break;
#ifndef NO_ATTN
        case K_ATTN: attn_phase(Qb, Kbuf, VTb, (const bf16_t*)(ws + WS_CK), (const bf16_t*)(ws + WS_CVT), a.in[13] + jl * 16, jl, vcu, G, wave, lane); break;
#endif
#ifndef NO_QKV
        case K_QKV: {
            pg8::Gemm g{(const char*)Hb, (const char*)(ws + WS_WQKV) + (size_t)jl * NQKV * DM * 2, DM, DM, DM, 160, 6, 160, 0, 0};
            pg8::Order S; S.init(160, 6, G, bx);
            pg8::EpiQKV E{Qb, Kbuf, VTb, out + OUT_CK + (size_t)jl * 65536, out + OUT_CV + (size_t)jl * 65536, a.in[11] + jl * 64, a.in[12] + jl * 64, ropec, ropes};
            pg8::gemm_phase<pg8::EpiQKV>(lds, xl, g, S, E, tid);
        } break;
#endif
#ifndef NO_CHAN
        case K_CHAN: {
            for (int v = 0; v < 2; ++v) {
                pg8::Gemm g{(const char*)(ws + WS_WCS), (const char*)(Hb + (size_t)(v ? NCTX : 0) * DM), DM, DM, DM, 8, v ? 128 : 32, 8, 0, 0};
                g.bperm = v;
                pg8::Order S; S.init(8, v ? 128 : 32, G, bx);
                pg8::EpiChan E{(bf16_t*)(ws + (v ? WS_PTL : WS_PTC)), v};
                pg8::gemm_phase<pg8::EpiChan>(lds, xl, g, S, E, tid);
            }
        } break;
#endif
        case K_ST1: {
            pg8::Gemm g{(const char*)(ws + WS_PTL), (const char*)(ws + WS_A1), 8192, 256, 256, 32, 32, 32, 512, 0};
            pg8::Order S; S.init(32, 32, G, bx);
            pg8::EpiY1 E{(bf16_t*)(ws + WS_YT)};
            pg8::gemm_phase<pg8::EpiY1>(lds, xl, g, S, E, tid);
        } break;
#ifndef NO_FFN1
        case K_FFN1: {
            pg8::Gemm g{(const char*)Hb, (const char*)(ws + WS_WIN) + (size_t)layer * DFF2 * DM * 2, DM, DM, DM, 160, 22, 160, 0, 0};
            pg8::Order S; S.init(160, 22, G, bx);
            pg8::EpiFfn1 E{BIG, hal, a.in[19] + (size_t)layer * 3 * DFF2, a.in[20] + (size_t)layer * DFF2};
            pg8::gemm_phase<pg8::EpiFfn1>(lds, xl, g, S, E, tid);
        } break;
#endif
#ifndef NO_RES
        default: {
            pg8::Gemm g; pg8::EpiRes E; E.src0 = xs0; E.src1 = xs1; E.xin = xbin; { const bool last_ = (kind == K_FFN2 && layer == 3); E.xout = last_ ? nullptr : XB; E.dst = last_ ? out : nullptr; } E.pscale = nullptr; E.pm0 = 0; E.rowmap = 0; E.gate = lmods + 2048;
            g.akoff = 0; g.bstride = 0;
            if (kind == K_WO) { g.A = (const char*)Qb; g.Bt = (const char*)(ws + WS_WO) + (size_t)jl * DM * DM * 2; g.lda = DM; g.ldb = DM; g.K = DM; g.nM = 160; g.nN = 4; g.amod = 160; }
            else if (kind == K_POOLG) { g.A = (const char*)BIG; g.Bt = (const char*)(ws + WS_WPOOL); g.lda = DM; g.ldb = 256; g.K = 256; g.nM = 160; g.nN = 4; g.amod = 160; g.akoff = 512; E.pscale = a.in[16]; }
            else if (kind == K_SEQC) { g.A = (const char*)(ws + WS_DFT256); g.Bt = (const char*)(ws + WS_PTC); g.lda = 512; g.ldb = 512; g.K = 512; g.nM = 32; g.nN = 4; g.amod = 1; g.bmod = 1; g.bstride = (size_t)256 * 2048 * 2; }
            else if (kind == K_ST2) { g.A = (const char*)(ws + WS_A2); g.Bt = (const char*)(ws + WS_YT); g.lda = 512; g.ldb = 8192; g.K = 512; g.nM = 128; g.nN = 4; g.amod = 1; g.bmod = 16; g.bstride = (size_t)1024 * 8192 * 2; g.bstride2 = 16; g.bkc = 256; E.rowmap = 1; }
            else { g.A = (const char*)BIG; g.Bt = (const char*)(ws + WS_WOUT) + (size_t)layer * DM * DFF * 2; g.lda = DFF; g.ldb = DFF; g.K = DFF; g.nM = 160; g.nN = 4; g.amod = 160; E.gate = lmods + 5120; }
            pg8::Order S; S.init(g.nM, g.nN, G, bx);
            const int nfull = (S.nwg / G) * G, rem = S.nwg - nfull;
            if (rem > 0 && 2 * rem <= G && (G & 1) == 0) {
                S.hi = nfull; if (nfull > 0) pg8::gemm_phase<pg8::EpiRes>(lds, xl, g, S, E, tid);
                S.lo = nfull; S.hi = S.nwg; S.G = G >> 1; S.c = bx >> 1;
                if (bx & 1) pg8::gemm_phase<pg8::EpiRes, 2>(lds, xl, g, S, E, tid); else pg8::gemm_phase<pg8::EpiRes, 1>(lds, xl, g, S, E, tid);
            } else pg8::gemm_phase<pg8::EpiRes>(lds, xl, g, S, E, tid);
        } break;
#endif
        }
        if (s + 1 < a.s_hi && kind != K_SEQC) { if (s == a.s_lo) grid.sync(); else xcd_barrier(bar, xcc, bst); }
    }
}

extern "C" void kernel_launch(void* const* d_in, const int* in_sizes, int n_in, void* d_out, int out_size, void* d_ws, size_t ws_size, hipStream_t stream) {
    static int grid = 0;
    if (grid == 0) {
        if (n_in != 22 || ws_size < WS_END) { fprintf(stderr, "kernel_launch: unexpected n_in %d or ws_size %zu (< %zu)\n", n_in, ws_size, (size_t)WS_END); grid = -1; return; }
        int dev = 0, cus = 0, per_cu = 0;
        hipGetDevice(&dev); hipDeviceGetAttribute(&cus, hipDeviceAttributeMultiprocessorCount, dev);
        if (hipFuncSetAttribute((const void*)mega_fwd, hipFuncAttributeMaxDynamicSharedMemorySize, LDS_BYTES) != hipSuccess) { fprintf(stderr, "kernel_launch: hipFuncSetAttribute failed\n"); grid = -1; return; }
        if (hipOccupancyMaxActiveBlocksPerMultiprocessor(&per_cu, (const void*)mega_fwd, 512, LDS_BYTES) != hipSuccess || per_cu < 1) { fprintf(stderr, "kernel_launch: occupancy query says %d\n", per_cu); per_cu = 1; }
        (void)hipGetLastError();
        grid = cus * 1;
    }
    if (grid < 0) return;
    if (hipMemsetAsync((char*)d_ws + WS_CTL, 0, CTL_BYTES, stream) != hipSuccess) { fprintf(stderr, "kernel_launch: memset failed\n"); return; }
    Args a{};
    for (int i = 0; i < 22; ++i) a.in[i] = (const float*)d_in[i];
    a.out = (float*)d_out; a.ws = (unsigned char*)d_ws;
#if MK_MULTI
    for (int s = 0; s < NSTEP;) {
        int e = s + 1; if (H_PROG_KIND[s] == K_SEQC) e = s + 2;
        a.s_lo = s; a.s_hi = e; void* args[] = {&a};
        hipError_t err = hipLaunchCooperativeKernel((const void*)mega_fwd, dim3(grid), dim3(512), args, LDS_BYTES, stream);
        if (err != hipSuccess) { fprintf(stderr, "kernel_launch: cooperative launch failed: %s\n", hipGetErrorString(err)); break; }
        s = e;
    }
#else
    a.s_lo = 0; a.s_hi = NSTEP; void* args[] = {&a};
    hipError_t err = hipLaunchCooperativeKernel((const void*)mega_fwd, dim3(grid), dim3(512), args, LDS_BYTES, stream);
    if (err != hipSuccess) fprintf(stderr, "kernel_launch: cooperative launch failed: %s (grid %d)\n", hipGetErrorString(err), grid);
#endif
}
```

```cpp
#include <hip/hip_runtime.h>
#include <hip/hip_cooperative_groups.h>
#include <cstdio>
#include <cstdint>
namespace cg = cooperative_groups;

#ifndef MK_MULTI
#define MK_MULTI 0
#endif

#define LAS __attribute__((address_space(3)))
typedef unsigned short bf16_t;
typedef short bf16x8 __attribute__((ext_vector_type(8)));
typedef float f32x2 __attribute__((ext_vector_type(2)));
typedef float f32x4 __attribute__((ext_vector_type(4)));
typedef float f32x16 __attribute__((ext_vector_type(16)));
typedef unsigned u32x2 __attribute__((ext_vector_type(2)));
typedef unsigned u32x4 __attribute__((ext_vector_type(4)));
typedef __bf16 bf16x2_t __attribute__((ext_vector_type(2)));

constexpr int DM = 1024, NCTX = 8192, NTOK = 40960, DFF = 2816, DFF2 = 5632, NQKV = 1536, NMOD = 6144;
constexpr float LOG2E = 1.4426950408889634f;
constexpr float QSCALE = 0.125f * LOG2E;

constexpr size_t MiB = 1u << 20;
constexpr size_t WS_MODS = 0;
constexpr size_t WS_ROPE = 1 * MiB;
constexpr size_t WS_DFT256 = 1 * MiB + 64 * 1024;
constexpr size_t WS_WQKV = 2 * MiB;
constexpr size_t WS_WO = 8 * MiB;
constexpr size_t WS_WPOOL = 12 * MiB;
constexpr size_t WS_WCS = 13 * MiB;
constexpr size_t WS_WIN = 17 * MiB;
constexpr size_t WS_WOUT = 61 * MiB;
constexpr size_t WS_CK = 83 * MiB;
constexpr size_t WS_CVT = 488 * MiB;
constexpr int K_LD = 272;
constexpr int VT_LDC = 288, VT_LDL = 4160, CVT_LD = 544;
constexpr size_t VT_CTX_SEQ = (size_t)256 * VT_LDC, VT_LAT_BASE = 32 * VT_CTX_SEQ, VT_LAT_SEQ = (size_t)256 * VT_LDL;
constexpr size_t WS_HAL = 88 * MiB;
constexpr size_t WS_A1 = 102 * MiB;
constexpr size_t WS_A2 = 106 * MiB;
constexpr size_t WS_XB = 107 * MiB;
constexpr size_t WS_YT = 187 * MiB;
constexpr size_t WS_H = 187 * MiB;
constexpr size_t WS_BIG = 267 * MiB;
constexpr size_t WS_PTC = WS_BIG + 60 * MiB, WS_PTL = WS_BIG + 92 * MiB;
constexpr size_t WS_Q = WS_BIG, WS_K = WS_BIG + 80 * MiB, WS_VT = WS_BIG + 104 * MiB;
constexpr size_t WS_CTL = 487 * MiB;
constexpr size_t CTL_BYTES = 64 * 1024;
constexpr size_t WS_END = 494 * MiB;

constexpr size_t OUT_CK = (size_t)NTOK * DM;
constexpr size_t OUT_CV = OUT_CK + (size_t)32 * 2 * 256 * 256;

constexpr int LDS_RING = 131072, LDS_X = 131072, LDS_MISC = 131072 + 8192, LDS_BYTES = 147456;

__device__ __forceinline__ unsigned cvtpk(float lo, float hi) { f32x2 v = {lo, hi}; bf16x2_t b = __builtin_convertvector(v, bf16x2_t); return __builtin_bit_cast(unsigned, b); }
__device__ __forceinline__ bf16_t f2bf(float f) { return (bf16_t)(cvtpk(f, 0.f) & 0xffffu); }
__device__ __forceinline__ float bf2f(unsigned v) { return __uint_as_float(v << 16); }
__device__ __forceinline__ float dpp_prev(float v) { return __int_as_float(__builtin_amdgcn_update_dpp(0, __float_as_int(v), 0x121, 0xf, 0xf, false)); }
__device__ __forceinline__ float dpp_next(float v) { return __int_as_float(__builtin_amdgcn_update_dpp(0, __float_as_int(v), 0x12F, 0xf, 0xf, false)); }
__device__ __forceinline__ f32x4 dpp_prev4(f32x4 v) { return (f32x4){dpp_prev(v[0]), dpp_prev(v[1]), dpp_prev(v[2]), dpp_prev(v[3])}; }
__device__ __forceinline__ f32x4 dpp_next4(f32x4 v) { return (f32x4){dpp_next(v[0]), dpp_next(v[1]), dpp_next(v[2]), dpp_next(v[3])}; }
__device__ __forceinline__ float silu_mul(float g, float v) { const float e = __builtin_amdgcn_exp2f(-g * LOG2E); return g * __builtin_amdgcn_rcpf(1.0f + e) * v; }
__device__ __forceinline__ int cond_of_row(int row) { return row < NCTX ? 0 : 1 + ((row - NCTX) >> 12); }

namespace pg8 {
constexpr int BM = 256, BK = 64, HALF = 128, HTB = HALF * BK * 2, NXCD = 8, WGM = 8;
__device__ __forceinline__ int lds_byte(int r, int c) { const int st = (r >> 4) * 2 + (c >> 5), rr = r & 15, cc = c & 31, ob = rr * 64 + cc * 2; return st * 1024 + (ob ^ (((ob >> 9) & 1) << 5)); }
__device__ __forceinline__ void stage_rc(int b, int& R, int& C) { const int st = b / 1024, sb = b % 1024, swz = sb ^ (((sb >> 9) & 1) << 5); R = (st >> 1) * 16 + swz / 64; C = (st & 1) * 32 + (swz % 64) / 2; }
__device__ __forceinline__ int perm32(int rho) { const int n = rho >> 4, i = rho & 15; return 8 * (i >> 2) + 4 * n + (i & 3); }

struct Unit { int pm, pn, half; };
struct Gemm { const char* A; const char* Bt; int lda, ldb, K, nM, nN, amod, akoff; size_t bstride; int bmod = 1 << 30; size_t bstride2 = 0; int bperm = 0; int bkc = 16; };
__device__ __forceinline__ const char* aptr(const Gemm& g, const Unit& u) { return g.A + (size_t)(u.pm % g.amod) * (size_t)512 * g.lda + (size_t)u.pn * g.akoff; }
__device__ __forceinline__ const char* bptr(const Gemm& g, const Unit& u) {
    if (g.bperm) return g.Bt + (size_t)((u.pn >> 4) * 4096 + 4 * (u.pn & 15)) * (size_t)2 * g.ldb;
    return g.Bt + (size_t)(u.pm / g.bmod) * g.bstride + (size_t)(u.pm % g.bmod) * g.bstride2 + (size_t)u.pn * (size_t)512 * g.ldb; }

struct Order {
    int nM, nN, nwg, G, c, lo, hi;
    __device__ __forceinline__ void init(int nM_, int nN_, int G_, int c_) { nM = nM_; nN = nN_; nwg = nM * nN; G = G_; c = c_; lo = 0; hi = nwg; }
    __device__ __forceinline__ bool next(int i, Unit& u) const {
        const long L = (long)lo + (long)i * G + c; if (L >= hi) return false;
        int wgid = (int)L; u.half = 0; { const int q = nwg / NXCD, r = nwg % NXCD, xcd = wgid % NXCD, off = wgid / NXCD; wgid = (xcd < r ? xcd * (q + 1) : r * (q + 1) + (xcd - r) * q) + off; }
        const int nig = WGM * nN, gid = wgid / nig, fm = gid * WGM, gsz = (nM - fm) < WGM ? (nM - fm) : WGM;
        u.pm = fm + ((wgid % nig) % gsz); u.pn = (wgid % nig) / gsz; return true;
    }
};


struct EpiRes {
    static constexpr bool PERM = true;
    const float* src0; const float* src1;
    const bf16_t* xin; bf16_t* xout;
    float* dst;
    const float* gate; const float* pscale; int pm0; int rowmap;
    __device__ __forceinline__ void operator()(f32x4 (&acc)[2][2][4][2], const Unit& u, int wr, int wc, int fr, int fq, LAS unsigned char*) const {
        asm volatile("" : "+v"(fr), "+v"(fq), "+s"(wr), "+s"(wc));
        const int rowt = rowmap ? NCTX + (u.pm >> 4) * 4096 + 4 * (u.pm & 15) : (pm0 + u.pm) * BM; const float* g = gate + (size_t)cond_of_row(rowt) * NMOD;
        const int col0 = u.pn * BM + wc * 32 + 8 * fq;
        f32x4 gv[2][2];
#pragma unroll
        for (int bj = 0; bj < 2; ++bj)
#pragma unroll
            for (int n = 0; n < 2; ++n) { gv[bj][n] = *(const f32x4*)(g + col0 + bj * HALF + n * 4); if (pscale) gv[bj][n] = gv[bj][n] * *(const f32x4*)(pscale + col0 + bj * HALF + n * 4); }
#pragma unroll
        for (int ai = 0; ai < 2; ++ai) { if (u.half == 2 - ai) continue;
#pragma unroll
            for (int m = 0; m < 4; ++m) {
                const int row = rowmap ? rowt + 2 * ai + wr + 64 * (16 * m + fr) : rowt + ai * HALF + wr * 64 + m * 16 + fr;
#pragma unroll
                for (int bj = 0; bj < 2; ++bj) {
                    f32x4 x0, x1;
                    if (xin) { const u32x4 w = *(const u32x4*)(xin + (size_t)row * DM + col0 + bj * HALF);
                        x0 = (f32x4){bf2f(w.x & 0xffffu), bf2f(w.x >> 16), bf2f(w.y & 0xffffu), bf2f(w.y >> 16)}; x1 = (f32x4){bf2f(w.z & 0xffffu), bf2f(w.z >> 16), bf2f(w.w & 0xffffu), bf2f(w.w >> 16)}; }
                    else { const float* s = (row < NCTX ? src0 + (size_t)row * DM : src1 + (size_t)(row - NCTX) * DM) + col0 + bj * HALF; x0 = *(const f32x4*)s; x1 = *(const f32x4*)(s + 4); }
                    x0 = x0 + gv[bj][0] * acc[ai][bj][m][0]; x1 = x1 + gv[bj][1] * acc[ai][bj][m][1];
                    if (xout) { u32x4 w; w.x = cvtpk(x0[0], x0[1]); w.y = cvtpk(x0[2], x0[3]); w.z = cvtpk(x1[0], x1[1]); w.w = cvtpk(x1[2], x1[3]); *(u32x4*)(xout + (size_t)row * DM + col0 + bj * HALF) = w; }
                    if (dst) { float* d = dst + (size_t)row * DM + col0 + bj * HALF; *(f32x4*)d = x0; *(f32x4*)(d + 4) = x1; }
                }
            } }
    }
};

struct EpiQKV {
    static constexpr bool PERM = false;
    bf16_t* Q; bf16_t* Kb; bf16_t* VT; float* ock; float* ocv; const float* qn; const float* kn; const float* ropec; const float* ropes;
    __device__ __forceinline__ void operator()(f32x4 (&acc)[2][2][4][2], const Unit& u, int wr, int wc, int fr, int fq, LAS unsigned char*) const {
        asm volatile("" : "+v"(fr), "+v"(fq), "+s"(wr), "+s"(wc));

        const int rowt = u.pm * BM; const bool lat = rowt >= NCTX; const int dl = 4 * fq;
        if (u.pn < 5) {
            const bool isq = u.pn < 4; const float* nw = isq ? qn : kn;
            f32x4 nwv[2][2];
#pragma unroll
            for (int bj = 0; bj < 2; ++bj)
#pragma unroll
                for (int n = 0; n < 2; ++n) nwv[bj][n] = *(const f32x4*)(nw + 32 * bj + 16 * n + dl);
#pragma unroll
            for (int ai = 0; ai < 2; ++ai)
#pragma unroll
                for (int m = 0; m < 4; ++m) {
                    const int row = rowt + ai * HALF + wr * 64 + m * 16 + fr;
                    float ss = 0.f;
#pragma unroll
                    for (int bj = 0; bj < 2; ++bj)
#pragma unroll
                        for (int n = 0; n < 2; ++n) { const f32x4 v = acc[ai][bj][m][n]; ss += (v[0] * v[0] + v[1] * v[1]) + (v[2] * v[2] + v[3] * v[3]); }
                    ss += __shfl_xor(ss, 16); ss += __shfl_xor(ss, 32);
                    const float rstd = 1.0f / sqrtf(ss * (1.0f / 64.0f) + 1e-6f);
                    f32x4 y[2][2];
#pragma unroll
                    for (int bj = 0; bj < 2; ++bj)
#pragma unroll
                        for (int n = 0; n < 2; ++n) y[bj][n] = acc[ai][bj][m][n] * rstd * nwv[bj][n];
                    if (!isq && !lat) {
                        float* p = ock + (size_t)(row >> 8) * 131072 + (size_t)(row & 255) * 256 + wc * 64 + dl;
#pragma unroll
                        for (int bj = 0; bj < 2; ++bj)
#pragma unroll
                            for (int n = 0; n < 2; ++n) *(f32x4*)(p + 32 * bj + 16 * n) = y[bj][n];
                    }
                    if (lat) {
                        const int lr = row - NCTX, pr = (lr & 4095) >> 6, pc = lr & 63;
#pragma unroll
                        for (int bj = 0; bj < 2; ++bj) {
                            const int pos = bj ? pc : pr;
                            const f32x4 c4 = *(const f32x4*)(ropec + pos * 16 + dl), s4 = *(const f32x4*)(ropes + pos * 16 + dl);
                            const f32x4 x1 = y[bj][0], x2 = y[bj][1];
                            y[bj][0] = x1 * c4 - x2 * s4; y[bj][1] = x1 * s4 + x2 * c4;
                        }
                    }
                    bf16_t* dstp;
                    if (isq) { dstp = Q + (size_t)row * DM + (4 * u.pn + wc) * 64 + dl;
#pragma unroll
                        for (int bj = 0; bj < 2; ++bj)
#pragma unroll
                            for (int n = 0; n < 2; ++n) y[bj][n] = y[bj][n] * QSCALE;
                    } else dstp = Kb + (size_t)row * K_LD + wc * 64 + dl;
#pragma unroll
                    for (int bj = 0; bj < 2; ++bj)
#pragma unroll
                        for (int n = 0; n < 2; ++n) { u32x2 w; w.x = cvtpk(y[bj][n][0], y[bj][n][1]); w.y = cvtpk(y[bj][n][2], y[bj][n][3]); *(u32x2*)(dstp + 32 * bj + 16 * n) = w; }
                }
        } else {
#pragma unroll
            for (int ai = 0; ai < 2; ++ai)
#pragma unroll
                for (int m = 0; m < 4; ++m) {
                    const int row = rowt + ai * HALF + wr * 64 + m * 16 + fr;
                    if (!lat) {
                        float* p = ocv + (size_t)(row >> 8) * 131072 + (size_t)(row & 255) * 256 + wc * 64 + dl;
#pragma unroll
                        for (int bj = 0; bj < 2; ++bj)
#pragma unroll
                            for (int n = 0; n < 2; ++n) *(f32x4*)(p + 32 * bj + 16 * n) = acc[ai][bj][m][n];
                    }
                    size_t sb; int pos, L;
                    if (lat) { const int lr = row - NCTX; sb = VT_LAT_BASE + (size_t)(lr >> 12) * VT_LAT_SEQ; pos = lr & 4095; L = VT_LDL; } else { sb = (size_t)(row >> 8) * VT_CTX_SEQ; pos = row & 255; L = VT_LDC; }
                    const int k16 = pos & 15, pp = (pos & ~15) + 8 * ((k16 >> 2) & 1) + (k16 & 3) + 4 * (k16 >> 3);
                    bf16_t* base = VT + sb + (size_t)(wc * 64 + dl) * L + pp;
#pragma unroll
                    for (int bj = 0; bj < 2; ++bj)
#pragma unroll
                        for (int n = 0; n < 2; ++n)
#pragma unroll
                            for (int e = 0; e < 4; ++e) base[(size_t)(32 * bj + 16 * n + e) * L] = f2bf(acc[ai][bj][m][n][e]);
                }
        }
    }
};

struct EpiChan {
    static constexpr bool PERM = true;
    bf16_t* PT; int lat;
    __device__ __forceinline__ void operator()(f32x4 (&acc)[2][2][4][2], const Unit& u, int wr, int wc, int fr, int fq, LAS unsigned char*) const {
        asm volatile("" : "+v"(fr), "+v"(fq), "+s"(wr), "+s"(wc));
#pragma unroll
        for (int ai = 0; ai < 2; ++ai)
#pragma unroll
            for (int m = 0; m < 4; ++m) {
                const int row = u.pm * BM + ai * HALF + wr * 64 + m * 16 + fr, part = row >> 10, n_ = row & 1023;
#pragma unroll
                for (int bj = 0; bj < 2; ++bj) {
                    bf16_t* d;
                    if (lat) d = PT + (size_t)(u.pn >> 4) * (1024 * 8192) + (size_t)n_ * 8192 + (4 * (u.pn & 15) + 2 * bj + (wc >> 1)) * 128 + part * 64 + (wc & 1) * 32 + 8 * fq;
                    else d = PT + (size_t)u.pn * (256 * 2048) + (size_t)n_ * 512 + part * 256 + bj * HALF + wc * 32 + 8 * fq;
                    const f32x4 v0 = acc[ai][bj][m][0], v1 = acc[ai][bj][m][1]; u32x4 w; w.x = cvtpk(v0[0], v0[1]); w.y = cvtpk(v0[2], v0[3]); w.z = cvtpk(v1[0], v1[1]); w.w = cvtpk(v1[2], v1[3]); *(u32x4*)d = w; }
            }
    }
};

struct EpiY1 {
    static constexpr bool PERM = true;
    bf16_t* YT;
    __device__ __forceinline__ void operator()(f32x4 (&acc)[2][2][4][2], const Unit& u, int wr, int wc, int fr, int fq, LAS unsigned char*) const {
        asm volatile("" : "+v"(fr), "+v"(fq), "+s"(wr), "+s"(wc));
#pragma unroll
        for (int ai = 0; ai < 2; ++ai)
#pragma unroll
            for (int m = 0; m < 4; ++m) {
                bf16_t* d = YT + (size_t)(u.pm * BM + ai * HALF + wr * 64 + m * 16 + fr) * 8192 + u.pn * BM + wc * 32 + 8 * fq;
#pragma unroll
                for (int bj = 0; bj < 2; ++bj) { const f32x4 v0 = acc[ai][bj][m][0], v1 = acc[ai][bj][m][1]; u32x4 w; w.x = cvtpk(v0[0], v0[1]); w.y = cvtpk(v0[2], v0[3]); w.z = cvtpk(v1[0], v1[1]); w.w = cvtpk(v1[2], v1[3]); *(u32x4*)(d + bj * HALF) = w; }
            }
    }
};

struct EpiFfn1 {
    static constexpr bool PERM = true;
    bf16_t* Aout; float* hal; const float* cw; const float* cb;
    __device__ __forceinline__ void operator()(f32x4 (&acc)[2][2][4][2], const Unit& u, int wr, int wc, int fr, int fq, LAS unsigned char* xl) const {
        asm volatile("" : "+v"(fr), "+v"(fq), "+s"(wr), "+s"(wc));

        LAS float* X = (LAS float*)xl;
        const int chl = wc * 32 + 8 * fq;
        LAS float* WL = (LAS float*)(xl + 9216);
        { const int t2 = (wr * 4 + wc) * 64 + fq * 16 + fr;
#pragma unroll
            for (int q = 0; q < 2; ++q) { const int idx = t2 + 512 * q, k = idx >> 8, c = idx & 255, col = (c >> 7) * DFF + u.pn * 128 + (c & 127); WL[idx] = (k < 3) ? cw[(size_t)k * DFF2 + col] : cb[col]; } }
#pragma unroll
        for (int ai = 0; ai < 2; ++ai) { const int blk = 2 * ai + wr;
            if (fr == 0) {
#pragma unroll
                for (int bj = 0; bj < 2; ++bj)
#pragma unroll
                    for (int n = 0; n < 2; ++n) *(LAS f32x4*)(X + ((blk * 2 + 0) * 2 + bj) * 128 + chl + 4 * n) = acc[ai][bj][0][n]; }
            if (fr == 15) {
#pragma unroll
                for (int bj = 0; bj < 2; ++bj)
#pragma unroll
                    for (int n = 0; n < 2; ++n) *(LAS f32x4*)(X + ((blk * 2 + 1) * 2 + bj) * 128 + chl + 4 * n) = acc[ai][bj][3][n]; }
        }
        { float* hp = hal + (size_t)u.pm * 4 * DFF2 + u.pn * 128 + chl;
            if (wr == 0 && fr < 2) {
#pragma unroll
                for (int bj = 0; bj < 2; ++bj)
#pragma unroll
                    for (int n = 0; n < 2; ++n) *(f32x4*)(hp + (size_t)fr * DFF2 + bj * DFF + 4 * n) = acc[0][bj][0][n]; }
            if (wr == 1 && fr >= 14) {
#pragma unroll
                for (int bj = 0; bj < 2; ++bj)
#pragma unroll
                    for (int n = 0; n < 2; ++n) *(f32x4*)(hp + (size_t)(fr - 12) * DFF2 + bj * DFF + 4 * n) = acc[1][bj][3][n]; }
        }
        asm volatile("s_waitcnt lgkmcnt(0)" ::: "memory"); __builtin_amdgcn_s_barrier(); asm volatile("" ::: "memory");
        const f32x4 z4 = {0.f, 0.f, 0.f, 0.f};
#pragma unroll
        for (int n = 0; n < 2; ++n) {
            const LAS float* wl = WL + chl + 4 * n;
#define CW_(k, bj) (*(const LAS f32x4*)(wl + (k) * 256 + (bj) * 128))
#pragma unroll
            for (int ai = 0; ai < 2; ++ai) { const int blk = 2 * ai + wr;
                f32x4 top[2], bot[2];
#pragma unroll
                for (int bj = 0; bj < 2; ++bj) {
                    top[bj] = blk > 0 ? *(LAS f32x4*)(X + (((blk - 1) * 2 + 1) * 2 + bj) * 128 + chl + 4 * n) : z4;
                    bot[bj] = blk < 3 ? *(LAS f32x4*)(X + (((blk + 1) * 2 + 0) * 2 + bj) * 128 + chl + 4 * n) : z4; }
#pragma unroll
                for (int m = 0; m < 4; ++m) {
                    f32x4 cv[2];
#pragma unroll
                    for (int bj = 0; bj < 2; ++bj) {
                        const f32x4 cur = acc[ai][bj][m][n];
                        f32x4 pr = dpp_prev4(cur), nx = dpp_next4(cur);
                        const f32x4 pe = (m > 0) ? dpp_prev4(acc[ai][bj][m > 0 ? m - 1 : 0][n]) : top[bj];
                        const f32x4 ne = (m < 3) ? dpp_next4(acc[ai][bj][m < 3 ? m + 1 : 3][n]) : bot[bj];
                        if (fr == 0) pr = pe;
                        if (fr == 15) nx = ne;
                        cv[bj] = CW_(0, bj) * pr + CW_(1, bj) * cur + CW_(2, bj) * nx + CW_(3, bj);
                    }
                    u32x2 w; w.x = cvtpk(silu_mul(cv[0][0], cv[1][0]), silu_mul(cv[0][1], cv[1][1])); w.y = cvtpk(silu_mul(cv[0][2], cv[1][2]), silu_mul(cv[0][3], cv[1][3]));
                    *(u32x2*)(Aout + (size_t)(u.pm * BM + ai * HALF + wr * 64 + m * 16 + fr) * DFF + u.pn * 128 + chl + 4 * n) = w;
                }
            }
        }
    }
};

template <class Epi, int HM = 0>
__device__ __forceinline__ void gemm_phase(LAS unsigned char* lds, LAS unsigned char* xl, const Gemm g, const Order& S, const Epi& E, const int tid) {
    const int wid = __builtin_amdgcn_readfirstlane(tid >> 6), lane = tid & 63, wr = wid >> 2, wc = wid & 3, fr = lane & 15, fq = lane >> 4;
    const int nt = g.K / BK;
    unsigned voffA[2], voffB[2];
#pragma unroll
    for (int i = 0; i < 2; ++i) { int R, C; stage_rc(tid * 16 + i * 8192, R, C); const int Rb = Epi::PERM ? ((R & ~31) + perm32(R & 31)) : R;
        const int Rt = g.bperm ? 64 * (Rb & 63) + (Rb >> 6) : Rb;
        voffA[i] = (unsigned)(R * g.lda + C) * 2u; voffB[i] = (unsigned)(Rt * g.ldb) * 2u + (unsigned)((C >> 3) * g.bkc); }
    const size_t kstep = (size_t)(BK * 2), kstepB = (size_t)(8 * g.bkc);
    const size_t hA = (size_t)HALF * g.lda * 2, hB = g.bperm ? (size_t)4 * g.ldb : (size_t)HALF * g.ldb * 2;
    const unsigned ldsw = (unsigned)wid * 1024u;
    const int aoff = lds_byte(wr * 64 + fr, fq * 8), boff = lds_byte(wc * 32 + fr, fq * 8);
#define PG8_SA(b, h) (((b) * 2 + (h)) * HTB)
#define PG8_SB(b, h) ((4 + (b) * 2 + (h)) * HTB)
#define PG8_STAGE(bufoff, gbase, voff) do { _Pragma("unroll") for (int _i = 0; _i < 2; ++_i) \
        __builtin_amdgcn_global_load_lds((const unsigned*)((const char*)(gbase) + (voff)[_i]), (LAS unsigned*)(lds + (bufoff) + ldsw + _i * 8192), 16, 0, 0); } while (0)
#define PG8_LDA(dst, b, h) do { _Pragma("unroll") for (int m = 0; m < 4; ++m) _Pragma("unroll") for (int k = 0; k < 2; ++k) dst[m][k] = *(const LAS bf16x8*)(lds + PG8_SA(b, h) + aoff + m * 2048 + k * 1024); } while (0)
#define PG8_LDB(dst, b, h) do { _Pragma("unroll") for (int n = 0; n < 2; ++n) _Pragma("unroll") for (int k = 0; k < 2; ++k) dst[n][k] = *(const LAS bf16x8*)(lds + PG8_SB(b, h) + boff + n * 2048 + k * 1024); } while (0)
#define PG8_MMA(ai, bj, At, Bt) do { __builtin_amdgcn_s_setprio(1); _Pragma("unroll") for (int m = 0; m < 4; ++m) _Pragma("unroll") for (int n = 0; n < 2; ++n) _Pragma("unroll") for (int k = 0; k < 2; ++k) \
        acc[ai][bj][m][n] = __builtin_amdgcn_mfma_f32_16x16x32_bf16(Bt[n][k], At[m][k], acc[ai][bj][m][n], 0, 0, 0); __builtin_amdgcn_s_setprio(0); } while (0)
#define PG8_WAIT_V(n) asm volatile("s_waitcnt vmcnt(" #n ")" ::: "memory")
#define PG8_WAIT_L(n) asm volatile("s_waitcnt lgkmcnt(" #n ")" ::: "memory")
#define PG8_BAR __builtin_amdgcn_s_barrier()
#define PG8_SCHED __builtin_amdgcn_sched_barrier(0)
    Unit cur, nxt; int ui = 0;
    if (!S.next(0, cur)) return;
    f32x4 acc[2][2][4][2];
#pragma unroll
    for (int a = 0; a < 2; ++a)
#pragma unroll
        for (int b = 0; b < 2; ++b)
#pragma unroll
            for (int m = 0; m < 4; ++m)
#pragma unroll
                for (int n = 0; n < 2; ++n) acc[a][b][m][n] = (f32x4){0.f, 0.f, 0.f, 0.f};
    bf16x8 At[4][2], B0[2][2], B1[2][2];
    const char* cA = aptr(g, cur); const char* cB = bptr(g, cur);
    PG8_STAGE(PG8_SB(0, 0), cB, voffB); PG8_STAGE(PG8_SB(0, 1), cB + hB, voffB); PG8_STAGE(PG8_SA(0, 0), cA, voffA); PG8_STAGE(PG8_SA(0, 1), cA + hA, voffA);
    if (wr == 1) PG8_BAR;
    PG8_WAIT_V(2); PG8_BAR;
    PG8_STAGE(PG8_SB(1, 0), cB + kstepB, voffB); PG8_STAGE(PG8_SA(1, 0), cA + kstep, voffA); PG8_STAGE(PG8_SB(1, 1), cB + hB + kstepB, voffB);
    PG8_WAIT_V(6); PG8_BAR;
    for (;;) {
        const bool has_next = S.next(ui + 1, nxt);
        const char* nA = has_next ? aptr(g, nxt) : cA; const char* nB = has_next ? bptr(g, nxt) : cB;
        for (int t = 0; t < nt; t += 2) {
            const bool last = (t == nt - 2);
            const char* a1 = cA + (size_t)(t + 1) * kstep;
            const char* a2 = last ? nA : cA + (size_t)(t + 2) * kstep; const char* b2 = last ? nB : cB + (size_t)(t + 2) * kstepB;
            const char* a3 = a2 + kstep; const char* b3 = b2 + kstepB;
            PG8_LDB(B0, 0, 0); PG8_LDB(B1, 0, 1); PG8_SCHED; PG8_LDA(At, 0, 0); PG8_STAGE(PG8_SA(1, 1), a1 + hA, voffA);
            PG8_WAIT_V(8); PG8_WAIT_L(0); PG8_BAR; if constexpr (HM != 2) { PG8_MMA(0, 0, At, B0); PG8_MMA(0, 1, At, B1); } PG8_BAR; PG8_SCHED;
            PG8_LDA(At, 0, 1); PG8_STAGE(PG8_SB(0, 0), b2, voffB); PG8_STAGE(PG8_SB(0, 1), b2 + hB, voffB); PG8_STAGE(PG8_SA(0, 0), a2, voffA);
            PG8_WAIT_V(8); PG8_WAIT_L(0); PG8_BAR; if constexpr (HM != 1) { PG8_MMA(1, 0, At, B0); PG8_MMA(1, 1, At, B1); } PG8_BAR; PG8_SCHED;
            PG8_LDB(B0, 1, 0); PG8_LDB(B1, 1, 1); PG8_SCHED; PG8_LDA(At, 1, 0); PG8_STAGE(PG8_SA(0, 1), a2 + hA, voffA);
            PG8_WAIT_V(8); PG8_WAIT_L(0); PG8_BAR; if constexpr (HM != 2) { PG8_MMA(0, 0, At, B0); PG8_MMA(0, 1, At, B1); } PG8_BAR; PG8_SCHED;
            PG8_LDA(At, 1, 1); PG8_STAGE(PG8_SB(1, 0), b3, voffB); PG8_STAGE(PG8_SB(1, 1), b3 + hB, voffB); PG8_STAGE(PG8_SA(1, 0), a3, voffA);
            PG8_WAIT_V(8); PG8_WAIT_L(0); PG8_BAR; if constexpr (HM != 1) { PG8_MMA(1, 0, At, B0); PG8_MMA(1, 1, At, B1); } PG8_BAR; PG8_SCHED;
        }
        if (wr == 0) PG8_BAR;
        cur.half = HM; E(acc, cur, wr, wc, fr, fq, xl);
        if (!has_next) break;
#pragma unroll
        for (int a = 0; a < 2; ++a)
#pragma unroll
            for (int b = 0; b < 2; ++b)
#pragma unroll
                for (int m = 0; m < 4; ++m)
#pragma unroll
                    for (int n = 0; n < 2; ++n) acc[a][b][m][n] = (f32x4){0.f, 0.f, 0.f, 0.f};
        cur = nxt; cA = nA; cB = nB; ++ui;
        if (wr == 1) PG8_BAR;
    }
    PG8_WAIT_V(0);
    PG8_BAR;
#undef PG8_SA
#undef PG8_SB
#undef PG8_STAGE
#undef PG8_LDA
#undef PG8_LDB
#undef PG8_MMA
#undef PG8_WAIT_V
#undef PG8_WAIT_L
#undef PG8_BAR
#undef PG8_SCHED
}
}


#define XB_TMO      128
#define XB_XCNT(j)  (256  + 64 * (j))
#define XB_XSUB(j)  (1280 + 64 * (j))
#define XB_XGEN(j)  (2304 + 64 * (j))
#define XB_TOP      3328
#define XB_TOPGEN   3392
#define XCD_BAR_WORDS 3456
#define XB_SPIN_CAP (1u << 18)
__device__ __forceinline__ unsigned xb_ld(unsigned* p)              { return __hip_atomic_load(p, __ATOMIC_RELAXED, __HIP_MEMORY_SCOPE_AGENT); }
__device__ __forceinline__ unsigned xb_add(unsigned* p, unsigned v) { return __hip_atomic_fetch_add(p, v, __ATOMIC_RELAXED, __HIP_MEMORY_SCOPE_AGENT); }
__device__ __forceinline__ unsigned xb_xcc_id() { return (unsigned)__builtin_amdgcn_s_getreg((3 << 11) | 20) & 0xFu; }
#define XB_SPIN(cond, bar) do { unsigned _sp = 0; while (cond) { __builtin_amdgcn_s_sleep(1); \
    if ((++_sp & 255u) == 0u) { if (xb_ld(&(bar)[XB_TMO])) break; if (_sp > XB_SPIN_CAP) { atomicAdd(&(bar)[XB_TMO], 1u); break; } } } } while (0)
__device__ __forceinline__ void xcd_barrier_complete(unsigned* bar, unsigned x, unsigned& nloc, unsigned& nx) {
    const unsigned G = gridDim.x * gridDim.y * gridDim.z;
    unsigned sum, cnt, mine, sp = 0u;
    for (;;) {
        sum = 0u; cnt = 0u; mine = 0u;
#pragma unroll
        for (unsigned j = 0; j < 16; ++j) { const unsigned c = xb_ld(&bar[XB_XCNT(j)]); sum += c; cnt += (c > 0u) ? 1u : 0u; mine = (j == x) ? c : mine; }
        if (sum == G) break;
        __builtin_amdgcn_s_sleep(1);
        if ((++sp & 255u) == 0u) { if (xb_ld(&bar[XB_TMO])) break; if (sp > XB_SPIN_CAP) { atomicAdd(&bar[XB_TMO], 1u); break; } }
    }
    nloc = mine > 0u ? mine : 1u; nx = cnt > 0u ? cnt : 1u;
}
__device__ __forceinline__ void xcd_barrier(unsigned* bar, unsigned x, volatile LAS unsigned* st) {
    asm volatile("s_waitcnt vmcnt(0)" ::: "memory");
    __syncthreads();
    if (threadIdx.x == 0) {
        __builtin_amdgcn_s_waitcnt(0);
        unsigned nloc = st[0], nx = st[1];
        if (nloc == 0u) { xcd_barrier_complete(bar, x, nloc, nx); st[0] = nloc; st[1] = nx; }
        const unsigned old = xb_add(&bar[XB_XSUB(x)], 1u);
        const unsigned gen = old / nloc;
        if (old + 1u == (gen + 1u) * nloc) {
            __builtin_amdgcn_fence(__ATOMIC_RELEASE, "agent");
            asm volatile("s_waitcnt vmcnt(0)" ::: "memory");
            const unsigned og = xb_add(&bar[XB_TOP], 1u);
            const unsigned tg = og / nx;
            if (og + 1u == (tg + 1u) * nx) xb_add(&bar[XB_TOPGEN], 1u);
            else XB_SPIN(xb_ld(&bar[XB_TOPGEN]) == tg, bar);
            __builtin_amdgcn_fence(__ATOMIC_ACQUIRE, "agent");
            xb_add(&bar[XB_XGEN(x)], 1u);
            asm volatile("s_waitcnt vmcnt(0)" ::: "memory");
        } else {
            XB_SPIN(xb_ld(&bar[XB_XGEN(x)]) == gen, bar);
            __builtin_amdgcn_fence(__ATOMIC_ACQUIRE, "agent");
            asm volatile("s_waitcnt vmcnt(0)" ::: "memory");
        }
    }
    __syncthreads();
}

#define MFMA32(a, b, c) __builtin_amdgcn_mfma_f32_32x32x16_bf16((a), (b), (c), 0, 0, 0)
__device__ __forceinline__ int crow(int r, int hi) { return (r & 3) + 8 * (r >> 2) + 4 * hi; }

__device__ __forceinline__ void attn_phase(bf16_t* Q, const bf16_t* Kb, const bf16_t* VT, const bf16_t* CK, const bf16_t* CVT, const float* sink, int j, int vcu, int G, int wave, int lane) {
    const int r = lane & 31, h = lane >> 5;
    for (int u = vcu; u < 1280; u += G) {
        const bool lat = u < 1024;
        int b, kvh, qb, L, seqrow;
        if (lat) { b = u >> 7; kvh = (u >> 5) & 3; qb = u & 31; L = 4096; seqrow = NCTX + b * 4096; }
        else { const int v = u - 1024; b = v >> 3; kvh = (v >> 1) & 3; qb = v & 1; L = 256; seqrow = b * 256; }
        const int hq = kvh * 4 + (wave & 3), t0 = qb * 128 + (wave >> 2) * 64;
        bf16_t* Qp = Q + (size_t)(seqrow + t0) * DM + hq * 64;
        bf16x8 qf[2][4];
#pragma unroll
        for (int qi = 0; qi < 2; ++qi)
#pragma unroll
            for (int ks = 0; ks < 4; ++ks) qf[qi][ks] = *(const bf16x8*)(Qp + (size_t)(qi * 32 + r) * DM + ks * 16 + h * 8);
        const float m0 = sink[hq] * LOG2E;
        float mrow[2] = {m0, m0}, lrow[2] = {h == 0 ? 1.f : 0.f, h == 0 ? 1.f : 0.f};
        f32x16 O[2][2];
#pragma unroll
        for (int qi = 0; qi < 2; ++qi)
#pragma unroll
            for (int db = 0; db < 2; ++db)
#pragma unroll
                for (int i = 0; i < 16; ++i) O[qi][db][i] = 0.f;
        const int nseg = lat ? 2 : 1;
        for (int seg = 0; seg < nseg; ++seg) {
            const bf16_t* kb; const bf16_t* vb; int ldv, klo, khi; bool mask;
            if (seg == 0) { kb = Kb + (size_t)seqrow * K_LD + kvh * 64; ldv = lat ? VT_LDL : VT_LDC; vb = VT + (lat ? VT_LAT_BASE + (size_t)b * VT_LAT_SEQ : (size_t)b * VT_CTX_SEQ) + (size_t)kvh * 64 * ldv;
                if (lat) { klo = t0 - 128 < 0 ? 0 : t0 - 128; khi = t0 + 192 > L ? L : t0 + 192; mask = true; } else { klo = 0; khi = 256; mask = false; } }
            else { kb = CK + (size_t)(b * 2 + j) * 512 * K_LD + kvh * 64; vb = CVT + (size_t)((b * 2 + j) * 4 + kvh) * 64 * CVT_LD; ldv = CVT_LD; klo = 0; khi = 512; mask = false; }
            bf16x8 kf[4];
#pragma unroll
            for (int ks = 0; ks < 4; ++ks) kf[ks] = *(const bf16x8*)(kb + (size_t)(klo + r) * K_LD + ks * 16 + h * 8);
            bf16x8 vf[2][2];
#pragma unroll
            for (int db = 0; db < 2; ++db)
#pragma unroll
                for (int s = 0; s < 2; ++s) vf[db][s] = *(const bf16x8*)(vb + (size_t)(db * 32 + r) * ldv + klo + s * 16 + h * 8);
            for (int key = klo; key < khi; key += 32) {
                bf16x8 kn[4], vn[2][2];
                const int keyn = (key + 32 < khi) ? key + 32 : key;
#pragma unroll
                for (int db = 0; db < 2; ++db)
#pragma unroll
                    for (int s = 0; s < 2; ++s) vn[db][s] = *(const bf16x8*)(vb + (size_t)(db * 32 + r) * ldv + keyn + s * 16 + h * 8);
#pragma unroll
                for (int ks = 0; ks < 4; ++ks) kn[ks] = *(const bf16x8*)(kb + (size_t)(keyn + r) * K_LD + ks * 16 + h * 8);
                f32x16 S[2];
#pragma unroll
                for (int qi = 0; qi < 2; ++qi) {
#pragma unroll
                    for (int i = 0; i < 16; ++i) S[qi][i] = 0.f;
#pragma unroll
                    for (int ks = 0; ks < 4; ++ks) S[qi] = MFMA32(kf[ks], qf[qi][ks], S[qi]);
                }
                if (mask) {
#pragma unroll
                    for (int qi = 0; qi < 2; ++qi) { const int t = t0 + qi * 32 + r;
#pragma unroll
                        for (int i = 0; i < 16; ++i) { const int d = t - (key + crow(i, h)); if (d > 128 || d < -128) S[qi][i] = -1e30f; } }
                }
#pragma unroll
                for (int qi = 0; qi < 2; ++qi) {
                    float tm = S[qi][0];
#pragma unroll
                    for (int i = 1; i < 16; ++i) tm = fmaxf(tm, S[qi][i]);
                    tm = fmaxf(tm, __shfl_xor(tm, 32));
                    if (__any(tm > mrow[qi] + 8.0f)) {
                        const float mn = fmaxf(mrow[qi], tm), alpha = __builtin_amdgcn_exp2f(mrow[qi] - mn);
                        mrow[qi] = mn; lrow[qi] *= alpha;
#pragma unroll
                        for (int db = 0; db < 2; ++db)
#pragma unroll
                            for (int i = 0; i < 16; ++i) O[qi][db][i] *= alpha;
                    }
                    const float mn = mrow[qi];
                    float ps = 0.f;
#pragma unroll
                    for (int i = 0; i < 16; ++i) { S[qi][i] = __builtin_amdgcn_exp2f(S[qi][i] - mn); ps += S[qi][i]; }
                    lrow[qi] += ps;
                    bf16x8 pk[2];
#pragma unroll
                    for (int s = 0; s < 2; ++s) { u32x4 w; w.x = cvtpk(S[qi][8 * s], S[qi][8 * s + 1]); w.y = cvtpk(S[qi][8 * s + 2], S[qi][8 * s + 3]); w.z = cvtpk(S[qi][8 * s + 4], S[qi][8 * s + 5]); w.w = cvtpk(S[qi][8 * s + 6], S[qi][8 * s + 7]); pk[s] = __builtin_bit_cast(bf16x8, w); }
#pragma unroll
                    for (int db = 0; db < 2; ++db)
#pragma unroll
                        for (int s = 0; s < 2; ++s) O[qi][db] = MFMA32(vf[db][s], pk[s], O[qi][db]);
                }
#pragma unroll
                for (int ks = 0; ks < 4; ++ks) kf[ks] = kn[ks];
#pragma unroll
                for (int db = 0; db < 2; ++db)
#pragma unroll
                    for (int s = 0; s < 2; ++s) vf[db][s] = vn[db][s];
            }
        }
#pragma unroll
        for (int qi = 0; qi < 2; ++qi) {
            const float lt = lrow[qi] + __shfl_xor(lrow[qi], 32), inv = 1.0f / lt;
#pragma unroll
            for (int db = 0; db < 2; ++db)
#pragma unroll
                for (int g4 = 0; g4 < 4; ++g4) { u32x2 w; w.x = cvtpk(O[qi][db][4 * g4] * inv, O[qi][db][4 * g4 + 1] * inv); w.y = cvtpk(O[qi][db][4 * g4 + 2] * inv, O[qi][db][4 * g4 + 3] * inv);
                    *(u32x2*)(Qp + (size_t)(qi * 32 + r) * DM + db * 32 + 8 * g4 + 4 * h) = w; }
        }
    }
}

__device__ __forceinline__ float wave_sum(float v) {
#pragma unroll
    for (int o = 1; o < 64; o <<= 1) v += __shfl_xor(v, o);
    return v;
}
__device__ __forceinline__ void prep_phase(const float* src0, const float* src1, const bf16_t* xb, bf16_t* H, const float* nw, const float* mods, int shoff, int scoff, int gw, int NGW, int lane) {
    for (int row0 = gw; row0 < NTOK; row0 += 2 * NGW) {
        const int row1 = row0 + NGW < NTOK ? row0 + NGW : row0;
        f32x4 v[2][4]; float ss[2] = {0.f, 0.f};
#pragma unroll
        for (int rr = 0; rr < 2; ++rr) { const int row = rr ? row1 : row0;
            if (xb) {
#pragma unroll
                for (int q = 0; q < 2; ++q) { const u32x4 w = *(const u32x4*)(xb + (size_t)row * DM + 512 * q + 8 * lane);
                    v[rr][2 * q] = (f32x4){bf2f(w.x & 0xffffu), bf2f(w.x >> 16), bf2f(w.y & 0xffffu), bf2f(w.y >> 16)}; v[rr][2 * q + 1] = (f32x4){bf2f(w.z & 0xffffu), bf2f(w.z >> 16), bf2f(w.w & 0xffffu), bf2f(w.w >> 16)}; }
            } else { const float* s = row < NCTX ? src0 + (size_t)row * DM : src1 + (size_t)(row - NCTX) * DM;
#pragma unroll
                for (int q = 0; q < 2; ++q) { v[rr][2 * q] = *(const f32x4*)(s + 512 * q + 8 * lane); v[rr][2 * q + 1] = *(const f32x4*)(s + 512 * q + 8 * lane + 4); } } }
#pragma unroll
        for (int rr = 0; rr < 2; ++rr)
#pragma unroll
            for (int q = 0; q < 4; ++q) ss[rr] += (v[rr][q][0] * v[rr][q][0] + v[rr][q][1] * v[rr][q][1]) + (v[rr][q][2] * v[rr][q][2] + v[rr][q][3] * v[rr][q][3]);
#pragma unroll
        for (int o = 1; o < 64; o <<= 1) { ss[0] += __shfl_xor(ss[0], o); ss[1] += __shfl_xor(ss[1], o); }
#pragma unroll
        for (int rr = 0; rr < 2; ++rr) { const int row = rr ? row1 : row0; if (rr && row1 == row0) break;
            const float* md = mods + (size_t)cond_of_row(row) * NMOD;
            const float rstd = 1.0f / sqrtf(ss[rr] * (1.0f / DM) + 1e-6f);
#pragma unroll
            for (int q = 0; q < 2; ++q) { const int c = 512 * q + 8 * lane; u32x4 w;
#pragma unroll
                for (int hh = 0; hh < 2; ++hh) { const f32x4 g4 = *(const f32x4*)(nw + c + 4 * hh), sc = *(const f32x4*)(md + scoff + c + 4 * hh), sh = *(const f32x4*)(md + shoff + c + 4 * hh);
                    const f32x4 o = v[rr][2 * q + hh] * rstd * g4 * (sc + 1.0f) + sh; w[2 * hh] = cvtpk(o[0], o[1]); w[2 * hh + 1] = cvtpk(o[2], o[3]); }
                *(u32x4*)(H + (size_t)row * DM + c) = w; } }
    }
}
__device__ __forceinline__ void pool_phase(const bf16_t* H, bf16_t* P, int gw, int NGW, int lane) {
    for (int row = gw; row < NTOK; row += NGW) {
        int sb, t, L;
        if (row < NCTX) { sb = row & ~255; t = row & 255; L = 256; } else { const int lr = row - NCTX; sb = NCTX + (lr & ~4095); t = lr & 4095; L = 4096; }
#pragma unroll
        for (int q = 0; q < 2; ++q) { const int c8 = lane + 64 * q, grp = c8 >> 5, hw = 1 << grp;
            int st = t - hw; if (st < 0) st = 0; int en = t + hw; if (en > L) en = L;
            float a[8];
#pragma unroll
            for (int e = 0; e < 8; ++e) a[e] = 0.f;
            for (int jr = st; jr < en; ++jr) { const u32x4 w = *(const u32x4*)(H + (size_t)(sb + jr) * DM + c8 * 8);
#pragma unroll
                for (int e = 0; e < 4; ++e) { a[2 * e] += bf2f(w[e] & 0xffffu); a[2 * e + 1] += bf2f(w[e] >> 16); } }
            const float inv = 1.0f / (float)(en - st);
            const u32x4 w = *(const u32x4*)(H + (size_t)row * DM + c8 * 8); u32x4 o;
#pragma unroll
            for (int e = 0; e < 4; ++e) o[e] = cvtpk(a[2 * e] * inv - bf2f(w[e] & 0xffffu), a[2 * e + 1] * inv - bf2f(w[e] >> 16));
            *(u32x4*)(P + (size_t)row * DM + c8 * 8) = o; }
    }
}
__device__ __forceinline__ void fix_phase(const float* hal, bf16_t* A, const float* cw, const float* cb, int gt, int GT) {
    for (int it = gt; it < 120 * 704; it += GT) {
        const int bi = it / 704, c = (it % 704) * 4, b = bi / 15, i = bi % 15 + 1, pmh = 32 + b * 16 + i;
        const float* hl = hal + (size_t)(pmh - 1) * 4 * DFF2; const float* hh = hal + (size_t)pmh * 4 * DFF2;
        f32x4 cv1[2], cv2[2];
#pragma unroll
        for (int bj = 0; bj < 2; ++bj) { const int col = bj * DFF + c;
            const f32x4 uA = *(const f32x4*)(hl + 2 * DFF2 + col), uB = *(const f32x4*)(hl + 3 * DFF2 + col), uC = *(const f32x4*)(hh + col), uD = *(const f32x4*)(hh + DFF2 + col);
            const f32x4 w0 = *(const f32x4*)(cw + col), w1 = *(const f32x4*)(cw + DFF2 + col), w2 = *(const f32x4*)(cw + 2 * DFF2 + col), bb = *(const f32x4*)(cb + col);
            cv1[bj] = w0 * uA + w1 * uB + w2 * uC + bb; cv2[bj] = w0 * uB + w1 * uC + w2 * uD + bb; }
        const size_t R = (size_t)pmh * 256;
        u32x2 w; w.x = cvtpk(silu_mul(cv1[0][0], cv1[1][0]), silu_mul(cv1[0][1], cv1[1][1])); w.y = cvtpk(silu_mul(cv1[0][2], cv1[1][2]), silu_mul(cv1[0][3], cv1[1][3]));
        *(u32x2*)(A + (R - 1) * DFF + c) = w;
        w.x = cvtpk(silu_mul(cv2[0][0], cv2[1][0]), silu_mul(cv2[0][1], cv2[1][1])); w.y = cvtpk(silu_mul(cv2[0][2], cv2[1][2]), silu_mul(cv2[0][3], cv2[1][3]));
        *(u32x2*)(A + R * DFF + c) = w;
    }
}

__device__ __forceinline__ void transpose_item(const float* W, int K, int N, bf16_t* WT, int mapkind, LAS float* scr, int item, int lane) {
    const int nblk = N / 32, kb = item / nblk, nb = item % nblk, k0 = 64 * kb, n0 = 32 * nb;
    int d0 = n0;
    if (mapkind == 1) { const int head = n0 >> 6, bj = (n0 >> 5) & 1; d0 = 256 * (head >> 2) + 128 * bj + 32 * (head & 3); }
    else if (mapkind == 2) { const int bj = n0 >= DFF ? 1 : 0, cc = n0 - bj * DFF; d0 = 256 * (cc >> 7) + 128 * bj + (cc & 127); }
#pragma unroll 32
    for (int i = 0; i < 32; ++i) { const int kk = 2 * i + (lane >> 5); scr[kk * 33 + (lane & 31)] = W[(size_t)(k0 + kk) * N + n0 + (lane & 31)]; }
    asm volatile("s_waitcnt lgkmcnt(0)" ::: "memory");
    const int c = lane & 7;
#pragma unroll
    for (int jj = 0; jj < 4; ++jj) { const int n = (lane >> 3) + 8 * jj; const LAS float* s = scr + (8 * c) * 33 + n;
        u32x4 o; o.x = cvtpk(s[0 * 33], s[1 * 33]); o.y = cvtpk(s[2 * 33], s[3 * 33]); o.z = cvtpk(s[4 * 33], s[5 * 33]); o.w = cvtpk(s[6 * 33], s[7 * 33]);
        *(u32x4*)(WT + (size_t)(d0 + n) * K + k0 + 8 * c) = o; }
    asm volatile("s_waitcnt lgkmcnt(0)" ::: "memory");
}

enum { K_PRO = 0, K_PREP1, K_PREP2, K_QKV, K_ATTN, K_WO, K_POOLP, K_POOLG, K_CHAN, K_SEQC, K_SEQL, K_FFN1, K_FIX, K_FFN2, K_ST1, K_ST2, K_FFN2X };
#ifndef PROBE_DUP
#define PROBE_DUP(X, k)
#endif
#define PROG_LIST(X) X(K_PRO,0) \
    X(K_PREP1,0) X(K_QKV,0) X(K_ATTN,0) X(K_WO,0) X(K_PREP2,0) PROBE_DUP(X, 0) X(K_FFN1,0) X(K_FIX,0) X(K_FFN2,0) \
    X(K_PREP1,1) X(K_POOLP,1) X(K_POOLG,1) X(K_PREP2,1) PROBE_DUP(X, 1) X(K_FFN1,1) X(K_FIX,1) X(K_FFN2,1) \
    X(K_PREP1,2) X(K_CHAN,2) X(K_SEQC,2) X(K_ST1,2) X(K_ST2,2) X(K_PREP2,2) PROBE_DUP(X, 2) X(K_FFN1,2) X(K_FIX,2) X(K_FFN2,2) \
    X(K_PREP1,3) X(K_QKV,3) X(K_ATTN,3) X(K_WO,3) X(K_PREP2,3) PROBE_DUP(X, 3) X(K_FFN1,3) X(K_FIX,3) X(K_FFN2,3)
#define PROG_K(k, l) k,
#define PROG_L(k, l) l,
__constant__ unsigned char PROG_KIND[] = { PROG_LIST(PROG_K) };
__constant__ unsigned char PROG_LAYER[] = { PROG_LIST(PROG_L) };
static const unsigned char H_PROG_KIND[] = { PROG_LIST(PROG_K) };
constexpr int NSTEP = (int)sizeof(H_PROG_KIND);

struct Args { const float* in[22]; float* out; unsigned char* ws; int s_lo, s_hi; };

__global__ void __launch_bounds__(512, 2) mega_fwd(Args a) {
    extern __shared__ __attribute__((aligned(16))) unsigned char lds_raw[];
    LAS unsigned char* lds = (LAS unsigned char*)lds_raw;
    LAS unsigned char* xl = lds + LDS_X;
    cg::grid_group grid = cg::this_grid();
    volatile LAS unsigned* bst = (volatile LAS unsigned*)(lds + LDS_MISC);
    unsigned* bar = (unsigned*)(a.ws + WS_CTL);
    if (threadIdx.x < 4) bst[threadIdx.x] = 0u;
    __syncthreads();
    const unsigned xcc = xb_xcc_id();
    if (threadIdx.x == 0) (void)xb_add(&bar[XB_XCNT(xcc)], 1u);
    const int G = gridDim.x, NGW = G * 8, GT = G * 512;
    unsigned char* ws = a.ws; float* out = a.out;
    float* mods = (float*)(ws + WS_MODS);
    float* ropec = (float*)(ws + WS_ROPE); float* ropes = ropec + 1024;
    bf16_t* Hb = (bf16_t*)(ws + WS_H);
    bf16_t* BIG = (bf16_t*)(ws + WS_BIG);
    bf16_t* Qb = (bf16_t*)(ws + WS_Q); bf16_t* Kbuf = (bf16_t*)(ws + WS_K); bf16_t* VTb = (bf16_t*)(ws + WS_VT);
    float* hal = (float*)(ws + WS_HAL);

    for (int s = a.s_lo; s < a.s_hi; ++s) {
        int tid = threadIdx.x, bx = blockIdx.x;
        asm volatile("" : "+v"(tid), "+s"(bx));
        const int lane = tid & 63, wave = __builtin_amdgcn_readfirstlane(tid >> 6);
        const int vcu = (G % 8 == 0) ? (bx % 8) * (G / 8) + bx / 8 : bx;
        const int gw = vcu * 8 + wave, gt = bx * 512 + tid;
        const int kind = PROG_KIND[s], layer = PROG_LAYER[s], jl = layer / 3;
        const float* xs0 = a.in[0]; const float* xs1 = a.in[1];
        bf16_t* XB = (bf16_t*)(ws + WS_XB); const bf16_t* xbin = (s <= 4) ? nullptr : XB;
        const float* lmods = mods + (size_t)layer * 9 * NMOD;
        switch (kind) {
#ifndef NO_PRO
        case K_PRO: {
            LAS float* scond = (LAS float*)lds; LAS float* part = (LAS float*)(lds + 40960);
            for (int i = tid; i < 9 * 1024; i += 512) { const int cnd = i >> 10, k = i & 1023; const float v = cnd == 0 ? a.in[5][k] : a.in[4][(cnd - 1) * 1024 + k];
                scond[((k & 1) * 9 + cnd) * 512 + (k >> 7) * 64 + ((k & 127) >> 1)] = v / (1.0f + __expf(-v)); }
            __syncthreads();
            for (int item = bx; item < 768; item += G) {
                const int ly = item / 192, cb = item % 192, col = lane & 31, hk = lane >> 5;
                const float* w = a.in[8] + (size_t)ly * 1024 * NMOD + cb * 32 + col + (size_t)(wave * 128 + hk) * NMOD;
                const LAS float* sc = scond + (hk * 9) * 512 + wave * 64;
                float ac[9];
#pragma unroll
                for (int c = 0; c < 9; ++c) ac[c] = 0.f;
#pragma unroll 4
                for (int kk = 0; kk < 64; kk += 4) {
                    const float w0 = w[(size_t)(2 * kk) * NMOD], w1 = w[(size_t)(2 * kk + 2) * NMOD], w2 = w[(size_t)(2 * kk + 4) * NMOD], w3 = w[(size_t)(2 * kk + 6) * NMOD];
#pragma unroll
                    for (int c = 0; c < 9; ++c) { const f32x4 s = *(const LAS f32x4*)(sc + c * 512 + kk); ac[c] += (w0 * s[0] + w1 * s[1]) + (w2 * s[2] + w3 * s[3]); }
                }
#pragma unroll
                for (int c = 0; c < 9; ++c) part[((wave * 2 + hk) * 9 + c) * 32 + col] = ac[c];
                __syncthreads();
                for (int i = tid; i < 288; i += 512) { const int c = i >> 5, l = i & 31; float sm = a.in[9][ly * NMOD + cb * 32 + l];
#pragma unroll
                    for (int p = 0; p < 16; ++p) sm += part[(p * 9 + c) * 32 + l];
                    mods[((size_t)ly * 9 + c) * NMOD + cb * 32 + l] = sm; }
                __syncthreads();
            }
            {
                LAS float* scr = (LAS float*)(lds + wave * 16384);
                constexpr int I_QKV = 16 * 48, I_WO = 16 * 32, I_POOL = 4 * 8, I_IN = 16 * 176, I_OUT = 44 * 32;
                constexpr int NIT = 2 * I_QKV + 2 * I_WO + 4 * I_POOL + 4 * I_IN + 4 * I_OUT;
                for (int it = gw; it < NIT; it += NGW) {
                    int r_ = it;
                    if (r_ < 4 * I_IN) { const int ly = r_ / I_IN; transpose_item(a.in[18] + (size_t)ly * DM * DFF2, DM, DFF2, (bf16_t*)(ws + WS_WIN) + (size_t)ly * DFF2 * DM, 2, scr, r_ % I_IN, lane); continue; } r_ -= 4 * I_IN;
                    if (r_ < 4 * I_OUT) { const int ly = r_ / I_OUT; transpose_item(a.in[21] + (size_t)ly * DFF * DM, DFF, DM, (bf16_t*)(ws + WS_WOUT) + (size_t)ly * DM * DFF, 0, scr, r_ % I_OUT, lane); continue; } r_ -= 4 * I_OUT;
                    if (r_ < 2 * I_QKV) { const int ly = r_ / I_QKV; transpose_item(a.in[10] + (size_t)ly * DM * NQKV, DM, NQKV, (bf16_t*)(ws + WS_WQKV) + (size_t)ly * NQKV * DM, 1, scr, r_ % I_QKV, lane); continue; } r_ -= 2 * I_QKV;
                    if (r_ < 2 * I_WO) { const int ly = r_ / I_WO; transpose_item(a.in[14] + (size_t)ly * DM * DM, DM, DM, (bf16_t*)(ws + WS_WO) + (size_t)ly * DM * DM, 0, scr, r_ % I_WO, lane); continue; } r_ -= 2 * I_WO;
                    { const int gp = r_ / I_POOL; transpose_item(a.in[15] + (size_t)gp * 65536, 256, 256, (bf16_t*)(ws + WS_WPOOL) + (size_t)gp * 65536, 0, scr, r_ % I_POOL, lane); }
                }
            }
            __syncthreads();
            LAS f32x2* TAB = (LAS f32x2*)lds;
            for (int k = tid; k < 4096; k += 512) { float sv, cv; sincospif((float)k * (1.0f / 2048.0f), &sv, &cv); TAB[k] = (f32x2){cv, sv}; }
            __syncthreads();
            { bf16_t* A1 = (bf16_t*)(ws + WS_A1);
                for (int it = gt; it < 32 * 256 * 32; it += GT) { const int p = it >> 13, j = (it >> 5) & 255, k0 = (it & 31) * 8, t1 = (j >> 1) & 63, bbl = j >> 7, ri = j & 1, part_ = (k0 >> 6) & 1, a0 = k0 & 63; float v[8];
#pragma unroll
                    for (int e = 0; e < 8; ++e) { const f32x2 cs = TAB[(t1 * (64 * (a0 + e) + 2 * p + bbl)) & 4095]; const float x = ri == 0 ? (part_ == 0 ? cs.x : -cs.y) : (part_ == 0 ? -cs.y : -cs.x); v[e] = ((k0 >> 7) == bbl) ? x * (1.0f / 64.0f) : 0.f; }
                    u32x4 o; o.x = cvtpk(v[0], v[1]); o.y = cvtpk(v[2], v[3]); o.z = cvtpk(v[4], v[5]); o.w = cvtpk(v[6], v[7]); *(u32x4*)(A1 + (size_t)it * 8) = o; }
                bf16_t* A2 = (bf16_t*)(ws + WS_A2);
                for (int it = gt; it < 256 * 64; it += GT) { const int r_ = it >> 6, k0 = (it & 63) * 8, t1l = r_ >> 6, t2 = r_ & 63; float v[8];
#pragma unroll
                    for (int e = 0; e < 8; ++e) { const int k = k0 + e, bb = k >> 3; const f32x2 cs = TAB[((t2 * bb) & 63) * 64]; v[e] = (((k >> 1) & 3) == t1l) ? ((k & 1) ? cs.y : cs.x) : 0.f; }
                    u32x4 o; o.x = cvtpk(v[0], v[1]); o.y = cvtpk(v[2], v[3]); o.z = cvtpk(v[4], v[5]); o.w = cvtpk(v[6], v[7]); *(u32x4*)(A2 + (size_t)it * 8) = o; }
                bf16_t* D2 = (bf16_t*)(ws + WS_DFT256);
                for (int it = gt; it < 256 * 64; it += GT) { const int t = it >> 6, j0 = (it & 63) * 8, part_ = j0 >= 256, jj = j0 & 255; float v[8];
#pragma unroll
                    for (int e = 0; e < 8; ++e) { const f32x2 cs = TAB[((t * (jj + e)) & 255) * 16]; v[e] = (part_ ? -cs.y : cs.x) * (1.0f / 16.0f); }
                    u32x4 o; o.x = cvtpk(v[0], v[1]); o.y = cvtpk(v[2], v[3]); o.z = cvtpk(v[4], v[5]); o.w = cvtpk(v[6], v[7]); *(u32x4*)(D2 + (size_t)t * 512 + j0) = o; }
            }
            { LAS float* wt = (LAS float*)(lds + 32768); bf16_t* WCS = (bf16_t*)(ws + WS_WCS);
                for (int item = bx; item < 256; item += G) {
                    const int gp = item >> 6, n0 = (item & 63) * 16;
                    for (int i = tid; i < 4096; i += 512) wt[i] = a.in[17][(size_t)(gp * 256 + (i >> 4)) * DM + n0 + (i & 15)];
                    __syncthreads();
                    const int nn = tid & 15, cg_ = tid >> 4;
                    float ac[8], as[8];
#pragma unroll
                    for (int e = 0; e < 8; ++e) { ac[e] = 0.f; as[e] = 0.f; }
                    for (int cp = 0; cp < 256; ++cp) { const float wv = wt[cp * 16 + nn];
#pragma unroll
                        for (int e = 0; e < 8; ++e) { const f32x2 cs = TAB[(((cg_ * 8 + e) * cp) & 255) * 16]; ac[e] += wv * cs.x; as[e] += wv * cs.y; } }
                    u32x4 o; o.x = cvtpk(ac[0] * 0.0625f, ac[1] * 0.0625f); o.y = cvtpk(ac[2] * 0.0625f, ac[3] * 0.0625f); o.z = cvtpk(ac[4] * 0.0625f, ac[5] * 0.0625f); o.w = cvtpk(ac[6] * 0.0625f, ac[7] * 0.0625f);
                    *(u32x4*)(WCS + (size_t)(n0 + nn) * DM + gp * 256 + cg_ * 8) = o;
                    o.x = cvtpk(as[0] * 0.0625f, as[1] * 0.0625f); o.y = cvtpk(as[2] * 0.0625f, as[3] * 0.0625f); o.z = cvtpk(as[4] * 0.0625f, as[5] * 0.0625f); o.w = cvtpk(as[6] * 0.0625f, as[7] * 0.0625f);
                    *(u32x4*)(WCS + (size_t)(1024 + n0 + nn) * DM + gp * 256 + cg_ * 8) = o;
                    __syncthreads();
                }
            }
            for (int i = gt; i < 1024; i += GT) { const int pos = i >> 4, f = i & 15; const float invf = 1.0f / powf(10000.0f, (float)f * (1.0f / 16.0f)); float sv, cv; sincosf((float)pos * invf, &sv, &cv); ropec[i] = cv; ropes[i] = sv; }
            { bf16_t* CKb = (bf16_t*)(ws + WS_CK); bf16_t* CVTb = (bf16_t*)(ws + WS_CVT);
                for (int it = gt; it < 262144; it += GT) { const f32x4 v0 = *(const f32x4*)(a.in[2] + (size_t)it * 8), v1 = *(const f32x4*)(a.in[2] + (size_t)it * 8 + 4);
                    u32x4 o; o.x = cvtpk(v0[0], v0[1]); o.y = cvtpk(v0[2], v0[3]); o.z = cvtpk(v1[0], v1[1]); o.w = cvtpk(v1[2], v1[3]); *(u32x4*)(CKb + (size_t)(it >> 5) * K_LD + (it & 31) * 8) = o; }
                for (int it = gt; it < 262144; it += GT) { const int d = it & 63, chunk = (it >> 6) & 63, kvh = (it >> 12) & 3, bj2 = it >> 14, g16 = chunk >> 1, hh = chunk & 1; float v[8];
#pragma unroll
                    for (int e = 0; e < 8; ++e) { const int pos = 16 * g16 + 4 * hh + (e & 3) + 8 * (e >> 2); v[e] = a.in[3][((size_t)(bj2 * 512 + pos) * 4 + kvh) * 64 + d]; }
                    u32x4 o; o.x = cvtpk(v[0], v[1]); o.y = cvtpk(v[2], v[3]); o.z = cvtpk(v[4], v[5]); o.w = cvtpk(v[6], v[7]); *(u32x4*)(CVTb + ((size_t)(bj2 * 4 + kvh) * 64 + d) * CVT_LD + chunk * 8) = o; }
            }
        } break;
#endif
        case K_PREP1: prep_phase(xs0, xs1, xbin, Hb, a.in[6] + layer * DM, lmods, 0, 1024, gw, NGW, lane); break;
        case K_PREP2: prep_phase(xs0, xs1, xbin, Hb, a.in[7] + layer * DM, lmods, 3072, 4096, gw, NGW, lane); break;
        case K_POOLP: pool_phase(Hb, BIG, gw, NGW, lane); break;
        case K_FIX: fix_phase(hal, BIG, a.in[19] + (size_t)layer * 3 * DFF2, a.in[20] + (size_t)layer * DFF2, gt, GT); break;
#ifndef NO_ATTN
        case K_ATTN: attn_phase(Qb, Kbuf, VTb, (const bf16_t*)(ws + WS_CK), (const bf16_t*)(ws + WS_CVT), a.in[13] + jl * 16, jl, vcu, G, wave, lane); break;
#endif
#ifndef NO_QKV
        case K_QKV: {
            pg8::Gemm g{(const char*)Hb, (const char*)(ws + WS_WQKV) + (size_t)jl * NQKV * DM * 2, DM, DM, DM, 160, 6, 160, 0, 0};
            pg8::Order S; S.init(160, 6, G, bx);
            pg8::EpiQKV E{Qb, Kbuf, VTb, out + OUT_CK + (size_t)jl * 65536, out + OUT_CV + (size_t)jl * 65536, a.in[11] + jl * 64, a.in[12] + jl * 64, ropec, ropes};
            pg8::gemm_phase<pg8::EpiQKV>(lds, xl, g, S, E, tid);
        } break;
#endif
#ifndef NO_CHAN
        case K_CHAN: {
            for (int v = 0; v < 2; ++v) {
                pg8::Gemm g{(const char*)(ws + WS_WCS), (const char*)(Hb + (size_t)(v ? NCTX : 0) * DM), DM, DM, DM, 8, v ? 128 : 32, 8, 0, 0};
                g.bperm = v;
                pg8::Order S; S.init(8, v ? 128 : 32, G, bx);
                pg8::EpiChan E{(bf16_t*)(ws + (v ? WS_PTL : WS_PTC)), v};
                pg8::gemm_phase<pg8::EpiChan>(lds, xl, g, S, E, tid);
            }
        } break;
#endif
        case K_ST1: {
            pg8::Gemm g{(const char*)(ws + WS_PTL), (const char*)(ws + WS_A1), 8192, 256, 256, 32, 32, 32, 512, 0};
            pg8::Order S; S.init(32, 32, G, bx);
            pg8::EpiY1 E{(bf16_t*)(ws + WS_YT)};
            pg8::gemm_phase<pg8::EpiY1>(lds, xl, g, S, E, tid);
        } break;
#ifndef NO_FFN1
        case K_FFN1: {
            pg8::Gemm g{(const char*)Hb, (const char*)(ws + WS_WIN) + (size_t)layer * DFF2 * DM * 2, DM, DM, DM, 160, 22, 160, 0, 0};
            pg8::Order S; S.init(160, 22, G, bx);
            pg8::EpiFfn1 E{BIG, hal, a.in[19] + (size_t)layer * 3 * DFF2, a.in[20] + (size_t)layer * DFF2};
            pg8::gemm_phase<pg8::EpiFfn1>(lds, xl, g, S, E, tid);
        } break;
#endif
#ifndef NO_RES
        default: {
            pg8::Gemm g; pg8::EpiRes E; E.src0 = xs0; E.src1 = xs1; E.xin = xbin; { const bool last_ = (kind == K_FFN2 && layer == 3); E.xout = last_ ? nullptr : XB; E.dst = last_ ? out : nullptr; } E.pscale = nullptr; E.pm0 = 0; E.rowmap = 0; E.gate = lmods + 2048;
            g.akoff = 0; g.bstride = 0;
            if (kind == K_WO) { g.A = (const char*)Qb; g.Bt = (const char*)(ws + WS_WO) + (size_t)jl * DM * DM * 2; g.lda = DM; g.ldb = DM; g.K = DM; g.nM = 160; g.nN = 4; g.amod = 160; }
            else if (kind == K_POOLG) { g.A = (const char*)BIG; g.Bt = (const char*)(ws + WS_WPOOL); g.lda = DM; g.ldb = 256; g.K = 256; g.nM = 160; g.nN = 4; g.amod = 160; g.akoff = 512; E.pscale = a.in[16]; }
            else if (kind == K_SEQC) { g.A = (const char*)(ws + WS_DFT256); g.Bt = (const char*)(ws + WS_PTC); g.lda = 512; g.ldb = 512; g.K = 512; g.nM = 32; g.nN = 4; g.amod = 1; g.bmod = 1; g.bstride = (size_t)256 * 2048 * 2; }
            else if (kind == K_ST2) { g.A = (const char*)(ws + WS_A2); g.Bt = (const char*)(ws + WS_YT); g.lda = 512; g.ldb = 8192; g.K = 512; g.nM = 128; g.nN = 4; g.amod = 1; g.bmod = 16; g.bstride = (size_t)1024 * 8192 * 2; g.bstride2 = 16; g.bkc = 256; E.rowmap = 1; }
            else { g.A = (const char*)BIG; g.Bt = (const char*)(ws + WS_WOUT) + (size_t)layer * DM * DFF * 2; g.lda = DFF; g.ldb = DFF; g.K = DFF; g.nM = 160; g.nN = 4; g.amod = 160; E.gate = lmods + 5120; }
            pg8::Order S; S.init(g.nM, g.nN, G, bx);
            const int nfull = (S.nwg / G) * G, rem = S.nwg - nfull;
            if (rem > 0 && 2 * rem <= G && (G & 1) == 0) {
                S.hi = nfull; if (nfull > 0) pg8::gemm_phase<pg8::EpiRes>(lds, xl, g, S, E, tid);
                S.lo = nfull; S.hi = S.nwg; S.G = G >> 1; S.c = bx >> 1;
                if (bx & 1) pg8::gemm_phase<pg8::EpiRes, 2>(lds, xl, g, S, E, tid); else pg8::gemm_phase<pg8::EpiRes, 1>(lds, xl, g, S, E, tid);
            } else pg8::gemm_phase<pg8::EpiRes>(lds, xl, g, S, E, tid);
        } break;
#endif
        }
        if (s + 1 < a.s_hi && kind != K_SEQC) { if (s == a.s_lo) grid.sync(); else xcd_barrier(bar, xcc, bst); }
    }
}

extern "C" void kernel_launch(void* const* d_in, const int* in_sizes, int n_in, void* d_out, int out_size, void* d_ws, size_t ws_size, hipStream_t stream) {
    static int grid = 0;
    if (grid == 0) {
        if (n_in != 22 || ws_size < WS_END) { fprintf(stderr, "kernel_launch: unexpected n_in %d or ws_size %zu (< %zu)\n", n_in, ws_size, (size_t)WS_END); grid = -1; return; }
        int dev = 0, cus = 0, per_cu = 0;
        hipGetDevice(&dev); hipDeviceGetAttribute(&cus, hipDeviceAttributeMultiprocessorCount, dev);
        if (hipFuncSetAttribute((const void*)mega_fwd, hipFuncAttributeMaxDynamicSharedMemorySize, LDS_BYTES) != hipSuccess) { fprintf(stderr, "kernel_launch: hipFuncSetAttribute failed\n"); grid = -1; return; }
        if (hipOccupancyMaxActiveBlocksPerMultiprocessor(&per_cu, (const void*)mega_fwd, 512, LDS_BYTES) != hipSuccess || per_cu < 1) { fprintf(stderr, "kernel_launch: occupancy query says %d\n", per_cu); per_cu = 1; }
        (void)hipGetLastError();
        grid = cus * 1;
    }
    if (grid < 0) return;
    if (hipMemsetAsync((char*)d_ws + WS_CTL, 0, CTL_BYTES, stream) != hipSuccess) { fprintf(stderr, "kernel_launch: memset failed\n"); return; }
    Args a{};
    for (int i = 0; i < 22; ++i) a.in[i] = (const float*)d_in[i];
    a.out = (float*)d_out; a.ws = (unsigned char*)d_ws;
#if MK_MULTI
    for (int s = 0; s < NSTEP;) {
        int e = s + 1; if (H_PROG_KIND[s] == K_SEQC) e = s + 2;
        a.s_lo = s; a.s_hi = e; void* args[] = {&a};
        hipError_t err = hipLaunchCooperativeKernel((const void*)mega_fwd, dim3(grid), dim3(512), args, LDS_BYTES, stream);
        if (err != hipSuccess) { fprintf(stderr, "kernel_launch: cooperative launch failed: %s\n", hipGetErrorString(err)); break; }
        s = e;
    }
#else
    a.s_lo = 0; a.s_hi = NSTEP; void* args[] = {&a};
    hipError_t err = hipLaunchCooperativeKernel((const void*)mega_fwd, dim3(grid), dim3(512), args, LDS_BYTES, stream);
    if (err != hipSuccess) fprintf(stderr, "kernel_launch: cooperative launch failed: %s (grid %d)\n", hipGetErrorString(err), grid);
#endif
}
```

```cpp
#include <hip/hip_runtime.h>
#include <hip/hip_cooperative_groups.h>
#include <cstdio>
#include <cstdint>
namespace cg = cooperative_groups;

#ifndef MK_MULTI
#define MK_MULTI 0
#endif

#define LAS __attribute__((address_space(3)))
typedef unsigned short bf16_t;
typedef short bf16x8 __attribute__((ext_vector_type(8)));
typedef float f32x2 __attribute__((ext_vector_type(2)));
typedef float f32x4 __attribute__((ext_vector_type(4)));
typedef float f32x16 __attribute__((ext_vector_type(16)));
typedef unsigned u32x2 __attribute__((ext_vector_type(2)));
typedef unsigned u32x4 __attribute__((ext_vector_type(4)));
typedef __bf16 bf16x2_t __attribute__((ext_vector_type(2)));

constexpr int DM = 1024, NCTX = 8192, NTOK = 40960, DFF = 2816, DFF2 = 5632, NQKV = 1536, NMOD = 6144;
constexpr float LOG2E = 1.4426950408889634f;
constexpr float QSCALE = 0.125f * LOG2E;

constexpr size_t MiB = 1u << 20;
constexpr size_t WS_MODS = 0;
constexpr size_t WS_ROPE = 1 * MiB;
constexpr size_t WS_DFT256 = 1 * MiB + 64 * 1024;
constexpr size_t WS_WQKV = 2 * MiB;
constexpr size_t WS_WO = 8 * MiB;
constexpr size_t WS_WPOOL = 12 * MiB;
constexpr size_t WS_WCS = 13 * MiB;
constexpr size_t WS_WIN = 17 * MiB;
constexpr size_t WS_WOUT = 61 * MiB;
constexpr size_t WS_CK = 83 * MiB;
constexpr size_t WS_CVT = 488 * MiB;
constexpr int K_LD = 272;
constexpr int VT_LDC = 288, VT_LDL = 4160, CVT_LD = 544;
constexpr size_t VT_CTX_SEQ = (size_t)256 * VT_LDC, VT_LAT_BASE = 32 * VT_CTX_SEQ, VT_LAT_SEQ = (size_t)256 * VT_LDL;
constexpr size_t WS_HAL = 88 * MiB;
constexpr size_t WS_A1 = 102 * MiB;
constexpr size_t WS_A2 = 106 * MiB;
constexpr size_t WS_XB = 107 * MiB;
constexpr size_t WS_YT = 187 * MiB;
constexpr size_t WS_H = 187 * MiB;
constexpr size_t WS_BIG = 267 * MiB;
constexpr size_t WS_PTC = WS_BIG + 60 * MiB, WS_PTL = WS_BIG + 92 * MiB;
constexpr size_t WS_Q = WS_BIG, WS_K = WS_BIG + 80 * MiB, WS_VT = WS_BIG + 104 * MiB;
constexpr size_t WS_CTL = 487 * MiB;
constexpr size_t CTL_BYTES = 64 * 1024;
constexpr size_t WS_END = 494 * MiB;

constexpr size_t OUT_CK = (size_t)NTOK * DM;
constexpr size_t OUT_CV = OUT_CK + (size_t)32 * 2 * 256 * 256;

constexpr int LDS_RING = 131072, LDS_X = 131072, LDS_MISC = 131072 + 8192, LDS_BYTES = 147456;

__device__ __forceinline__ unsigned cvtpk(float lo, float hi) { f32x2 v = {lo, hi}; bf16x2_t b = __builtin_convertvector(v, bf16x2_t); return __builtin_bit_cast(unsigned, b); }
__device__ __forceinline__ bf16_t f2bf(float f) { return (bf16_t)(cvtpk(f, 0.f) & 0xffffu); }
__device__ __forceinline__ float bf2f(unsigned v) { return __uint_as_float(v << 16); }
__device__ __forceinline__ float dpp_prev(float v) { return __int_as_float(__builtin_amdgcn_update_dpp(0, __float_as_int(v), 0x121, 0xf, 0xf, false)); }
__device__ __forceinline__ float dpp_next(float v) { return __int_as_float(__builtin_amdgcn_update_dpp(0, __float_as_int(v), 0x12F, 0xf, 0xf, false)); }
__device__ __forceinline__ f32x4 dpp_prev4(f32x4 v) { return (f32x4){dpp_prev(v[0]), dpp_prev(v[1]), dpp_prev(v[2]), dpp_prev(v[3])}; }
__device__ __forceinline__ f32x4 dpp_next4(f32x4 v) { return (f32x4){dpp_next(v[0]), dpp_next(v[1]), dpp_next(v[2]), dpp_next(v[3])}; }
__device__ __forceinline__ float silu_mul(float g, float v) { const float e = __builtin_amdgcn_exp2f(-g * LOG2E); return g * __builtin_amdgcn_rcpf(1.0f + e) * v; }
__device__ __forceinline__ int cond_of_row(int row) { return row < NCTX ? 0 : 1 + ((row - NCTX) >> 12); }

namespace pg8 {
constexpr int BM = 256, BK = 64, HALF = 128, HTB = HALF * BK * 2, NXCD = 8, WGM = 8;
__device__ __forceinline__ int lds_byte(int r, int c) { const int st = (r >> 4) * 2 + (c >> 5), rr = r & 15, cc = c & 31, ob = rr * 64 + cc * 2; return st * 1024 + (ob ^ (((ob >> 9) & 1) << 5)); }
__device__ __forceinline__ void stage_rc(int b, int& R, int& C) { const int st = b / 1024, sb = b % 1024, swz = sb ^ (((sb >> 9) & 1) << 5); R = (st >> 1) * 16 + swz / 64; C = (st & 1) * 32 + (swz % 64) / 2; }
__device__ __forceinline__ int perm32(int rho) { const int n = rho >> 4, i = rho & 15; return 8 * (i >> 2) + 4 * n + (i & 3); }

struct Unit { int pm, pn, half; };
struct Gemm { const char* A; const char* Bt; int lda, ldb, K, nM, nN, amod, akoff; size_t bstride; int bmod = 1 << 30; size_t bstride2 = 0; int bperm = 0; int bkc = 16; };
__device__ __forceinline__ const char* aptr(const Gemm& g, const Unit& u) { return g.A + (size_t)(u.pm % g.amod) * (size_t)512 * g.lda + (size_t)u.pn * g.akoff; }
__device__ __forceinline__ const char* bptr(const Gemm& g, const Unit& u) {
    if (g.bperm) return g.Bt + (size_t)((u.pn >> 4) * 4096 + 4 * (u.pn & 15)) * (size_t)2 * g.ldb;
    return g.Bt + (size_t)(u.pm / g.bmod) * g.bstride + (size_t)(u.pm % g.bmod) * g.bstride2 + (size_t)u.pn * (size_t)512 * g.ldb; }

struct Order {
    int nM, nN, nwg, G, c, lo, hi;
    __device__ __forceinline__ void init(int nM_, int nN_, int G_, int c_) { nM = nM_; nN = nN_; nwg = nM * nN; G = G_; c = c_; lo = 0; hi = nwg; }
    __device__ __forceinline__ bool next(int i, Unit& u) const {
        const long L = (long)lo + (long)i * G + c; if (L >= hi) return false;
        int wgid = (int)L; u.half = 0; { const int q = nwg / NXCD, r = nwg % NXCD, xcd = wgid % NXCD, off = wgid / NXCD; wgid = (xcd < r ? xcd * (q + 1) : r * (q + 1) + (xcd - r) * q) + off; }
        const int nig = WGM * nN, gid = wgid / nig, fm = gid * WGM, gsz = (nM - fm) < WGM ? (nM - fm) : WGM;
        u.pm = fm + ((wgid % nig) % gsz); u.pn = (wgid % nig) / gsz; return true;
    }
};


struct EpiRes {
    static constexpr bool PERM = true;
    const float* src0; const float* src1;
    const bf16_t* xin; bf16_t* xout;
    float* dst;
    const float* gate; const float* pscale; int pm0; int rowmap;
    __device__ __forceinline__ void operator()(f32x4 (&acc)[2][2][4][2], const Unit& u, int wr, int wc, int fr, int fq, LAS unsigned char*) const {
        asm volatile("" : "+v"(fr), "+v"(fq), "+s"(wr), "+s"(wc));
        const int rowt = rowmap ? NCTX + (u.pm >> 4) * 4096 + 4 * (u.pm & 15) : (pm0 + u.pm) * BM; const float* g = gate + (size_t)cond_of_row(rowt) * NMOD;
        const int col0 = u.pn * BM + wc * 32 + 8 * fq;
        f32x4 gv[2][2];
#pragma unroll
        for (int bj = 0; bj < 2; ++bj)
#pragma unroll
            for (int n = 0; n < 2; ++n) { gv[bj][n] = *(const f32x4*)(g + col0 + bj * HALF + n * 4); if (pscale) gv[bj][n] = gv[bj][n] * *(const f32x4*)(pscale + col0 + bj * HALF + n * 4); }
#pragma unroll
        for (int ai = 0; ai < 2; ++ai) { if (u.half == 2 - ai) continue;
#pragma unroll
            for (int m = 0; m < 4; ++m) {
                const int row = rowmap ? rowt + 2 * ai + wr + 64 * (16 * m + fr) : rowt + ai * HALF + wr * 64 + m * 16 + fr;
#pragma unroll
                for (int bj = 0; bj < 2; ++bj) {
                    f32x4 x0, x1;
                    if (xin) { const u32x4 w = *(const u32x4*)(xin + (size_t)row * DM + col0 + bj * HALF);
                        x0 = (f32x4){bf2f(w.x & 0xffffu), bf2f(w.x >> 16), bf2f(w.y & 0xffffu), bf2f(w.y >> 16)}; x1 = (f32x4){bf2f(w.z & 0xffffu), bf2f(w.z >> 16), bf2f(w.w & 0xffffu), bf2f(w.w >> 16)}; }
                    else { const float* s = (row < NCTX ? src0 + (size_t)row * DM : src1 + (size_t)(row - NCTX) * DM) + col0 + bj * HALF; x0 = *(const f32x4*)s; x1 = *(const f32x4*)(s + 4); }
                    x0 = x0 + gv[bj][0] * acc[ai][bj][m][0]; x1 = x1 + gv[bj][1] * acc[ai][bj][m][1];
                    if (xout) { u32x4 w; w.x = cvtpk(x0[0], x0[1]); w.y = cvtpk(x0[2], x0[3]); w.z = cvtpk(x1[0], x1[1]); w.w = cvtpk(x1[2], x1[3]); *(u32x4*)(xout + (size_t)row * DM + col0 + bj * HALF) = w; }
                    if (dst) { float* d = dst + (size_t)row * DM + col0 + bj * HALF; *(f32x4*)d = x0; *(f32x4*)(d + 4) = x1; }
                }
            } }
    }
};

struct EpiQKV {
    static constexpr bool PERM = false;
    bf16_t* Q; bf16_t* Kb; bf16_t* VT; float* ock; float* ocv; const float* qn; const float* kn; const float* ropec; const float* ropes;
    __device__ __forceinline__ void operator()(f32x4 (&acc)[2][2][4][2], const Unit& u, int wr, int wc, int fr, int fq, LAS unsigned char*) const {
        asm volatile("" : "+v"(fr), "+v"(fq), "+s"(wr), "+s"(wc));

        const int rowt = u.pm * BM; const bool lat = rowt >= NCTX; const int dl = 4 * fq;
        if (u.pn < 5) {
            const bool isq = u.pn < 4; const float* nw = isq ? qn : kn;
            f32x4 nwv[2][2];
#pragma unroll
            for (int bj = 0; bj < 2; ++bj)
#pragma unroll
                for (int n = 0; n < 2; ++n) nwv[bj][n] = *(const f32x4*)(nw + 32 * bj + 16 * n + dl);
#pragma unroll
            for (int ai = 0; ai < 2; ++ai)
#pragma unroll
                for (int m = 0; m < 4; ++m) {
                    const int row = rowt + ai * HALF + wr * 64 + m * 16 + fr;
                    float ss = 0.f;
#pragma unroll
                    for (int bj = 0; bj < 2; ++bj)
#pragma unroll
                        for (int n = 0; n < 2; ++n) { const f32x4 v = acc[ai][bj][m][n]; ss += (v[0] * v[0] + v[1] * v[1]) + (v[2] * v[2] + v[3] * v[3]); }
                    ss += __shfl_xor(ss, 16); ss += __shfl_xor(ss, 32);
                    const float rstd = 1.0f / sqrtf(ss * (1.0f / 64.0f) + 1e-6f);
                    f32x4 y[2][2];
#pragma unroll
                    for (int bj = 0; bj < 2; ++bj)
#pragma unroll
                        for (int n = 0; n < 2; ++n) y[bj][n] = acc[ai][bj][m][n] * rstd * nwv[bj][n];
                    if (!isq && !lat) {
                        float* p = ock + (size_t)(row >> 8) * 131072 + (size_t)(row & 255) * 256 + wc * 64 + dl;
#pragma unroll
                        for (int bj = 0; bj < 2; ++bj)
#pragma unroll
                            for (int n = 0; n < 2; ++n) *(f32x4*)(p + 32 * bj + 16 * n) = y[bj][n];
                    }
                    if (lat) {
                        const int lr = row - NCTX, pr = (lr & 4095) >> 6, pc = lr & 63;
#pragma unroll
                        for (int bj = 0; bj < 2; ++bj) {
                            const int pos = bj ? pc : pr;
                            const f32x4 c4 = *(const f32x4*)(ropec + pos * 16 + dl), s4 = *(const f32x4*)(ropes + pos * 16 + dl);
                            const f32x4 x1 = y[bj][0], x2 = y[bj][1];
                            y[bj][0] = x1 * c4 - x2 * s4; y[bj][1] = x1 * s4 + x2 * c4;
                        }
                    }
                    bf16_t* dstp;
                    if (isq) { dstp = Q + (size_t)row * DM + (4 * u.pn + wc) * 64 + dl;
#pragma unroll
                        for (int bj = 0; bj < 2; ++bj)
#pragma unroll
                            for (int n = 0; n < 2; ++n) y[bj][n] = y[bj][n] * QSCALE;
                    } else dstp = Kb + (size_t)row * K_LD + wc * 64 + dl;
#pragma unroll
                    for (int bj = 0; bj < 2; ++bj)
#pragma unroll
                        for (int n = 0; n < 2; ++n) { u32x2 w; w.x = cvtpk(y[bj][n][0], y[bj][n][1]); w.y = cvtpk(y[bj][n][2], y[bj][n][3]); *(u32x2*)(dstp + 32 * bj + 16 * n) = w; }
                }
        } else {
#pragma unroll
            for (int ai = 0; ai < 2; ++ai)
#pragma unroll
                for (int m = 0; m < 4; ++m) {
                    const int row = rowt + ai * HALF + wr * 64 + m * 16 + fr;
                    if (!lat) {
                        float* p = ocv + (size_t)(row >> 8) * 131072 + (size_t)(row & 255) * 256 + wc * 64 + dl;
#pragma unroll
                        for (int bj = 0; bj < 2; ++bj)
#pragma unroll
                            for (int n = 0; n < 2; ++n) *(f32x4*)(p + 32 * bj + 16 * n) = acc[ai][bj][m][n];
                    }
                    size_t sb; int pos, L;
                    if (lat) { const int lr = row - NCTX; sb = VT_LAT_BASE + (size_t)(lr >> 12) * VT_LAT_SEQ; pos = lr & 4095; L = VT_LDL; } else { sb = (size_t)(row >> 8) * VT_CTX_SEQ; pos = row & 255; L = VT_LDC; }
                    const int k16 = pos & 15, pp = (pos & ~15) + 8 * ((k16 >> 2) & 1) + (k16 & 3) + 4 * (k16 >> 3);
                    bf16_t* base = VT + sb + (size_t)(wc * 64 + dl) * L + pp;
#pragma unroll
                    for (int bj = 0; bj < 2; ++bj)
#pragma unroll
                        for (int n = 0; n < 2; ++n)
#pragma unroll
                            for (int e = 0; e < 4; ++e) base[(size_t)(32 * bj + 16 * n + e) * L] = f2bf(acc[ai][bj][m][n][e]);
                }
        }
    }
};

struct EpiChan {
    static constexpr bool PERM = true;
    bf16_t* PT; int lat;
    __device__ __forceinline__ void operator()(f32x4 (&acc)[2][2][4][2], const Unit& u, int wr, int wc, int fr, int fq, LAS unsigned char*) const {
        asm volatile("" : "+v"(fr), "+v"(fq), "+s"(wr), "+s"(wc));
#pragma unroll
        for (int ai = 0; ai < 2; ++ai)
#pragma unroll
            for (int m = 0; m < 4; ++m) {
                const int row = u.pm * BM + ai * HALF + wr * 64 + m * 16 + fr, part = row >> 10, n_ = row & 1023;
#pragma unroll
                for (int bj = 0; bj < 2; ++bj) {
                    bf16_t* d;
                    if (lat) d = PT + (size_t)(u.pn >> 4) * (1024 * 8192) + (size_t)n_ * 8192 + (4 * (u.pn & 15) + 2 * bj + (wc >> 1)) * 128 + part * 64 + (wc & 1) * 32 + 8 * fq;
                    else d = PT + (size_t)u.pn * (256 * 2048) + (size_t)n_ * 512 + part * 256 + bj * HALF + wc * 32 + 8 * fq;
                    const f32x4 v0 = acc[ai][bj][m][0], v1 = acc[ai][bj][m][1]; u32x4 w; w.x = cvtpk(v0[0], v0[1]); w.y = cvtpk(v0[2], v0[3]); w.z = cvtpk(v1[0], v1[1]); w.w = cvtpk(v1[2], v1[3]); *(u32x4*)d = w; }
            }
    }
};

struct EpiY1 {
    static constexpr bool PERM = true;
    bf16_t* YT;
    __device__ __forceinline__ void operator()(f32x4 (&acc)[2][2][4][2], const Unit& u, int wr, int wc, int fr, int fq, LAS unsigned char*) const {
        asm volatile("" : "+v"(fr), "+v"(fq), "+s"(wr), "+s"(wc));
#pragma unroll
        for (int ai = 0; ai < 2; ++ai)
#pragma unroll
            for (int m = 0; m < 4; ++m) {
                bf16_t* d = YT + (size_t)(u.pm * BM + ai * HALF + wr * 64 + m * 16 + fr) * 8192 + u.pn * BM + wc * 32 + 8 * fq;
#pragma unroll
                for (int bj = 0; bj < 2; ++bj) { const f32x4 v0 = acc[ai][bj][m][0], v1 = acc[ai][bj][m][1]; u32x4 w; w.x = cvtpk(v0[0], v0[1]); w.y = cvtpk(v0[2], v0[3]); w.z = cvtpk(v1[0], v1[1]); w.w = cvtpk(v1[2], v1[3]); *(u32x4*)(d + bj * HALF) = w; }
            }
    }
};

struct EpiFfn1 {
    static constexpr bool PERM = true;
    bf16_t* Aout; float* hal; const float* cw; const float* cb;
    __device__ __forceinline__ void operator()(f32x4 (&acc)[2][2][4][2], const Unit& u, int wr, int wc, int fr, int fq, LAS unsigned char* xl) const {
        asm volatile("" : "+v"(fr), "+v"(fq), "+s"(wr), "+s"(wc));

        LAS float* X = (LAS float*)xl;
        const int chl = wc * 32 + 8 * fq;
        LAS float* WL = (LAS float*)(xl + 9216);
        { const int t2 = (wr * 4 + wc) * 64 + fq * 16 + fr;
#pragma unroll
            for (int q = 0; q < 2; ++q) { const int idx = t2 + 512 * q, k = idx >> 8, c = idx & 255, col = (c >> 7) * DFF + u.pn * 128 + (c & 127); WL[idx] = (k < 3) ? cw[(size_t)k * DFF2 + col] : cb[col]; } }
#pragma unroll
        for (int ai = 0; ai < 2; ++ai) { const int blk = 2 * ai + wr;
            if (fr == 0) {
#pragma unroll
                for (int bj = 0; bj < 2; ++bj)
#pragma unroll
                    for (int n = 0; n < 2; ++n) *(LAS f32x4*)(X + ((blk * 2 + 0) * 2 + bj) * 128 + chl + 4 * n) = acc[ai][bj][0][n]; }
            if (fr == 15) {
#pragma unroll
                for (int bj = 0; bj < 2; ++bj)
#pragma unroll
                    for (int n = 0; n < 2; ++n) *(LAS f32x4*)(X + ((blk * 2 + 1) * 2 + bj) * 128 + chl + 4 * n) = acc[ai][bj][3][n]; }
        }
        { float* hp = hal + (size_t)u.pm * 4 * DFF2 + u.pn * 128 + chl;
            if (wr == 0 && fr < 2) {
#pragma unroll
                for (int bj = 0; bj < 2; ++bj)
#pragma unroll
                    for (int n = 0; n < 2; ++n) *(f32x4*)(hp + (size_t)fr * DFF2 + bj * DFF + 4 * n) = acc[0][bj][0][n]; }
            if (wr == 1 && fr >= 14) {
#pragma unroll
                for (int bj = 0; bj < 2; ++bj)
#pragma unroll
                    for (int n = 0; n < 2; ++n) *(f32x4*)(hp + (size_t)(fr - 12) * DFF2 + bj * DFF + 4 * n) = acc[1][bj][3][n]; }
        }
        asm volatile("s_waitcnt lgkmcnt(0)" ::: "memory"); __builtin_amdgcn_s_barrier(); asm volatile("" ::: "memory");
        const f32x4 z4 = {0.f, 0.f, 0.f, 0.f};
#pragma unroll
        for (int n = 0; n < 2; ++n) {
            const LAS float* wl = WL + chl + 4 * n;
#define CW_(k, bj) (*(const LAS f32x4*)(wl + (k) * 256 + (bj) * 128))
#pragma unroll
            for (int ai = 0; ai < 2; ++ai) { const int blk = 2 * ai + wr;
                f32x4 top[2], bot[2];
#pragma unroll
                for (int bj = 0; bj < 2; ++bj) {
                    top[bj] = blk > 0 ? *(LAS f32x4*)(X + (((blk - 1) * 2 + 1) * 2 + bj) * 128 + chl + 4 * n) : z4;
                    bot[bj] = blk < 3 ? *(LAS f32x4*)(X + (((blk + 1) * 2 + 0) * 2 + bj) * 128 + chl + 4 * n) : z4; }
#pragma unroll
                for (int m = 0; m < 4; ++m) {
                    f32x4 cv[2];
#pragma unroll
                    for (int bj = 0; bj < 2; ++bj) {
                        const f32x4 cur = acc[ai][bj][m][n];
                        f32x4 pr = dpp_prev4(cur), nx = dpp_next4(cur);
                        const f32x4 pe = (m > 0) ? dpp_prev4(acc[ai][bj][m > 0 ? m - 1 : 0][n]) : top[bj];
                        const f32x4 ne = (m < 3) ? dpp_next4(acc[ai][bj][m < 3 ? m + 1 : 3][n]) : bot[bj];
                        if (fr == 0) pr = pe;
                        if (fr == 15) nx = ne;
                        cv[bj] = CW_(0, bj) * pr + CW_(1, bj) * cur + CW_(2, bj) * nx + CW_(3, bj);
                    }
                    u32x2 w; w.x = cvtpk(silu_mul(cv[0][0], cv[1][0]), silu_mul(cv[0][1], cv[1][1])); w.y = cvtpk(silu_mul(cv[0][2], cv[1][2]), silu_mul(cv[0][3], cv[1][3]));
                    *(u32x2*)(Aout + (size_t)(u.pm * BM + ai * HALF + wr * 64 + m * 16 + fr) * DFF + u.pn * 128 + chl + 4 * n) = w;
                }
            }
        }
    }
};

template <class Epi, int HM = 0>
__device__ __forceinline__ void gemm_phase(LAS unsigned char* lds, LAS unsigned char* xl, const Gemm g, const Order& S, const Epi& E, const int tid) {
    const int wid = __builtin_amdgcn_readfirstlane(tid >> 6), lane = tid & 63, wr = wid >> 2, wc = wid & 3, fr = lane & 15, fq = lane >> 4;
    const int nt = g.K / BK;
    unsigned voffA[2], voffB[2];
#pragma unroll
    for (int i = 0; i < 2; ++i) { int R, C; stage_rc(tid * 16 + i * 8192, R, C); const int Rb = Epi::PERM ? ((R & ~31) + perm32(R & 31)) : R;
        const int Rt = g.bperm ? 64 * (Rb & 63) + (Rb >> 6) : Rb;
        voffA[i] = (unsigned)(R * g.lda + C) * 2u; voffB[i] = (unsigned)(Rt * g.ldb) * 2u + (unsigned)((C >> 3) * g.bkc); }
    const size_t kstep = (size_t)(BK * 2), kstepB = (size_t)(8 * g.bkc);
    const size_t hA = (size_t)HALF * g.lda * 2, hB = g.bperm ? (size_t)4 * g.ldb : (size_t)HALF * g.ldb * 2;
    const unsigned ldsw = (unsigned)wid * 1024u;
    const int aoff = lds_byte(wr * 64 + fr, fq * 8), boff = lds_byte(wc * 32 + fr, fq * 8);
#define PG8_SA(b, h) (((b) * 2 + (h)) * HTB)
#define PG8_SB(b, h) ((4 + (b) * 2 + (h)) * HTB)
#define PG8_STAGE(bufoff, gbase, voff) do { _Pragma("unroll") for (int _i = 0; _i < 2; ++_i) \
        __builtin_amdgcn_global_load_lds((const unsigned*)((const char*)(gbase) + (voff)[_i]), (LAS unsigned*)(lds + (bufoff) + ldsw + _i * 8192), 16, 0, 0); } while (0)
#define PG8_LDA(dst, b, h) do { _Pragma("unroll") for (int m = 0; m < 4; ++m) _Pragma("unroll") for (int k = 0; k < 2; ++k) dst[m][k] = *(const LAS bf16x8*)(lds + PG8_SA(b, h) + aoff + m * 2048 + k * 1024); } while (0)
#define PG8_LDB(dst, b, h) do { _Pragma("unroll") for (int n = 0; n < 2; ++n) _Pragma("unroll") for (int k = 0; k < 2; ++k) dst[n][k] = *(const LAS bf16x8*)(lds + PG8_SB(b, h) + boff + n * 2048 + k * 1024); } while (0)
#define PG8_MMA(ai, bj, At, Bt) do { __builtin_amdgcn_s_setprio(1); _Pragma("unroll") for (int m = 0; m < 4; ++m) _Pragma("unroll") for (int n = 0; n < 2; ++n) _Pragma("unroll") for (int k = 0; k < 2; ++k) \
        acc[ai][bj][m][n] = __builtin_amdgcn_mfma_f32_16x16x32_bf16(Bt[n][k], At[m][k], acc[ai][bj][m][n], 0, 0, 0); __builtin_amdgcn_s_setprio(0); } while (0)
#define PG8_WAIT_V(n) asm volatile("s_waitcnt vmcnt(" #n ")" ::: "memory")
#define PG8_WAIT_L(n) asm volatile("s_waitcnt lgkmcnt(" #n ")" ::: "memory")
#define PG8_BAR __builtin_amdgcn_s_barrier()
#define PG8_SCHED __builtin_amdgcn_sched_barrier(0)
    Unit cur, nxt; int ui = 0;
    if (!S.next(0, cur)) return;
    f32x4 acc[2][2][4][2];
#pragma unroll
    for (int a = 0; a < 2; ++a)
#pragma unroll
        for (int b = 0; b < 2; ++b)
#pragma unroll
            for (int m = 0; m < 4; ++m)
#pragma unroll
                for (int n = 0; n < 2; ++n) acc[a][b][m][n] = (f32x4){0.f, 0.f, 0.f, 0.f};
    bf16x8 At[4][2], B0[2][2], B1[2][2];
    const char* cA = aptr(g, cur); const char* cB = bptr(g, cur);
    PG8_STAGE(PG8_SB(0, 0), cB, voffB); PG8_STAGE(PG8_SB(0, 1), cB + hB, voffB); PG8_STAGE(PG8_SA(0, 0), cA, voffA); PG8_STAGE(PG8_SA(0, 1), cA + hA, voffA);
    if (wr == 1) PG8_BAR;
    PG8_WAIT_V(2); PG8_BAR;
    PG8_STAGE(PG8_SB(1, 0), cB + kstepB, voffB); PG8_STAGE(PG8_SA(1, 0), cA + kstep, voffA); PG8_STAGE(PG8_SB(1, 1), cB + hB + kstepB, voffB);
    PG8_WAIT_V(6); PG8_BAR;
    for (;;) {
        const bool has_next = S.next(ui + 1, nxt);
        const char* nA = has_next ? aptr(g, nxt) : cA; const char* nB = has_next ? bptr(g, nxt) : cB;
        for (int t = 0; t < nt; t += 2) {
            const bool last = (t == nt - 2);
            const char* a1 = cA + (size_t)(t + 1) * kstep;
            const char* a2 = last ? nA : cA + (size_t)(t + 2) * kstep; const char* b2 = last ? nB : cB + (size_t)(t + 2) * kstepB;
            const char* a3 = a2 + kstep; const char* b3 = b2 + kstepB;
            PG8_LDB(B0, 0, 0); PG8_LDB(B1, 0, 1); PG8_SCHED; PG8_LDA(At, 0, 0); PG8_STAGE(PG8_SA(1, 1), a1 + hA, voffA);
            PG8_WAIT_V(8); PG8_WAIT_L(0); PG8_BAR; if constexpr (HM != 2) { PG8_MMA(0, 0, At, B0); PG8_MMA(0, 1, At, B1); } PG8_BAR; PG8_SCHED;
            PG8_LDA(At, 0, 1); PG8_STAGE(PG8_SB(0, 0), b2, voffB); PG8_STAGE(PG8_SB(0, 1), b2 + hB, voffB); PG8_STAGE(PG8_SA(0, 0), a2, voffA);
            PG8_WAIT_V(8); PG8_WAIT_L(0); PG8_BAR; if constexpr (HM != 1) { PG8_MMA(1, 0, At, B0); PG8_MMA(1, 1, At, B1); } PG8_BAR; PG8_SCHED;
            PG8_LDB(B0, 1, 0); PG8_LDB(B1, 1, 1); PG8_SCHED; PG8_LDA(At, 1, 0); PG8_STAGE(PG8_SA(0, 1), a2 + hA, voffA);
            PG8_WAIT_V(8); PG8_WAIT_L(0); PG8_BAR; if constexpr (HM != 2) { PG8_MMA(0, 0, At, B0); PG8_MMA(0, 1, At, B1); } PG8_BAR; PG8_SCHED;
            PG8_LDA(At, 1, 1); PG8_STAGE(PG8_SB(1, 0), b3, voffB); PG8_STAGE(PG8_SB(1, 1), b3 + hB, voffB); PG8_STAGE(PG8_SA(1, 0), a3, voffA);
            PG8_WAIT_V(8); PG8_WAIT_L(0); PG8_BAR; if constexpr (HM != 1) { PG8_MMA(1, 0, At, B0); PG8_MMA(1, 1, At, B1); } PG8_BAR; PG8_SCHED;
        }
        if (wr == 0) PG8_BAR;
        cur.half = HM; E(acc, cur, wr, wc, fr, fq, xl);
        if (!has_next) break;
#pragma unroll
        for (int a = 0; a < 2; ++a)
#pragma unroll
            for (int b = 0; b < 2; ++b)
#pragma unroll
                for (int m = 0; m < 4; ++m)
#pragma unroll
                    for (int n = 0; n < 2; ++n) acc[a][b][m][n] = (f32x4){0.f, 0.f, 0.f, 0.f};
        cur = nxt; cA = nA; cB = nB; ++ui;
        if (wr == 1) PG8_BAR;
    }
    PG8_WAIT_V(0);
    PG8_BAR;
#undef PG8_SA
#undef PG8_SB
#undef PG8_STAGE
#undef PG8_LDA
#undef PG8_LDB
#undef PG8_MMA
#undef PG8_WAIT_V
#undef PG8_WAIT_L
#undef PG8_BAR
#undef PG8_SCHED
}
}


#define XB_TMO      128
#define XB_XCNT(j)  (256  + 64 * (j))
#define XB_XSUB(j)  (1280 + 64 * (j))
#define XB_XGEN(j)  (2304 + 64 * (j))
#define XB_TOP      3328
#define XB_TOPGEN   3392
#define XCD_BAR_WORDS 3456
#define XB_SPIN_CAP (1u << 18)
__device__ __forceinline__ unsigned xb_ld(unsigned* p)              { return __hip_atomic_load(p, __ATOMIC_RELAXED, __HIP_MEMORY_SCOPE_AGENT); }
__device__ __forceinline__ unsigned xb_add(unsigned* p, unsigned v) { return __hip_atomic_fetch_add(p, v, __ATOMIC_RELAXED, __HIP_MEMORY_SCOPE_AGENT); }
__device__ __forceinline__ unsigned xb_xcc_id() { return (unsigned)__builtin_amdgcn_s_getreg((3 << 11) | 20) & 0xFu; }
#define XB_SPIN(cond, bar) do { unsigned _sp = 0; while (cond) { __builtin_amdgcn_s_sleep(1); \
    if ((++_sp & 255u) == 0u) { if (xb_ld(&(bar)[XB_TMO])) break; if (_sp > XB_SPIN_CAP) { atomicAdd(&(bar)[XB_TMO], 1u); break; } } } } while (0)
__device__ __forceinline__ void xcd_barrier_complete(unsigned* bar, unsigned x, unsigned& nloc, unsigned& nx) {
    const unsigned G = gridDim.x * gridDim.y * gridDim.z;
    unsigned sum, cnt, mine, sp = 0u;
    for (;;) {
        sum = 0u; cnt = 0u; mine = 0u;
#pragma unroll
        for (unsigned j = 0; j < 16; ++j) { const unsigned c = xb_ld(&bar[XB_XCNT(j)]); sum += c; cnt += (c > 0u) ? 1u : 0u; mine = (j == x) ? c : mine; }
        if (sum == G) break;
        __builtin_amdgcn_s_sleep(1);
        if ((++sp & 255u) == 0u) { if (xb_ld(&bar[XB_TMO])) break; if (sp > XB_SPIN_CAP) { atomicAdd(&bar[XB_TMO], 1u); break; } }
    }
    nloc = mine > 0u ? mine : 1u; nx = cnt > 0u ? cnt : 1u;
}
__device__ __forceinline__ void xcd_barrier(unsigned* bar, unsigned x, volatile LAS unsigned* st) {
    asm volatile("s_waitcnt vmcnt(0)" ::: "memory");
    __syncthreads();
    if (threadIdx.x == 0) {
        __builtin_amdgcn_s_waitcnt(0);
        unsigned nloc = st[0], nx = st[1];
        if (nloc == 0u) { xcd_barrier_complete(bar, x, nloc, nx); st[0] = nloc; st[1] = nx; }
        const unsigned old = xb_add(&bar[XB_XSUB(x)], 1u);
        const unsigned gen = old / nloc;
        if (old + 1u == (gen + 1u) * nloc) {
            __builtin_amdgcn_fence(__ATOMIC_RELEASE, "agent");
            asm volatile("s_waitcnt vmcnt(0)" ::: "memory");
            const unsigned og = xb_add(&bar[XB_TOP], 1u);
            const unsigned tg = og / nx;
            if (og + 1u == (tg + 1u) * nx) xb_add(&bar[XB_TOPGEN], 1u);
            else XB_SPIN(xb_ld(&bar[XB_TOPGEN]) == tg, bar);
            __builtin_amdgcn_fence(__ATOMIC_ACQUIRE, "agent");
            xb_add(&bar[XB_XGEN(x)], 1u);
            asm volatile("s_waitcnt vmcnt(0)" ::: "memory");
        } else {
            XB_SPIN(xb_ld(&bar[XB_XGEN(x)]) == gen, bar);
            __builtin_amdgcn_fence(__ATOMIC_ACQUIRE, "agent");
            asm volatile("s_waitcnt vmcnt(0)" ::: "memory");
        }
    }
    __syncthreads();
}

#define MFMA32(a, b, c) __builtin_amdgcn_mfma_f32_32x32x16_bf16((a), (b), (c), 0, 0, 0)
__device__ __forceinline__ int crow(int r, int hi) { return (r & 3) + 8 * (r >> 2) + 4 * hi; }

__device__ __forceinline__ void attn_phase(bf16_t* Q, const bf16_t* Kb, const bf16_t* VT, const bf16_t* CK, const bf16_t* CVT, const float* sink, int j, int vcu, int G, int wave, int lane) {
    const int r = lane & 31, h = lane >> 5;
    for (int u = vcu; u < 1280; u += G) {
        const bool lat = u < 1024;
        int b, kvh, qb, L, seqrow;
        if (lat) { b = u >> 7; kvh = (u >> 5) & 3; qb = u & 31; L = 4096; seqrow = NCTX + b * 4096; }
        else { const int v = u - 1024; b = v >> 3; kvh = (v >> 1) & 3; qb = v & 1; L = 256; seqrow = b * 256; }
        const int hq = kvh * 4 + (wave & 3), t0 = qb * 128 + (wave >> 2) * 64;
        bf16_t* Qp = Q + (size_t)(seqrow + t0) * DM + hq * 64;
        bf16x8 qf[2][4];
#pragma unroll
        for (int qi = 0; qi < 2; ++qi)
#pragma unroll
            for (int ks = 0; ks < 4; ++ks) qf[qi][ks] = *(const bf16x8*)(Qp + (size_t)(qi * 32 + r) * DM + ks * 16 + h * 8);
        const float m0 = sink[hq] * LOG2E;
        float mrow[2] = {m0, m0}, lrow[2] = {h == 0 ? 1.f : 0.f, h == 0 ? 1.f : 0.f};
        f32x16 O[2][2];
#pragma unroll
        for (int qi = 0; qi < 2; ++qi)
#pragma unroll
            for (int db = 0; db < 2; ++db)
#pragma unroll
                for (int i = 0; i < 16; ++i) O[qi][db][i] = 0.f;
        const int nseg = lat ? 2 : 1;
        for (int seg = 0; seg < nseg; ++seg) {
            const bf16_t* kb; const bf16_t* vb; int ldv, klo, khi; bool mask;
            if (seg == 0) { kb = Kb + (size_t)seqrow * K_LD + kvh * 64; ldv = lat ? VT_LDL : VT_LDC; vb = VT + (lat ? VT_LAT_BASE + (size_t)b * VT_LAT_SEQ : (size_t)b * VT_CTX_SEQ) + (size_t)kvh * 64 * ldv;
                if (lat) { klo = t0 - 128 < 0 ? 0 : t0 - 128; khi = t0 + 192 > L ? L : t0 + 192; mask = true; } else { klo = 0; khi = 256; mask = false; } }
            else { kb = CK + (size_t)(b * 2 + j) * 512 * K_LD + kvh * 64; vb = CVT + (size_t)((b * 2 + j) * 4 + kvh) * 64 * CVT_LD; ldv = CVT_LD; klo = 0; khi = 512; mask = false; }
            bf16x8 kf[4];
#pragma unroll
            for (int ks = 0; ks < 4; ++ks) kf[ks] = *(const bf16x8*)(kb + (size_t)(klo + r) * K_LD + ks * 16 + h * 8);
            bf16x8 vf[2][2];
#pragma unroll
            for (int db = 0; db < 2; ++db)
#pragma unroll
                for (int s = 0; s < 2; ++s) vf[db][s] = *(const bf16x8*)(vb + (size_t)(db * 32 + r) * ldv + klo + s * 16 + h * 8);
            for (int key = klo; key < khi; key += 32) {
                bf16x8 kn[4], vn[2][2];
                const int keyn = (key + 32 < khi) ? key + 32 : key;
#pragma unroll
                for (int db = 0; db < 2; ++db)
#pragma unroll
                    for (int s = 0; s < 2; ++s) vn[db][s] = *(const bf16x8*)(vb + (size_t)(db * 32 + r) * ldv + keyn + s * 16 + h * 8);
#pragma unroll
                for (int ks = 0; ks < 4; ++ks) kn[ks] = *(const bf16x8*)(kb + (size_t)(keyn + r) * K_LD + ks * 16 + h * 8);
                f32x16 S[2];
#pragma unroll
                for (int qi = 0; qi < 2; ++qi) {
#pragma unroll
                    for (int i = 0; i < 16; ++i) S[qi][i] = 0.f;
#pragma unroll
                    for (int ks = 0; ks < 4; ++ks) S[qi] = MFMA32(kf[ks], qf[qi][ks], S[qi]);
                }
                if (mask) {
#pragma unroll
                    for (int qi = 0; qi < 2; ++qi) { const int t = t0 + qi * 32 + r;
#pragma unroll
                        for (int i = 0; i < 16; ++i) { const int d = t - (key + crow(i, h)); if (d > 128 || d < -128) S[qi][i] = -1e30f; } }
                }
#pragma unroll
                for (int qi = 0; qi < 2; ++qi) {
                    float tm = S[qi][0];
#pragma unroll
                    for (int i = 1; i < 16; ++i) tm = fmaxf(tm, S[qi][i]);
                    tm = fmaxf(tm, __shfl_xor(tm, 32));
                    if (__any(tm > mrow[qi] + 8.0f)) {
                        const float mn = fmaxf(mrow[qi], tm), alpha = __builtin_amdgcn_exp2f(mrow[qi] - mn);
                        mrow[qi] = mn; lrow[qi] *= alpha;
#pragma unroll
                        for (int db = 0; db < 2; ++db)
#pragma unroll
                            for (int i = 0; i < 16; ++i) O[qi][db][i] *= alpha;
                    }
                    const float mn = mrow[qi];
                    float ps = 0.f;
#pragma unroll
                    for (int i = 0; i < 16; ++i) { S[qi][i] = __builtin_amdgcn_exp2f(S[qi][i] - mn); ps += S[qi][i]; }
                    lrow[qi] += ps;
                    bf16x8 pk[2];
#pragma unroll
                    for (int s = 0; s < 2; ++s) { u32x4 w; w.x = cvtpk(S[qi][8 * s], S[qi][8 * s + 1]); w.y = cvtpk(S[qi][8 * s + 2], S[qi][8 * s + 3]); w.z = cvtpk(S[qi][8 * s + 4], S[qi][8 * s + 5]); w.w = cvtpk(S[qi][8 * s + 6], S[qi][8 * s + 7]); pk[s] = __builtin_bit_cast(bf16x8, w); }
#pragma unroll
                    for (int db = 0; db < 2; ++db)
#pragma unroll
                        for (int s = 0; s < 2; ++s) O[qi][db] = MFMA32(vf[db][s], pk[s], O[qi][db]);
                }
#pragma unroll
                for (int ks = 0; ks < 4; ++ks) kf[ks] = kn[ks];
#pragma unroll
                for (int db = 0; db < 2; ++db)
#pragma unroll
                    for (int s = 0; s < 2; ++s) vf[db][s] = vn[db][s];
            }
        }
#pragma unroll
        for (int qi = 0; qi < 2; ++qi) {
            const float lt = lrow[qi] + __shfl_xor(lrow[qi], 32), inv = 1.0f / lt;
#pragma unroll
            for (int db = 0; db < 2; ++db)
#pragma unroll
                for (int g4 = 0; g4 < 4; ++g4) { u32x2 w; w.x = cvtpk(O[qi][db][4 * g4] * inv, O[qi][db][4 * g4 + 1] * inv); w.y = cvtpk(O[qi][db][4 * g4 + 2] * inv, O[qi][db][4 * g4 + 3] * inv);
                    *(u32x2*)(Qp + (size_t)(qi * 32 + r) * DM + db * 32 + 8 * g4 + 4 * h) = w; }
        }
    }
}

__device__ __forceinline__ float wave_sum(float v) {
#pragma unroll
    for (int o = 1; o < 64; o <<= 1) v += __shfl_xor(v, o);
    return v;
}
__device__ __forceinline__ void prep_phase(const float* src0, const float* src1, const bf16_t* xb, bf16_t* H, const float* nw, const float* mods, int shoff, int scoff, int gw, int NGW, int lane) {
    for (int row0 = gw; row0 < NTOK; row0 += 2 * NGW) {
        const int row1 = row0 + NGW < NTOK ? row0 + NGW : row0;
        f32x4 v[2][4]; float ss[2] = {0.f, 0.f};
#pragma unroll
        for (int rr = 0; rr < 2; ++rr) { const int row = rr ? row1 : row0;
            if (xb) {
#pragma unroll
                for (int q = 0; q < 2; ++q) { const u32x4 w = *(const u32x4*)(xb + (size_t)row * DM + 512 * q + 8 * lane);
                    v[rr][2 * q] = (f32x4){bf2f(w.x & 0xffffu), bf2f(w.x >> 16), bf2f(w.y & 0xffffu), bf2f(w.y >> 16)}; v[rr][2 * q + 1] = (f32x4){bf2f(w.z & 0xffffu), bf2f(w.z >> 16), bf2f(w.w & 0xffffu), bf2f(w.w >> 16)}; }
            } else { const float* s = row < NCTX ? src0 + (size_t)row * DM : src1 + (size_t)(row - NCTX) * DM;
#pragma unroll
                for (int q = 0; q < 2; ++q) { v[rr][2 * q] = *(const f32x4*)(s + 512 * q + 8 * lane); v[rr][2 * q + 1] = *(const f32x4*)(s + 512 * q + 8 * lane + 4); } } }
#pragma unroll
        for (int rr = 0; rr < 2; ++rr)
#pragma unroll
            for (int q = 0; q < 4; ++q) ss[rr] += (v[rr][q][0] * v[rr][q][0] + v[rr][q][1] * v[rr][q][1]) + (v[rr][q][2] * v[rr][q][2] + v[rr][q][3] * v[rr][q][3]);
#pragma unroll
        for (int o = 1; o < 64; o <<= 1) { ss[0] += __shfl_xor(ss[0], o); ss[1] += __shfl_xor(ss[1], o); }
#pragma unroll
        for (int rr = 0; rr < 2; ++rr) { const int row = rr ? row1 : row0; if (rr && row1 == row0) break;
            const float* md = mods + (size_t)cond_of_row(row) * NMOD;
            const float rstd = 1.0f / sqrtf(ss[rr] * (1.0f / DM) + 1e-6f);
#pragma unroll
            for (int q = 0; q < 2; ++q) { const int c = 512 * q + 8 * lane; u32x4 w;
#pragma unroll
                for (int hh = 0; hh < 2; ++hh) { const f32x4 g4 = *(const f32x4*)(nw + c + 4 * hh), sc = *(const f32x4*)(md + scoff + c + 4 * hh), sh = *(const f32x4*)(md + shoff + c + 4 * hh);
                    const f32x4 o = v[rr][2 * q + hh] * rstd * g4 * (sc + 1.0f) + sh; w[2 * hh] = cvtpk(o[0], o[1]); w[2 * hh + 1] = cvtpk(o[2], o[3]); }
                *(u32x4*)(H + (size_t)row * DM + c) = w; } }
    }
}
__device__ __forceinline__ void pool_phase(const bf16_t* H, bf16_t* P, int gw, int NGW, int lane) {
    for (int it = gw; it < (NTOK / 16) * 2; it += NGW) {
        const int q = it & 1, row0 = (it >> 1) * 16;
        int sb, t0, L;
        if (row0 < NCTX) { sb = row0 & ~255; t0 = row0 & 255; L = 256; } else { const int lr = row0 - NCTX; sb = NCTX + (lr & ~4095); t0 = lr & 4095; L = 4096; }
        const int c8 = lane + 64 * q, hw = 1 << (c8 >> 5);
        const bf16_t* Hc = H + (size_t)sb * DM + c8 * 8; bf16_t* Pc = P + (size_t)sb * DM + c8 * 8;
        float a[8];
#pragma unroll
        for (int e = 0; e < 8; ++e) a[e] = 0.f;
        const int hwm = q ? 8 : 2;
        for (int d = 0; d < 2 * hwm; ++d) { const int jr = t0 - hwm + d; const bool ok = jr >= t0 - hw && jr < t0 + hw && jr >= 0 && jr < L;
            const int jc = jr < 0 ? 0 : (jr >= L ? L - 1 : jr); const u32x4 w = *(const u32x4*)(Hc + (size_t)jc * DM); const float m_ = ok ? 1.f : 0.f;
#pragma unroll
            for (int e = 0; e < 4; ++e) { a[2 * e] += m_ * bf2f(w[e] & 0xffffu); a[2 * e + 1] += m_ * bf2f(w[e] >> 16); } }
#pragma unroll 4
        for (int s_ = 0; s_ < 16; ++s_) { const int t = t0 + s_;
            int st = t - hw; if (st < 0) st = 0; int en = t + hw; if (en > L) en = L;
            const float inv = 1.0f / (float)(en - st);
            const u32x4 w = *(const u32x4*)(Hc + (size_t)t * DM); u32x4 o;
#pragma unroll
            for (int e = 0; e < 4; ++e) o[e] = cvtpk(a[2 * e] * inv - bf2f(w[e] & 0xffffu), a[2 * e + 1] * inv - bf2f(w[e] >> 16));
            *(u32x4*)(Pc + (size_t)t * DM) = o;
            const int ja = t + hw, jl = t - hw; const float ma = ja < L ? 1.f : 0.f, ml = jl >= 0 ? 1.f : 0.f;
            const u32x4 wa = *(const u32x4*)(Hc + (size_t)(ja < L ? ja : L - 1) * DM), wl = *(const u32x4*)(Hc + (size_t)(jl >= 0 ? jl : 0) * DM);
#pragma unroll
            for (int e = 0; e < 4; ++e) { a[2 * e] += ma * bf2f(wa[e] & 0xffffu) - ml * bf2f(wl[e] & 0xffffu); a[2 * e + 1] += ma * bf2f(wa[e] >> 16) - ml * bf2f(wl[e] >> 16); } }
    }
}
__device__ __forceinline__ void fix_phase(const float* hal, bf16_t* A, const float* cw, const float* cb, int gt, int GT) {
    for (int it = gt; it < 120 * 704; it += GT) {
        const int bi = it / 704, c = (it % 704) * 4, b = bi / 15, i = bi % 15 + 1, pmh = 32 + b * 16 + i;
        const float* hl = hal + (size_t)(pmh - 1) * 4 * DFF2; const float* hh = hal + (size_t)pmh * 4 * DFF2;
        f32x4 cv1[2], cv2[2];
#pragma unroll
        for (int bj = 0; bj < 2; ++bj) { const int col = bj * DFF + c;
            const f32x4 uA = *(const f32x4*)(hl + 2 * DFF2 + col), uB = *(const f32x4*)(hl + 3 * DFF2 + col), uC = *(const f32x4*)(hh + col), uD = *(const f32x4*)(hh + DFF2 + col);
            const f32x4 w0 = *(const f32x4*)(cw + col), w1 = *(const f32x4*)(cw + DFF2 + col), w2 = *(const f32x4*)(cw + 2 * DFF2 + col), bb = *(const f32x4*)(cb + col);
            cv1[bj] = w0 * uA + w1 * uB + w2 * uC + bb; cv2[bj] = w0 * uB + w1 * uC + w2 * uD + bb; }
        const size_t R = (size_t)pmh * 256;
        u32x2 w; w.x = cvtpk(silu_mul(cv1[0][0], cv1[1][0]), silu_mul(cv1[0][1], cv1[1][1])); w.y = cvtpk(silu_mul(cv1[0][2], cv1[1][2]), silu_mul(cv1[0][3], cv1[1][3]));
        *(u32x2*)(A + (R - 1) * DFF + c) = w;
        w.x = cvtpk(silu_mul(cv2[0][0], cv2[1][0]), silu_mul(cv2[0][1], cv2[1][1])); w.y = cvtpk(silu_mul(cv2[0][2], cv2[1][2]), silu_mul(cv2[0][3], cv2[1][3]));
        *(u32x2*)(A + R * DFF + c) = w;
    }
}

__device__ __forceinline__ void transpose_item(const float* W, int K, int N, bf16_t* WT, int mapkind, LAS float* scr, int item, int lane) {
    const int nblk = N / 32, kb = item / nblk, nb = item % nblk, k0 = 64 * kb, n0 = 32 * nb;
    int d0 = n0;
    if (mapkind == 1) { const int head = n0 >> 6, bj = (n0 >> 5) & 1; d0 = 256 * (head >> 2) + 128 * bj + 32 * (head & 3); }
    else if (mapkind == 2) { const int bj = n0 >= DFF ? 1 : 0, cc = n0 - bj * DFF; d0 = 256 * (cc >> 7) + 128 * bj + (cc & 127); }
#pragma unroll 32
    for (int i = 0; i < 32; ++i) { const int kk = 2 * i + (lane >> 5); scr[kk * 33 + (lane & 31)] = W[(size_t)(k0 + kk) * N + n0 + (lane & 31)]; }
    asm volatile("s_waitcnt lgkmcnt(0)" ::: "memory");
    const int c = lane & 7;
#pragma unroll
    for (int jj = 0; jj < 4; ++jj) { const int n = (lane >> 3) + 8 * jj; const LAS float* s = scr + (8 * c) * 33 + n;
        u32x4 o; o.x = cvtpk(s[0 * 33], s[1 * 33]); o.y = cvtpk(s[2 * 33], s[3 * 33]); o.z = cvtpk(s[4 * 33], s[5 * 33]); o.w = cvtpk(s[6 * 33], s[7 * 33]);
        *(u32x4*)(WT + (size_t)(d0 + n) * K + k0 + 8 * c) = o; }
    asm volatile("s_waitcnt lgkmcnt(0)" ::: "memory");
}

enum { K_PRO = 0, K_PREP1, K_PREP2, K_QKV, K_ATTN, K_WO, K_POOLP, K_POOLG, K_CHAN, K_SEQC, K_SEQL, K_FFN1, K_FIX, K_FFN2, K_ST1, K_ST2, K_FFN2X };
#ifndef PROBE_DUP
#define PROBE_DUP(X, k)
#endif
#define PROG_LIST(X) X(K_PRO,0) \
    X(K_PREP1,0) X(K_QKV,0) X(K_ATTN,0) X(K_WO,0) X(K_PREP2,0) PROBE_DUP(X, 0) X(K_FFN1,0) X(K_FIX,0) X(K_FFN2,0) \
    X(K_PREP1,1) X(K_POOLP,1) X(K_POOLG,1) X(K_PREP2,1) PROBE_DUP(X, 1) X(K_FFN1,1) X(K_FIX,1) X(K_FFN2,1) \
    X(K_PREP1,2) X(K_CHAN,2) X(K_SEQC,2) X(K_ST1,2) X(K_ST2,2) X(K_PREP2,2) PROBE_DUP(X, 2) X(K_FFN1,2) X(K_FIX,2) X(K_FFN2,2) \
    X(K_PREP1,3) X(K_QKV,3) X(K_ATTN,3) X(K_WO,3) X(K_PREP2,3) PROBE_DUP(X, 3) X(K_FFN1,3) X(K_FIX,3) X(K_FFN2,3)
#define PROG_K(k, l) k,
#define PROG_L(k, l) l,
__constant__ unsigned char PROG_KIND[] = { PROG_LIST(PROG_K) };
__constant__ unsigned char PROG_LAYER[] = { PROG_LIST(PROG_L) };
static const unsigned char H_PROG_KIND[] = { PROG_LIST(PROG_K) };
constexpr int NSTEP = (int)sizeof(H_PROG_KIND);

struct Args { const float* in[22]; float* out; unsigned char* ws; int s_lo, s_hi; };

__global__ void __launch_bounds__(512, 2) mega_fwd(Args a) {
    extern __shared__ __attribute__((aligned(16))) unsigned char lds_raw[];
    LAS unsigned char* lds = (LAS unsigned char*)lds_raw;
    LAS unsigned char* xl = lds + LDS_X;
    cg::grid_group grid = cg::this_grid();
    volatile LAS unsigned* bst = (volatile LAS unsigned*)(lds + LDS_MISC);
    unsigned* bar = (unsigned*)(a.ws + WS_CTL);
    if (threadIdx.x < 4) bst[threadIdx.x] = 0u;
    __syncthreads();
    const unsigned xcc = xb_xcc_id();
    if (threadIdx.x == 0) (void)xb_add(&bar[XB_XCNT(xcc)], 1u);
    const int G = gridDim.x, NGW = G * 8, GT = G * 512;
    unsigned char* ws = a.ws; float* out = a.out;
    float* mods = (float*)(ws + WS_MODS);
    float* ropec = (float*)(ws + WS_ROPE); float* ropes = ropec + 1024;
    bf16_t* Hb = (bf16_t*)(ws + WS_H);
    bf16_t* BIG = (bf16_t*)(ws + WS_BIG);
    bf16_t* Qb = (bf16_t*)(ws + WS_Q); bf16_t* Kbuf = (bf16_t*)(ws + WS_K); bf16_t* VTb = (bf16_t*)(ws + WS_VT);
    float* hal = (float*)(ws + WS_HAL);

    for (int s = a.s_lo; s < a.s_hi; ++s) {
        int tid = threadIdx.x, bx = blockIdx.x;
        asm volatile("" : "+v"(tid), "+s"(bx));
        const int lane = tid & 63, wave = __builtin_amdgcn_readfirstlane(tid >> 6);
        const int vcu = (G % 8 == 0) ? (bx % 8) * (G / 8) + bx / 8 : bx;
        const int gw = vcu * 8 + wave, gt = bx * 512 + tid;
        const int kind = PROG_KIND[s], layer = PROG_LAYER[s], jl = layer / 3;
        const float* xs0 = a.in[0]; const float* xs1 = a.in[1];
        bf16_t* XB = (bf16_t*)(ws + WS_XB); const bf16_t* xbin = (s <= 4) ? nullptr : XB;
        const float* lmods = mods + (size_t)layer * 9 * NMOD;
        switch (kind) {
#ifndef NO_PRO
        case K_PRO: {
            LAS float* scond = (LAS float*)lds; LAS float* part = (LAS float*)(lds + 40960);
            for (int i = tid; i < 9 * 1024; i += 512) { const int cnd = i >> 10, k = i & 1023; const float v = cnd == 0 ? a.in[5][k] : a.in[4][(cnd - 1) * 1024 + k];
                scond[((k & 1) * 9 + cnd) * 512 + (k >> 7) * 64 + ((k & 127) >> 1)] = v / (1.0f + __expf(-v)); }
            __syncthreads();
            for (int item = bx; item < 768; item += G) {
                const int ly = item / 192, cb = item % 192, col = lane & 31, hk = lane >> 5;
                const float* w = a.in[8] + (size_t)ly * 1024 * NMOD + cb * 32 + col + (size_t)(wave * 128 + hk) * NMOD;
                const LAS float* sc = scond + (hk * 9) * 512 + wave * 64;
                float ac[9];
#pragma unroll
                for (int c = 0; c < 9; ++c) ac[c] = 0.f;
#pragma unroll 4
                for (int kk = 0; kk < 64; kk += 4) {
                    const float w0 = w[(size_t)(2 * kk) * NMOD], w1 = w[(size_t)(2 * kk + 2) * NMOD], w2 = w[(size_t)(2 * kk + 4) * NMOD], w3 = w[(size_t)(2 * kk + 6) * NMOD];
#pragma unroll
                    for (int c = 0; c < 9; ++c) { const f32x4 s = *(const LAS f32x4*)(sc + c * 512 + kk); ac[c] += (w0 * s[0] + w1 * s[1]) + (w2 * s[2] + w3 * s[3]); }
                }
#pragma unroll
                for (int c = 0; c < 9; ++c) part[((wave * 2 + hk) * 9 + c) * 32 + col] = ac[c];
                __syncthreads();
                for (int i = tid; i < 288; i += 512) { const int c = i >> 5, l = i & 31; float sm = a.in[9][ly * NMOD + cb * 32 + l];
#pragma unroll
                    for (int p = 0; p < 16; ++p) sm += part[(p * 9 + c) * 32 + l];
                    mods[((size_t)ly * 9 + c) * NMOD + cb * 32 + l] = sm; }
                __syncthreads();
            }
            {
                LAS float* scr = (LAS float*)(lds + wave * 16384);
                constexpr int I_QKV = 16 * 48, I_WO = 16 * 32, I_POOL = 4 * 8, I_IN = 16 * 176, I_OUT = 44 * 32;
                constexpr int NIT = 2 * I_QKV + 2 * I_WO + 4 * I_POOL + 4 * I_IN + 4 * I_OUT;
                for (int it = gw; it < NIT; it += NGW) {
                    int r_ = it;
                    if (r_ < 4 * I_IN) { const int ly = r_ / I_IN; transpose_item(a.in[18] + (size_t)ly * DM * DFF2, DM, DFF2, (bf16_t*)(ws + WS_WIN) + (size_t)ly * DFF2 * DM, 2, scr, r_ % I_IN, lane); continue; } r_ -= 4 * I_IN;
                    if (r_ < 4 * I_OUT) { const int ly = r_ / I_OUT; transpose_item(a.in[21] + (size_t)ly * DFF * DM, DFF, DM, (bf16_t*)(ws + WS_WOUT) + (size_t)ly * DM * DFF, 0, scr, r_ % I_OUT, lane); continue; } r_ -= 4 * I_OUT;
                    if (r_ < 2 * I_QKV) { const int ly = r_ / I_QKV; transpose_item(a.in[10] + (size_t)ly * DM * NQKV, DM, NQKV, (bf16_t*)(ws + WS_WQKV) + (size_t)ly * NQKV * DM, 1, scr, r_ % I_QKV, lane); continue; } r_ -= 2 * I_QKV;
                    if (r_ < 2 * I_WO) { const int ly = r_ / I_WO; transpose_item(a.in[14] + (size_t)ly * DM * DM, DM, DM, (bf16_t*)(ws + WS_WO) + (size_t)ly * DM * DM, 0, scr, r_ % I_WO, lane); continue; } r_ -= 2 * I_WO;
                    { const int gp = r_ / I_POOL; transpose_item(a.in[15] + (size_t)gp * 65536, 256, 256, (bf16_t*)(ws + WS_WPOOL) + (size_t)gp * 65536, 0, scr, r_ % I_POOL, lane); }
                }
            }
            __syncthreads();
            LAS f32x2* TAB = (LAS f32x2*)lds;
            for (int k = tid; k < 4096; k += 512) { float sv, cv; sincospif((float)k * (1.0f / 2048.0f), &sv, &cv); TAB[k] = (f32x2){cv, sv}; }
            __syncthreads();
            { bf16_t* A1 = (bf16_t*)(ws + WS_A1);
                for (int it = gt; it < 32 * 256 * 32; it += GT) { const int p = it >> 13, j = (it >> 5) & 255, k0 = (it & 31) * 8, t1 = (j >> 1) & 63, bbl = j >> 7, ri = j & 1, part_ = (k0 >> 6) & 1, a0 = k0 & 63; float v[8];
#pragma unroll
                    for (int e = 0; e < 8; ++e) { const f32x2 cs = TAB[(t1 * (64 * (a0 + e) + 2 * p + bbl)) & 4095]; const float x = ri == 0 ? (part_ == 0 ? cs.x : -cs.y) : (part_ == 0 ? -cs.y : -cs.x); v[e] = ((k0 >> 7) == bbl) ? x * (1.0f / 64.0f) : 0.f; }
                    u32x4 o; o.x = cvtpk(v[0], v[1]); o.y = cvtpk(v[2], v[3]); o.z = cvtpk(v[4], v[5]); o.w = cvtpk(v[6], v[7]); *(u32x4*)(A1 + (size_t)it * 8) = o; }
                bf16_t* A2 = (bf16_t*)(ws + WS_A2);
                for (int it = gt; it < 256 * 64; it += GT) { const int r_ = it >> 6, k0 = (it & 63) * 8, t1l = r_ >> 6, t2 = r_ & 63; float v[8];
#pragma unroll
                    for (int e = 0; e < 8; ++e) { const int k = k0 + e, bb = k >> 3; const f32x2 cs = TAB[((t2 * bb) & 63) * 64]; v[e] = (((k >> 1) & 3) == t1l) ? ((k & 1) ? cs.y : cs.x) : 0.f; }
                    u32x4 o; o.x = cvtpk(v[0], v[1]); o.y = cvtpk(v[2], v[3]); o.z = cvtpk(v[4], v[5]); o.w = cvtpk(v[6], v[7]); *(u32x4*)(A2 + (size_t)it * 8) = o; }
                bf16_t* D2 = (bf16_t*)(ws + WS_DFT256);
                for (int it = gt; it < 256 * 64; it += GT) { const int t = it >> 6, j0 = (it & 63) * 8, part_ = j0 >= 256, jj = j0 & 255; float v[8];
#pragma unroll
                    for (int e = 0; e < 8; ++e) { const f32x2 cs = TAB[((t * (jj + e)) & 255) * 16]; v[e] = (part_ ? -cs.y : cs.x) * (1.0f / 16.0f); }
                    u32x4 o; o.x = cvtpk(v[0], v[1]); o.y = cvtpk(v[2], v[3]); o.z = cvtpk(v[4], v[5]); o.w = cvtpk(v[6], v[7]); *(u32x4*)(D2 + (size_t)t * 512 + j0) = o; }
            }
            { LAS float* wt = (LAS float*)(lds + 32768); bf16_t* WCS = (bf16_t*)(ws + WS_WCS);
                for (int item = bx; item < 256; item += G) {
                    const int gp = item >> 6, n0 = (item & 63) * 16;
                    for (int i = tid; i < 4096; i += 512) wt[i] = a.in[17][(size_t)(gp * 256 + (i >> 4)) * DM + n0 + (i & 15)];
                    __syncthreads();
                    const int nn = tid & 15, cg_ = tid >> 4;
                    float ac[8], as[8];
#pragma unroll
                    for (int e = 0; e < 8; ++e) { ac[e] = 0.f; as[e] = 0.f; }
                    for (int cp = 0; cp < 256; ++cp) { const float wv = wt[cp * 16 + nn];
#pragma unroll
                        for (int e = 0; e < 8; ++e) { const f32x2 cs = TAB[(((cg_ * 8 + e) * cp) & 255) * 16]; ac[e] += wv * cs.x; as[e] += wv * cs.y; } }
                    u32x4 o; o.x = cvtpk(ac[0] * 0.0625f, ac[1] * 0.0625f); o.y = cvtpk(ac[2] * 0.0625f, ac[3] * 0.0625f); o.z = cvtpk(ac[4] * 0.0625f, ac[5] * 0.0625f); o.w = cvtpk(ac[6] * 0.0625f, ac[7] * 0.0625f);
                    *(u32x4*)(WCS + (size_t)(n0 + nn) * DM + gp * 256 + cg_ * 8) = o;
                    o.x = cvtpk(as[0] * 0.0625f, as[1] * 0.0625f); o.y = cvtpk(as[2] * 0.0625f, as[3] * 0.0625f); o.z = cvtpk(as[4] * 0.0625f, as[5] * 0.0625f); o.w = cvtpk(as[6] * 0.0625f, as[7] * 0.0625f);
                    *(u32x4*)(WCS + (size_t)(1024 + n0 + nn) * DM + gp * 256 + cg_ * 8) = o;
                    __syncthreads();
                }
            }
            for (int i = gt; i < 1024; i += GT) { const int pos = i >> 4, f = i & 15; const float invf = 1.0f / powf(10000.0f, (float)f * (1.0f / 16.0f)); float sv, cv; sincosf((float)pos * invf, &sv, &cv); ropec[i] = cv; ropes[i] = sv; }
            { bf16_t* CKb = (bf16_t*)(ws + WS_CK); bf16_t* CVTb = (bf16_t*)(ws + WS_CVT);
                for (int it = gt; it < 262144; it += GT) { const f32x4 v0 = *(const f32x4*)(a.in[2] + (size_t)it * 8), v1 = *(const f32x4*)(a.in[2] + (size_t)it * 8 + 4);
                    u32x4 o; o.x = cvtpk(v0[0], v0[1]); o.y = cvtpk(v0[2], v0[3]); o.z = cvtpk(v1[0], v1[1]); o.w = cvtpk(v1[2], v1[3]); *(u32x4*)(CKb + (size_t)(it >> 5) * K_LD + (it & 31) * 8) = o; }
                for (int it = gt; it < 262144; it += GT) { const int d = it & 63, chunk = (it >> 6) & 63, kvh = (it >> 12) & 3, bj2 = it >> 14, g16 = chunk >> 1, hh = chunk & 1; float v[8];
#pragma unroll
                    for (int e = 0; e < 8; ++e) { const int pos = 16 * g16 + 4 * hh + (e & 3) + 8 * (e >> 2); v[e] = a.in[3][((size_t)(bj2 * 512 + pos) * 4 + kvh) * 64 + d]; }
                    u32x4 o; o.x = cvtpk(v[0], v[1]); o.y = cvtpk(v[2], v[3]); o.z = cvtpk(v[4], v[5]); o.w = cvtpk(v[6], v[7]); *(u32x4*)(CVTb + ((size_t)(bj2 * 4 + kvh) * 64 + d) * CVT_LD + chunk * 8) = o; }
            }
        } break;
#endif
        case K_PREP1: prep_phase(xs0, xs1, xbin, Hb, a.in[6] + layer * DM, lmods, 0, 1024, gw, NGW, lane); break;
        case K_PREP2: prep_phase(xs0, xs1, xbin, Hb, a.in[7] + layer * DM, lmods, 3072, 4096, gw, NGW, lane); break;
        case K_POOLP: pool_phase(Hb, BIG, gw, NGW, lane); break;
        case K_FIX: fix_phase(hal, BIG, a.in[19] + (size_t)layer * 3 * DFF2, a.in[20] + (size_t)layer * DFF2, gt, GT); break;
#ifndef NO_ATTN
        case K_ATTN: attn_phase(Qb, Kbuf, VTb, (const bf16_t*)(ws + WS_CK), (const bf16_t*)(ws + WS_CVT), a.in[13] + jl * 16, jl, vcu, G, wave, lane); break;
#endif
#ifndef NO_QKV
        case K_QKV: {
            pg8::Gemm g{(const char*)Hb, (const char*)(ws + WS_WQKV) + (size_t)jl * NQKV * DM * 2, DM, DM, DM, 160, 6, 160, 0, 0};
            pg8::Order S; S.init(160, 6, G, bx);
            pg8::EpiQKV E{Qb, Kbuf, VTb, out + OUT_CK + (size_t)jl * 65536, out + OUT_CV + (size_t)jl * 65536, a.in[11] + jl * 64, a.in[12] + jl * 64, ropec, ropes};
            pg8::gemm_phase<pg8::EpiQKV>(lds, xl, g, S, E, tid);
        } break;
#endif
#ifndef NO_CHAN
        case K_CHAN: {
            for (int v = 0; v < 2; ++v) {
                pg8::Gemm g{(const char*)(ws + WS_WCS), (const char*)(Hb + (size_t)(v ? NCTX : 0) * DM), DM, DM, DM, 8, v ? 128 : 32, 8, 0, 0};
                g.bperm = v;
                pg8::Order S; S.init(8, v ? 128 : 32, G, bx);
                pg8::EpiChan E{(bf16_t*)(ws + (v ? WS_PTL : WS_PTC)), v};
                pg8::gemm_phase<pg8::EpiChan>(lds, xl, g, S, E, tid);
            }
        } break;
#endif
        case K_ST1: {
            pg8::Gemm g{(const char*)(ws + WS_PTL), (const char*)(ws + WS_A1), 8192, 256, 256, 32, 32, 32, 512, 0};
            pg8::Order S; S.init(32, 32, G, bx);
            pg8::EpiY1 E{(bf16_t*)(ws + WS_YT)};
            pg8::gemm_phase<pg8::EpiY1>(lds, xl, g, S, E, tid);
        } break;
#ifndef NO_FFN1
        case K_FFN1: {
            pg8::Gemm g{(const char*)Hb, (const char*)(ws + WS_WIN) + (size_t)layer * DFF2 * DM * 2, DM, DM, DM, 160, 22, 160, 0, 0};
            pg8::Order S; S.init(160, 22, G, bx);
            pg8::EpiFfn1 E{BIG, hal, a.in[19] + (size_t)layer * 3 * DFF2, a.in[20] + (size_t)layer * DFF2};
            pg8::gemm_phase<pg8::EpiFfn1>(lds, xl, g, S, E, tid);
        } break;
#endif
#ifndef NO_RES
        default: {
            pg8::Gemm g; pg8::EpiRes E; E.src0 = xs0; E.src1 = xs1; E.xin = xbin; { const bool last_ = (kind == K_FFN2 && layer == 3); E.xout = last_ ? nullptr : XB; E.dst = last_ ? out : nullptr; } E.pscale = nullptr; E.pm0 = 0; E.rowmap = 0; E.gate = lmods + 2048;
            g.akoff = 0; g.bstride = 0;
            if (kind == K_WO) { g.A = (const char*)Qb; g.Bt = (const char*)(ws + WS_WO) + (size_t)jl * DM * DM * 2; g.lda = DM; g.ldb = DM; g.K = DM; g.nM = 160; g.nN = 4; g.amod = 160; }
            else if (kind == K_POOLG) { g.A = (const char*)BIG; g.Bt = (const char*)(ws + WS_WPOOL); g.lda = DM; g.ldb = 256; g.K = 256; g.nM = 160; g.nN = 4; g.amod = 160; g.akoff = 512; E.pscale = a.in[16]; }
            else if (kind == K_SEQC) { g.A = (const char*)(ws + WS_DFT256); g.Bt = (const char*)(ws + WS_PTC); g.lda = 512; g.ldb = 512; g.K = 512; g.nM = 32; g.nN = 4; g.amod = 1; g.bmod = 1; g.bstride = (size_t)256 * 2048 * 2; }
            else if (kind == K_ST2) { g.A = (const char*)(ws + WS_A2); g.Bt = (const char*)(ws + WS_YT); g.lda = 512; g.ldb = 8192; g.K = 512; g.nM = 128; g.nN = 4; g.amod = 1; g.bmod = 16; g.bstride = (size_t)1024 * 8192 * 2; g.bstride2 = 16; g.bkc = 256; E.rowmap = 1; }
            else { g.A = (const char*)BIG; g.Bt = (const char*)(ws + WS_WOUT) + (size_t)layer * DM * DFF * 2; g.lda = DFF; g.ldb = DFF; g.K = DFF; g.nM = 160; g.nN = 4; g.amod = 160; E.gate = lmods + 5120; }
            pg8::Order S; S.init(g.nM, g.nN, G, bx);
            const int nfull = (S.nwg / G) * G, rem = S.nwg - nfull;
            if (rem > 0 && 2 * rem <= G && (G & 1) == 0) {
                S.hi = nfull; if (nfull > 0) pg8::gemm_phase<pg8::EpiRes>(lds, xl, g, S, E, tid);
                S.lo = nfull; S.hi = S.nwg; S.G = G >> 1; S.c = bx >> 1;
                if (bx & 1) pg8::gemm_phase<pg8::EpiRes, 2>(lds, xl, g, S, E, tid); else pg8::gemm_phase<pg8::EpiRes, 1>(lds, xl, g, S, E, tid);
            } else pg8::gemm_phase<pg8::EpiRes>(lds, xl, g, S, E, tid);
        } break;
#endif
        }
        if (s + 1 < a.s_hi && kind != K_SEQC) { if (s == a.s_lo) grid.sync(); else xcd_barrier(bar, xcc, bst); }
    }
}

extern "C" void kernel_launch(void* const* d_in, const int* in_sizes, int n_in, void* d_out, int out_size, void* d_ws, size_t ws_size, hipStream_t stream) {
    static int grid = 0;
    if (grid == 0) {
        if (n_in != 22 || ws_size < WS_END) { fprintf(stderr, "kernel_launch: unexpected n_in %d or ws_size %zu (< %zu)\n", n_in, ws_size, (size_t)WS_END); grid = -1; return; }
        int dev = 0, cus = 0, per_cu = 0;
        hipGetDevice(&dev); hipDeviceGetAttribute(&cus, hipDeviceAttributeMultiprocessorCount, dev);
        if (hipFuncSetAttribute((const void*)mega_fwd, hipFuncAttributeMaxDynamicSharedMemorySize, LDS_BYTES) != hipSuccess) { fprintf(stderr, "kernel_launch: hipFuncSetAttribute failed\n"); grid = -1; return; }
        if (hipOccupancyMaxActiveBlocksPerMultiprocessor(&per_cu, (const void*)mega_fwd, 512, LDS_BYTES) != hipSuccess || per_cu < 1) { fprintf(stderr, "kernel_launch: occupancy query says %d\n", per_cu); per_cu = 1; }
        (void)hipGetLastError();
        grid = cus * 1;
    }
    if (grid < 0) return;
    if (hipMemsetAsync((char*)d_ws + WS_CTL, 0, CTL_BYTES, stream) != hipSuccess) { fprintf(stderr, "kernel_launch: memset failed\n"); return; }
    Args a{};
    for (int i = 0; i < 22; ++i) a.in[i] = (const float*)d_in[i];
    a.out = (float*)d_out; a.ws = (unsigned char*)d_ws;
#if MK_MULTI
    for (int s = 0; s < NSTEP;) {
        int e = s + 1; if (H_PROG_KIND[s] == K_SEQC) e = s + 2;
        a.s_lo = s; a.s_hi = e; void* args[] = {&a};
        hipError_t err = hipLaunchCooperativeKernel((const void*)mega_fwd, dim3(grid), dim3(512), args, LDS_BYTES, stream);
        if (err != hipSuccess) { fprintf(stderr, "kernel_launch: cooperative launch failed: %s\n", hipGetErrorString(err)); break; }
        s = e;
    }
#else
    a.s_lo = 0; a.s_hi = NSTEP; void* args[] = {&a};
    hipError_t err = hipLaunchCooperativeKernel((const void*)mega_fwd, dim3(grid), dim3(512), args, LDS_BYTES, stream);
    if (err != hipSuccess) fprintf(stderr, "kernel_launch: cooperative launch failed: %s (grid %d)\n", hipGetErrorString(err), grid);
#endif
}
```
